# Optimizing an MI355X kernel written in HIP

```python
import jax, jax.numpy as jnp
from jax import lax
import numpy as np

D_MODEL = 1024
BATCH = 1
SEQ = 16384
DEPTH = 2
DEC_BATCH = 8
DEC_SEQ = 16
PAST_LEN = 2048

CHUNK = 64
D_CONV = D_MODEL
CONV_W = 3
D_POOL = D_MODEL
POOL_WINDOWS = (2, 4, 8, 16)
N_POOL_GROUPS = len(POOL_WINDOWS)
POOL_GROUP = D_POOL // N_POOL_GROUPS
POOL_HIST = max(POOL_WINDOWS) - 1
N_BRANCH = 2
D_FF = 4 * D_MODEL
D_IN = 3 * D_CONV + D_POOL + N_BRANCH * D_MODEL
EPS = 1e-6

kernel_name = "hybrid_gated_conv_pool_stream_step"


def rms_norm(x, g):
    xf = x.astype(jnp.float32)
    y = xf * lax.rsqrt(jnp.mean(xf * xf, axis=-1, keepdims=True) + EPS)
    return (y * g.astype(jnp.float32)).astype(x.dtype)


def short_conv_branch(b, c, v, conv_state, conv_w):
    z = c * v
    zp = jnp.concatenate([conv_state.astype(z.dtype), z], axis=1)
    T = z.shape[1]
    y = conv_w[0] * zp[:, 0:T]
    for k in range(1, CONV_W):
        y = y + conv_w[k] * zp[:, k:k + T]
    return b * y, zp[:, -(CONV_W - 1):]


def pool_branch(p, pool_state, start, pool_w, pool_scale):
    T = p.shape[1]
    pp = jnp.concatenate([pool_state.astype(p.dtype), p], axis=1)
    ppf = pp.astype(jnp.float32)
    cs = jnp.pad(lax.cumsum(ppf, axis=1), ((0, 0), (1, 0), (0, 0)))
    pos = start + jnp.arange(T, dtype=jnp.int32)
    cur = ppf[:, POOL_HIST:]
    outs = []
    for gi, w in enumerate(POOL_WINDOWS):
        sl = slice(gi * POOL_GROUP, (gi + 1) * POOL_GROUP)
        hi = cs[:, POOL_HIST + 1:POOL_HIST + 1 + T, sl]
        lo = cs[:, POOL_HIST + 1 - w:POOL_HIST + 1 - w + T, sl]
        cnt = jnp.minimum(pos + 1, w).astype(jnp.float32)[None, :, None]
        outs.append((hi - lo) / cnt - cur[..., sl])
    d = jnp.stack(outs, axis=2).astype(p.dtype)
    y = jnp.einsum('btgc,gce->btge', d, pool_w).reshape(p.shape[0], T, D_POOL)
    return y * pool_scale, pp[:, -POOL_HIST:]


def trunk_layer(x, conv_state, pool_state, start, w_in, b_gate, conv_w, w_conv_out,
                pool_w, pool_scale, w_pool_out, w_o, g_mix_pre, g_mix_post,
                w_up, w_down, g_ffn_pre, g_ffn_post):
    h = rms_norm(x, g_mix_pre)
    proj = h @ w_in
    b, c, v, p, gates = jnp.split(
        proj, [D_CONV, 2 * D_CONV, 3 * D_CONV, 3 * D_CONV + D_POOL], axis=-1)
    gates = jax.nn.sigmoid(gates + b_gate)
    g_a, g_b = jnp.split(gates, N_BRANCH, axis=-1)
    ya, new_conv = short_conv_branch(b, c, v, conv_state, conv_w)
    yb, new_pool = pool_branch(p, pool_state, start, pool_w, pool_scale)
    merged = g_a * (ya @ w_conv_out) + g_b * (yb @ w_pool_out)
    x = x + rms_norm(merged @ w_o, g_mix_post)
    h = rms_norm(x, g_ffn_pre)
    f = jnp.square(jax.nn.relu(h @ w_up)) @ w_down
    x = x + rms_norm(f, g_ffn_post)
    return x, new_conv, new_pool


def run_trunk(x, conv_states, pool_states, start, w_in, b_gate, conv_w, w_conv_out,
              pool_w, pool_scale, w_pool_out, w_o, g_mix_pre, g_mix_post,
              w_up, w_down, g_ffn_pre, g_ffn_post):
    new_convs, new_pools = [], []
    for l in range(DEPTH):
        x, nc, npl = trunk_layer(
            x, conv_states[l], pool_states[l], start, w_in[l], b_gate[l], conv_w[l],
            w_conv_out[l], pool_w[l], pool_scale[l], w_pool_out[l], w_o[l],
            g_mix_pre[l], g_mix_post[l], w_up[l], w_down[l], g_ffn_pre[l], g_ffn_post[l])
        new_convs.append(nc)
        new_pools.append(npl)
    return x, jnp.stack(new_convs, axis=0), jnp.stack(new_pools, axis=0)


def setup_inputs(seed: int = 0) -> dict:
    key = jax.random.key(seed)
    ks = jax.random.split(key, 20)
    n = jax.random.normal
    f32 = jnp.float32
    return {
        "x_prompt": n(ks[0], (BATCH, SEQ, D_MODEL), f32),
        "x_sample": n(ks[1], (DEC_BATCH, DEC_SEQ, D_MODEL), f32),
        "cache_conv": n(ks[2], (DEPTH, DEC_BATCH, CONV_W - 1, D_CONV), f32),
        "cache_pool": n(ks[3], (DEPTH, DEC_BATCH, POOL_HIST, D_POOL), f32),
        "w_in": n(ks[4], (DEPTH, D_MODEL, D_IN), f32) * D_MODEL ** -0.5,
        "b_gate": n(ks[5], (DEPTH, N_BRANCH * D_MODEL), f32) * 0.1,
        "conv_w": n(ks[6], (DEPTH, CONV_W, D_CONV), f32) * CONV_W ** -0.5,
        "w_conv_out": n(ks[7], (DEPTH, D_CONV, D_MODEL), f32) * D_CONV ** -0.5,
        "pool_w": n(ks[8], (DEPTH, N_POOL_GROUPS, POOL_GROUP, POOL_GROUP), f32) * POOL_GROUP ** -0.5,
        "pool_scale": 1.0 + 0.1 * n(ks[9], (DEPTH, D_POOL), f32),
        "w_pool_out": n(ks[10], (DEPTH, D_POOL, D_MODEL), f32) * D_POOL ** -0.5,
        "w_o": n(ks[11], (DEPTH, D_MODEL, D_MODEL), f32) * D_MODEL ** -0.5,
        "g_mix_pre": 1.0 + 0.05 * n(ks[12], (DEPTH, D_MODEL), f32),
        "g_mix_post": 1.0 + 0.05 * n(ks[13], (DEPTH, D_MODEL), f32),
        "w_up": n(ks[14], (DEPTH, D_MODEL, D_FF), f32) * D_MODEL ** -0.5,
        "w_down": n(ks[15], (DEPTH, D_FF, D_MODEL), f32) * D_FF ** -0.5,
        "g_ffn_pre": 1.0 + 0.05 * n(ks[16], (DEPTH, D_MODEL), f32),
        "g_ffn_post": 1.0 + 0.05 * n(ks[17], (DEPTH, D_MODEL), f32),
    }


def reference(x_prompt, x_sample, cache_conv, cache_pool, w_in, b_gate, conv_w, w_conv_out,
              pool_w, pool_scale, w_pool_out, w_o, g_mix_pre, g_mix_post,
              w_up, w_down, g_ffn_pre, g_ffn_post):
    weights = (w_in, b_gate, conv_w, w_conv_out, pool_w, pool_scale, w_pool_out, w_o,
               g_mix_pre, g_mix_post, w_up, w_down, g_ffn_pre, g_ffn_post)
    zero_conv = jnp.zeros((DEPTH, x_prompt.shape[0], CONV_W - 1, D_CONV), x_prompt.dtype)
    zero_pool = jnp.zeros((DEPTH, x_prompt.shape[0], POOL_HIST, D_POOL), x_prompt.dtype)
    y_prompt, conv_state_prompt, pool_state_prompt = run_trunk(
        x_prompt, zero_conv, zero_pool, 0, *weights)
    y_sample, conv_state_sample, pool_state_sample = run_trunk(
        x_sample, cache_conv, cache_pool, PAST_LEN, *weights)
    return (y_prompt, y_sample, conv_state_prompt, pool_state_prompt,
            conv_state_sample, pool_state_sample)
```

```cpp
#include <hip/hip_runtime.h>
#include <hip/hip_cooperative_groups.h>
#include <cstdio>
namespace cg = cooperative_groups;

#ifndef SKELETON
#define SKELETON 0
#endif
#ifndef STOP_AFTER
#define STOP_AFTER 99
#endif
#ifndef USE_CG_ONLY
#define USE_CG_ONLY 1
#endif

#define LAS __attribute__((address_space(3)))
typedef unsigned short bf16_t;
typedef short bf16x8 __attribute__((ext_vector_type(8)));
typedef float f32x4 __attribute__((ext_vector_type(4)));
typedef unsigned u32x4 __attribute__((ext_vector_type(4)));
typedef unsigned u32x2 __attribute__((ext_vector_type(2)));

constexpr int D = 1024, DIN = 6144, DFF = 4096, NL = 2;
constexpr int MP = 16384, MS = 128, MTOT = MP + MS, MPAD = 16640;
constexpr int SEQ_S = 16, NB_S = 8, PAST = 2048;
constexpr int BM = 256, BK = 64, HALF = 128, HTB = HALF * BK * 2, STAGE_BYTES = 8 * HTB, NXCD = 8, WGM = 8;
constexpr int LDS_BYTES = STAGE_BYTES + 64;
constexpr float EPS = 1e-6f;

constexpr size_t SLOT = (size_t)MPAD * 1024 * 2;
constexpr size_t WS_WIN = 6 * SLOT;
constexpr size_t WIN_BYTES = (size_t)DIN * D * 2;
constexpr size_t WL_WC = 0, WL_WP = 2097152, WL_WO = 4194304, WL_POOL = 6291456, WL_UP = 6815744, WL_DOWN = 15204352, WL_BYTES = 23592960;
constexpr size_t WS_WL = WS_WIN + WIN_BYTES;
constexpr size_t WS_BAR = WS_WL + NL * WL_BYTES;
constexpr size_t WS_END = WS_BAR + 16384;

constexpr size_t O_Y = 0, O_CSP = (size_t)MTOT * D, O_PSP = O_CSP + NL * 2 * D, O_CSS = O_PSP + NL * 15 * D, O_PSS = O_CSS + (size_t)NL * NB_S * 2 * D;

struct Params {
    const float* in[18];
    float* out;
    unsigned char* ws;
    int stop, pad;
};

__device__ __forceinline__ unsigned cvt_pk_bf16(float lo, float hi) { unsigned r; asm volatile("v_cvt_pk_bf16_f32 %0, %1, %2" : "=v"(r) : "v"(lo), "v"(hi)); return r; }
__device__ __forceinline__ float bf_lo(unsigned w) { return __uint_as_float(w << 16); }
__device__ __forceinline__ float bf_hi(unsigned w) { return __uint_as_float(w & 0xffff0000u); }
__device__ __forceinline__ void st8(bf16_t* p, f32x4 a, f32x4 b) {
    u32x4 w; w.x = cvt_pk_bf16(a[0], a[1]); w.y = cvt_pk_bf16(a[2], a[3]); w.z = cvt_pk_bf16(b[0], b[1]); w.w = cvt_pk_bf16(b[2], b[3]);
    *(u32x4*)p = w;
}
__device__ __forceinline__ void ld8(const bf16_t* p, f32x4& a, f32x4& b) {
    const u32x4 w = *(const u32x4*)p;
    a[0] = bf_lo(w.x); a[1] = bf_hi(w.x); a[2] = bf_lo(w.y); a[3] = bf_hi(w.y);
    b[0] = bf_lo(w.z); b[1] = bf_hi(w.z); b[2] = bf_lo(w.w); b[3] = bf_hi(w.w);
}
__device__ __forceinline__ float sigmoidf_(float x) { return 1.0f / (1.0f + __expf(-x)); }
__device__ __forceinline__ float wave_sum(float v) {
#pragma unroll
    for (int o = 1; o < 64; o <<= 1) v += __shfl_xor(v, o);
    return v;
}
#define LDS_WAIT() asm volatile("s_waitcnt lgkmcnt(0)" ::: "memory")

#define XB_TMO      128
#define XB_XCNT(j)  (256  + 64 * (j))
#define XB_XSUB(j)  (1280 + 64 * (j))
#define XB_XGEN(j)  (2304 + 64 * (j))
#define XB_TOP      3328
#define XB_TOPGEN   3392
#define XCD_BAR_WORDS 3456
#define XB_SPIN_CAP (1u << 18)
__device__ __forceinline__ unsigned xb_ld(unsigned* p)              { return __hip_atomic_load(p, __ATOMIC_RELAXED, __HIP_MEMORY_SCOPE_AGENT); }
__device__ __forceinline__ unsigned xb_add(unsigned* p, unsigned v) { return __hip_atomic_fetch_add(p, v, __ATOMIC_RELAXED, __HIP_MEMORY_SCOPE_AGENT); }
__device__ __forceinline__ unsigned xb_xcc_id() { return (unsigned)__builtin_amdgcn_s_getreg((3 << 11) | 20) & 0xFu; }
#define XB_SPIN(cond, bar) do { unsigned _sp = 0; while (cond) { __builtin_amdgcn_s_sleep(1); \
    if ((++_sp & 255u) == 0u) { if (xb_ld(&(bar)[XB_TMO])) break; if (_sp > XB_SPIN_CAP) { atomicAdd(&(bar)[XB_TMO], 1u); break; } } } } while (0)
struct XcdBarrier { unsigned* bar; unsigned x; volatile LAS unsigned* st; };
__device__ __forceinline__ XcdBarrier xcd_barrier_post(unsigned* bar, volatile LAS unsigned* st) {
    XcdBarrier b; b.bar = bar; b.x = xb_xcc_id(); b.st = st;
    if (threadIdx.x == 0) (void)xb_add(&bar[XB_XCNT(b.x)], 1u);
    return b;
}
__device__ __forceinline__ void xcd_barrier_complete(unsigned* bar, unsigned x, unsigned& nloc, unsigned& nx) {
    const unsigned G = gridDim.x * gridDim.y * gridDim.z;
    unsigned sum, cnt, mine, sp = 0u;
    for (;;) {
        sum = 0u; cnt = 0u; mine = 0u;
#pragma unroll
        for (unsigned j = 0; j < 16; ++j) { const unsigned c = xb_ld(&bar[XB_XCNT(j)]); sum += c; cnt += (c > 0u) ? 1u : 0u; mine = (j == x) ? c : mine; }
        if (sum == G) break;
        __builtin_amdgcn_s_sleep(1);
        if ((++sp & 255u) == 0u) { if (xb_ld(&bar[XB_TMO])) break; if (sp > XB_SPIN_CAP) { atomicAdd(&bar[XB_TMO], 1u); break; } }
    }
    nloc = mine > 0u ? mine : 1u; nx = cnt > 0u ? cnt : 1u;
}
__device__ __forceinline__ void xcd_barrier(const XcdBarrier& b) {
    asm volatile("s_waitcnt vmcnt(0)" ::: "memory");
    __syncthreads();
    if (threadIdx.x == 0) {
        unsigned* bar = b.bar;
        __builtin_amdgcn_s_waitcnt(0);
        unsigned nloc = b.st[0], nx = b.st[1];
        if (nloc == 0u) { xcd_barrier_complete(bar, b.x, nloc, nx); b.st[0] = nloc; b.st[1] = nx; }
        const unsigned old = xb_add(&bar[XB_XSUB(b.x)], 1u);
        const unsigned gen = old / nloc;
        if (old + 1u == (gen + 1u) * nloc) {
            __builtin_amdgcn_fence(__ATOMIC_RELEASE, "agent");
            asm volatile("s_waitcnt vmcnt(0)" ::: "memory");
            const unsigned og = xb_add(&bar[XB_TOP], 1u);
            const unsigned tg = og / nx;
            if (og + 1u == (tg + 1u) * nx) xb_add(&bar[XB_TOPGEN], 1u);
            else XB_SPIN(xb_ld(&bar[XB_TOPGEN]) == tg, bar);
            __builtin_amdgcn_fence(__ATOMIC_ACQUIRE, "agent");
            xb_add(&bar[XB_XGEN(b.x)], 1u);
            asm volatile("s_waitcnt vmcnt(0)" ::: "memory");
        } else {
            XB_SPIN(xb_ld(&bar[XB_XGEN(b.x)]) == gen, bar);
            __builtin_amdgcn_fence(__ATOMIC_ACQUIRE, "agent");
            asm volatile("s_waitcnt vmcnt(0)" ::: "memory");
        }
    }
    __syncthreads();
}

__device__ __forceinline__ int lds_byte(int r, int c) { const int st = (r >> 4) * 2 + (c >> 5), rr = r & 15, cc = c & 31, ob = rr * 64 + cc * 2; return st * 1024 + (ob ^ (((ob >> 9) & 1) << 5)); }
__device__ __forceinline__ void stage_rc(int b, int& R, int& C) { const int st = b / 1024, sb = b % 1024, swz = sb ^ (((sb >> 9) & 1) << 5); R = (st >> 1) * 16 + swz / 64; C = (st & 1) * 32 + (swz % 64) / 2; }
__device__ __forceinline__ int perm32(int rho) { const int n = rho >> 4, i = rho & 15; return 8 * (i >> 2) + 4 * n + (i & 3); }

struct Unit { int pm, pn; };
struct Gemm { const bf16_t* A; const bf16_t* Bt; int lda, ldb, K, nM, nN, a_pn_off; };
struct StaticOrder {
    int nM, nN, nwg, G, c;
    __device__ void init(int nM_, int nN_, int G_, int c_) { nM = nM_; nN = nN_; nwg = nM * nN; G = G_; c = c_; }
    __device__ bool next(int i, Unit& u) const {
        const long L = (long)i * G + c; if (L >= nwg) return false;
        int wgid = (int)L; { const int q = nwg / NXCD, r = nwg % NXCD, xcd = wgid % NXCD, off = wgid / NXCD; wgid = (xcd < r ? xcd * (q + 1) : r * (q + 1) + (xcd - r) * q) + off; }
        const int nig = WGM * nN, gid = wgid / nig, fm = gid * WGM, gsz = (nM - fm) < WGM ? (nM - fm) : WGM;
        u.pm = fm + ((wgid % nig) % gsz); u.pn = (wgid % nig) / gsz; return true;
    }
};

enum { E_PROJ = 0, E_SCALE = 1, E_GATE = 2, E_GATEADD = 3, E_PLAIN = 4, E_RELU2 = 5 };
struct Epi { int id, ldc; bf16_t* o0; const bf16_t* x0; const bf16_t* x1; const float* vec; unsigned char* ws; };

__device__ __forceinline__ void epilogue(const Epi& E, const f32x4 (&acc)[2][2][4][2], const Unit& u) {
    int tl = threadIdx.x; asm volatile("" : "+v"(tl));
    const int wv = tl >> 6, ln = tl & 63, wr = wv >> 2, wc = wv & 3, fr = ln & 15, fq = ln >> 4;
    const int row0 = u.pm * BM + wr * 64 + fr;
    const int colw = wc * 32 + 8 * fq;
    if (E.id == E_PROJ) {
        if (u.pn >= 4 && u.pn < 12) {
            const int ch = (u.pn - 4) * 128 + colw;
#pragma unroll
            for (int ai = 0; ai < 2; ++ai)
#pragma unroll
                for (int m = 0; m < 4; ++m) {
                    const size_t r = (size_t)(row0 + ai * HALF + m * 16);
                    st8((bf16_t*)(E.ws + 2 * SLOT) + r * D + ch, acc[ai][0][m][0] * acc[ai][1][m][0], acc[ai][0][m][1] * acc[ai][1][m][1]);
                }
        } else if (u.pn >= 16) {
            const int gc0 = (u.pn - 16) * BM;
            bf16_t* O = (bf16_t*)(E.ws + (gc0 < D ? 4 : 5) * SLOT);
            const int oc0 = gc0 & (D - 1);
#pragma unroll
            for (int bj = 0; bj < 2; ++bj) {
                const f32x4 b0 = *(const f32x4*)(E.vec + gc0 + bj * HALF + colw), b1 = *(const f32x4*)(E.vec + gc0 + bj * HALF + colw + 4);
#pragma unroll
                for (int ai = 0; ai < 2; ++ai)
#pragma unroll
                    for (int m = 0; m < 4; ++m) {
                        const size_t r = (size_t)(row0 + ai * HALF + m * 16);
                        f32x4 v0 = acc[ai][bj][m][0] + b0, v1 = acc[ai][bj][m][1] + b1;
#pragma unroll
                        for (int j = 0; j < 4; ++j) { v0[j] = sigmoidf_(v0[j]); v1[j] = sigmoidf_(v1[j]); }
                        st8(O + r * D + oc0 + bj * HALF + colw, v0, v1);
                    }
            }
        } else {
            bf16_t* O = (bf16_t*)(E.ws + (u.pn < 4 ? 1 : 3) * SLOT);
            const int oc0 = (u.pn & 3) * BM;
#pragma unroll
            for (int ai = 0; ai < 2; ++ai)
#pragma unroll
                for (int m = 0; m < 4; ++m) {
                    const size_t r = (size_t)(row0 + ai * HALF + m * 16);
#pragma unroll
                    for (int bj = 0; bj < 2; ++bj) st8(O + r * D + oc0 + bj * HALF + colw, acc[ai][bj][m][0], acc[ai][bj][m][1]);
                }
        }
        return;
    }
    const int col0 = u.pn * BM + colw;
    if (E.id == E_SCALE) {
#pragma unroll
        for (int bj = 0; bj < 2; ++bj) {
            const f32x4 s0 = *(const f32x4*)(E.vec + col0 + bj * HALF), s1 = *(const f32x4*)(E.vec + col0 + bj * HALF + 4);
#pragma unroll
            for (int ai = 0; ai < 2; ++ai)
#pragma unroll
                for (int m = 0; m < 4; ++m) {
                    const size_t r = (size_t)(row0 + ai * HALF + m * 16);
                    st8(E.o0 + r * E.ldc + col0 + bj * HALF, acc[ai][bj][m][0] * s0, acc[ai][bj][m][1] * s1);
                }
        }
    } else if (E.id == E_GATE) {
#pragma unroll
        for (int ai = 0; ai < 2; ++ai)
#pragma unroll
            for (int m = 0; m < 4; ++m) {
                const size_t r = (size_t)(row0 + ai * HALF + m * 16);
#pragma unroll
                for (int bj = 0; bj < 2; ++bj) {
                    f32x4 g0, g1; ld8(E.x0 + r * D + col0 + bj * HALF, g0, g1);
                    st8(E.o0 + r * E.ldc + col0 + bj * HALF, acc[ai][bj][m][0] * g0, acc[ai][bj][m][1] * g1);
                }
                if (m == 3) asm volatile("" ::: "memory");
            }
    } else if (E.id == E_GATEADD) {
#pragma unroll
        for (int ai = 0; ai < 2; ++ai)
#pragma unroll
            for (int m = 0; m < 4; ++m) {
                const size_t r = (size_t)(row0 + ai * HALF + m * 16);
#pragma unroll
                for (int bj = 0; bj < 2; ++bj) {
                    f32x4 g0, g1, a0, a1; ld8(E.x0 + r * D + col0 + bj * HALF, g0, g1); ld8(E.x1 + r * D + col0 + bj * HALF, a0, a1);
                    st8(E.o0 + r * E.ldc + col0 + bj * HALF, a0 + acc[ai][bj][m][0] * g0, a1 + acc[ai][bj][m][1] * g1);
                }
                if (m & 1) asm volatile("" ::: "memory");
            }
    } else if (E.id == E_RELU2) {
#pragma unroll
        for (int ai = 0; ai < 2; ++ai)
#pragma unroll
            for (int m = 0; m < 4; ++m) {
                const size_t r = (size_t)(row0 + ai * HALF + m * 16);
#pragma unroll
                for (int bj = 0; bj < 2; ++bj) {
                    f32x4 v0 = acc[ai][bj][m][0], v1 = acc[ai][bj][m][1];
#pragma unroll
                    for (int j = 0; j < 4; ++j) { const float a = fmaxf(v0[j], 0.f), b = fmaxf(v1[j], 0.f); v0[j] = a * a; v1[j] = b * b; }
                    st8(E.o0 + r * E.ldc + col0 + bj * HALF, v0, v1);
                }
            }
    } else {
#pragma unroll
        for (int ai = 0; ai < 2; ++ai)
#pragma unroll
            for (int m = 0; m < 4; ++m) {
                const size_t r = (size_t)(row0 + ai * HALF + m * 16);
#pragma unroll
                for (int bj = 0; bj < 2; ++bj) st8(E.o0 + r * E.ldc + col0 + bj * HALF, acc[ai][bj][m][0], acc[ai][bj][m][1]);
            }
    }
}

__device__ __forceinline__ void gemm_phase(LAS unsigned char* lds, const Gemm g, const StaticOrder& S, const Epi& E) {
    const int tid = threadIdx.x, wid = __builtin_amdgcn_readfirstlane(tid >> 6), lane = tid & 63, wr = wid >> 2, wc = wid & 3, fr = lane & 15, fq = lane >> 4;
    const int nt = g.K / BK;
    unsigned voffA[2], voffB[2];
#pragma unroll
    for (int i = 0; i < 2; ++i) { int R, C; stage_rc(tid * 16 + i * 8192, R, C); const int Rb = (R & ~31) + perm32(R & 31);
        voffA[i] = (unsigned)(R * g.lda + C) * 2u; voffB[i] = (unsigned)(Rb * g.ldb + C) * 2u; }
    const size_t kstep = (size_t)(BK * 2);
    const size_t hstepA = (size_t)HALF * g.lda * 2, hstepB = (size_t)HALF * g.ldb * 2;
    const size_t tstepA = 2 * hstepA, tstepB = 2 * hstepB;
    const size_t pnoffA = (size_t)g.a_pn_off * 2;
    const unsigned ldsw = (unsigned)wid * 1024u;
    const int aoff = lds_byte(wr * 64 + fr, fq * 8), boff = lds_byte(wc * 32 + fr, fq * 8);
#define PG8_SA(b, h) (((b) * 2 + (h)) * HTB)
#define PG8_SB(b, h) ((4 + (b) * 2 + (h)) * HTB)
#define PG8_STAGE(bufoff, gbase, voff) do { _Pragma("unroll") for (int _i = 0; _i < 2; ++_i) \
        __builtin_amdgcn_global_load_lds((const unsigned*)((const char*)(gbase) + (voff)[_i]), (LAS unsigned*)(lds + (bufoff) + ldsw + _i * 8192), 16, 0, 0); } while (0)
#define PG8_LDA(dst, b, h) do { _Pragma("unroll") for (int m = 0; m < 4; ++m) _Pragma("unroll") for (int k = 0; k < 2; ++k) dst[m][k] = *(const LAS bf16x8*)(lds + PG8_SA(b, h) + aoff + m * 2048 + k * 1024); } while (0)
#define PG8_LDB(dst, b, h) do { _Pragma("unroll") for (int n = 0; n < 2; ++n) _Pragma("unroll") for (int k = 0; k < 2; ++k) dst[n][k] = *(const LAS bf16x8*)(lds + PG8_SB(b, h) + boff + n * 2048 + k * 1024); } while (0)
#define PG8_MMA(ai, bj, At, Bt) do { __builtin_amdgcn_s_setprio(1); _Pragma("unroll") for (int m = 0; m < 4; ++m) _Pragma("unroll") for (int n = 0; n < 2; ++n) _Pragma("unroll") for (int k = 0; k < 2; ++k) \
        acc[ai][bj][m][n] = __builtin_amdgcn_mfma_f32_16x16x32_bf16(Bt[n][k], At[m][k], acc[ai][bj][m][n], 0, 0, 0); __builtin_amdgcn_s_setprio(0); } while (0)
#define PG8_WAIT_V(n) asm volatile("s_waitcnt vmcnt(" #n ")" ::: "memory")
#define PG8_WAIT_L(n) asm volatile("s_waitcnt lgkmcnt(" #n ")" ::: "memory")
#define PG8_BAR __builtin_amdgcn_s_barrier()
#define PG8_SCHED __builtin_amdgcn_sched_barrier(0)
    Unit cur, nxt; int ui = 0;
    if (!S.next(0, cur)) return;
    f32x4 acc[2][2][4][2];
#pragma unroll
    for (int a = 0; a < 2; ++a)
#pragma unroll
        for (int b = 0; b < 2; ++b)
#pragma unroll
            for (int m = 0; m < 4; ++m)
#pragma unroll
                for (int n = 0; n < 2; ++n) acc[a][b][m][n] = (f32x4){0.f, 0.f, 0.f, 0.f};
    bf16x8 At[4][2], B0[2][2], B1[2][2];
    const char* cA = (const char*)g.A + (size_t)cur.pm * tstepA + (size_t)cur.pn * pnoffA; const char* cB = (const char*)g.Bt + (size_t)cur.pn * tstepB;
    PG8_STAGE(PG8_SB(0, 0), cB, voffB); PG8_STAGE(PG8_SA(0, 0), cA, voffA); PG8_STAGE(PG8_SB(0, 1), cB + hstepB, voffB); PG8_STAGE(PG8_SA(0, 1), cA + hstepA, voffA);
    if (wr == 1) PG8_BAR;
    PG8_WAIT_V(4); PG8_BAR;
    PG8_STAGE(PG8_SB(1, 0), cB + kstep, voffB); PG8_STAGE(PG8_SA(1, 0), cA + kstep, voffA); PG8_STAGE(PG8_SB(1, 1), cB + hstepB + kstep, voffB);
    PG8_WAIT_V(6); PG8_BAR;
    for (;;) {
        const bool has_next = S.next(ui + 1, nxt);
        const char* nA = has_next ? (const char*)g.A + (size_t)nxt.pm * tstepA + (size_t)nxt.pn * pnoffA : cA; const char* nB = has_next ? (const char*)g.Bt + (size_t)nxt.pn * tstepB : cB;
        for (int t = 0; t < nt; t += 2) {
            const bool last = (t == nt - 2);
            const char* a1 = cA + (size_t)(t + 1) * kstep;
            const char* a2 = last ? nA : cA + (size_t)(t + 2) * kstep; const char* b2 = last ? nB : cB + (size_t)(t + 2) * kstep;
            const char* a3 = a2 + kstep; const char* b3 = b2 + kstep;
            PG8_LDB(B0, 0, 0); PG8_SCHED; PG8_LDA(At, 0, 0); PG8_STAGE(PG8_SA(1, 1), a1 + hstepA, voffA);
            PG8_WAIT_L(8); PG8_BAR; PG8_WAIT_L(0); PG8_MMA(0, 0, At, B0); PG8_BAR; PG8_SCHED;
            PG8_LDB(B1, 0, 1); PG8_STAGE(PG8_SB(0, 0), b2, voffB);
            PG8_BAR; PG8_WAIT_L(0); PG8_MMA(0, 1, At, B1); PG8_BAR;
            PG8_LDA(At, 0, 1); PG8_STAGE(PG8_SA(0, 0), a2, voffA);
            PG8_BAR; PG8_WAIT_L(0); PG8_MMA(1, 0, At, B0); PG8_BAR; PG8_SCHED;
            PG8_STAGE(PG8_SB(0, 1), b2 + hstepB, voffB);
            PG8_WAIT_V(6); PG8_BAR; PG8_MMA(1, 1, At, B1); PG8_BAR;
            PG8_LDB(B0, 1, 0); PG8_SCHED; PG8_LDA(At, 1, 0); PG8_STAGE(PG8_SA(0, 1), a2 + hstepA, voffA);
            PG8_WAIT_L(8); PG8_BAR; PG8_WAIT_L(0); PG8_MMA(0, 0, At, B0); PG8_BAR; PG8_SCHED;
            PG8_LDB(B1, 1, 1); PG8_STAGE(PG8_SB(1, 0), b3, voffB);
            PG8_BAR; PG8_WAIT_L(0); PG8_MMA(0, 1, At, B1); PG8_BAR;
            PG8_LDA(At, 1, 1); PG8_STAGE(PG8_SA(1, 0), a3, voffA);
            PG8_BAR; PG8_WAIT_L(0); PG8_MMA(1, 0, At, B0); PG8_BAR; PG8_SCHED;
            PG8_STAGE(PG8_SB(1, 1), b3 + hstepB, voffB);
            PG8_WAIT_V(6); PG8_BAR; PG8_MMA(1, 1, At, B1); PG8_BAR;
        }
        epilogue(E, acc, cur);
        if (!has_next) break;
#pragma unroll
        for (int a = 0; a < 2; ++a)
#pragma unroll
            for (int b = 0; b < 2; ++b)
#pragma unroll
                for (int m = 0; m < 4; ++m)
#pragma unroll
                    for (int n = 0; n < 2; ++n) acc[a][b][m][n] = (f32x4){0.f, 0.f, 0.f, 0.f};
        cur = nxt; cA = nA; cB = nB; ++ui;
    }
    PG8_WAIT_V(0);
    if (wr == 0) PG8_BAR;
    PG8_BAR;
#undef PG8_SA
#undef PG8_SB
#undef PG8_STAGE
#undef PG8_LDA
#undef PG8_LDB
#undef PG8_MMA
#undef PG8_WAIT_V
#undef PG8_WAIT_L
#undef PG8_BAR
#undef PG8_SCHED
}

__device__ __forceinline__ int win_dst_row(int n0) {
    if (n0 < D || n0 >= 3 * D) return n0;
    const int isv = n0 >= 2 * D, ch = n0 - (isv ? 2 * D : D);
    return D + (ch >> 7) * 256 + isv * 128 + (ch & 127);
}
__device__ __forceinline__ void transpose_item(const float* W, int K, int N, bf16_t* WT, int wperm, LAS float* scr, int item, int lane) {
    const int nblk = N / 32, kb = item / nblk, nb = item % nblk, k0 = 64 * kb, n0 = 32 * nb;
#pragma unroll 8
    for (int i = 0; i < 32; ++i) { const int kk = 2 * i + (lane >> 5); scr[kk * 33 + (lane & 31)] = W[(size_t)(k0 + kk) * N + n0 + (lane & 31)]; }
    LDS_WAIT(); asm volatile("" ::: "memory");
    const int c = lane & 7;
    const int drow0 = wperm ? win_dst_row(n0) : n0;
#pragma unroll
    for (int j = 0; j < 4; ++j) { const int n = (lane >> 3) + 8 * j; const LAS float* s = scr + (8 * c) * 33 + n;
        u32x4 o; o.x = cvt_pk_bf16(s[0 * 33], s[1 * 33]); o.y = cvt_pk_bf16(s[2 * 33], s[3 * 33]); o.z = cvt_pk_bf16(s[4 * 33], s[5 * 33]); o.w = cvt_pk_bf16(s[6 * 33], s[7 * 33]);
        *(u32x4*)(WT + (size_t)(drow0 + n) * K + k0 + 8 * c) = o; }
    LDS_WAIT(); asm volatile("" ::: "memory");
}
__device__ __forceinline__ void transpose_matrix(const float* W, int K, int N, bf16_t* WT, int wperm, LAS float* scr, int gw, int NGW, int lane, int& off) {
    const int nitems = (K / 64) * (N / 32);
    int start = gw - (off % NGW); if (start < 0) start += NGW;
    for (int it = start; it < nitems; it += NGW) transpose_item(W, K, N, WT, wperm, scr, it, lane);
    off += nitems;
}

__global__ void __launch_bounds__(512, 2) fwd_megakernel(Params p) {
    extern __shared__ __attribute__((aligned(16))) unsigned char shm[];
    LAS unsigned char* lds = (LAS unsigned char*)shm;
    cg::grid_group grid = cg::this_grid();
    const int tid = threadIdx.x;
    const int G = (int)gridDim.x, NGW = G * 8;
    unsigned char* ws = p.ws;
    bf16_t* S0 = (bf16_t*)(ws + 0 * SLOT); bf16_t* S1 = (bf16_t*)(ws + 1 * SLOT); bf16_t* S2 = (bf16_t*)(ws + 2 * SLOT);
    bf16_t* S3 = (bf16_t*)(ws + 3 * SLOT); bf16_t* S4 = (bf16_t*)(ws + 4 * SLOT); bf16_t* S5 = (bf16_t*)(ws + 5 * SLOT);
    bf16_t* WIN = (bf16_t*)(ws + WS_WIN);
    float* X = p.out + O_Y;

#if !USE_CG_ONLY
    volatile LAS unsigned* xbst = (volatile LAS unsigned*)(lds + STAGE_BYTES);
    if (tid == 0) { xbst[0] = 0u; xbst[1] = 0u; xbst[2] = 0u; xbst[3] = 0u; }
    __syncthreads();
    XcdBarrier xb = xcd_barrier_post((unsigned*)(ws + WS_BAR), xbst);
#define GRID_BAR() xcd_barrier(xb)
#else
#define GRID_BAR() grid.sync()
#endif

    if (!SKELETON) {
        const int lane = tid & 63, wid = tid >> 6, gw = (int)blockIdx.x * 8 + wid;
        LAS float* scr = (LAS float*)(lds + wid * 16384);
        int off = 0;
        transpose_matrix(p.in[4], D, DIN, WIN, 1, scr, gw, NGW, lane, off);
        for (int l = 0; l < NL; ++l) {
            unsigned char* wl = ws + WS_WL + (size_t)l * WL_BYTES;
            transpose_matrix(p.in[7] + (size_t)l * D * D, D, D, (bf16_t*)(wl + WL_WC), 0, scr, gw, NGW, lane, off);
            transpose_matrix(p.in[10] + (size_t)l * D * D, D, D, (bf16_t*)(wl + WL_WP), 0, scr, gw, NGW, lane, off);
            transpose_matrix(p.in[11] + (size_t)l * D * D, D, D, (bf16_t*)(wl + WL_WO), 0, scr, gw, NGW, lane, off);
            for (int gi = 0; gi < 4; ++gi)
                transpose_matrix(p.in[8] + (size_t)l * 4 * 65536 + (size_t)gi * 65536, 256, 256, (bf16_t*)(wl + WL_POOL) + (size_t)gi * 65536, 0, scr, gw, NGW, lane, off);
            transpose_matrix(p.in[14] + (size_t)l * D * DFF, D, DFF, (bf16_t*)(wl + WL_UP), 0, scr, gw, NGW, lane, off);
            transpose_matrix(p.in[15] + (size_t)l * DFF * D, DFF, D, (bf16_t*)(wl + WL_DOWN), 0, scr, gw, NGW, lane, off);
        }
        for (int i = (int)blockIdx.x * 512 + tid; i < (MPAD - MTOT) * D / 8; i += G * 512) *(u32x4*)(S0 + (size_t)MTOT * D + (size_t)i * 8) = (u32x4){0u, 0u, 0u, 0u};
        const float* gpre = p.in[12];
        f32x4 gv[4];
#pragma unroll
        for (int j = 0; j < 4; ++j) gv[j] = *(const f32x4*)(gpre + lane * 4 + 256 * j);
        for (int r = gw; r < MTOT; r += NGW) {
            const float* xr = r < MP ? p.in[0] + (size_t)r * D : p.in[1] + (size_t)(r - MP) * D;
            f32x4 v[4]; float s = 0.f;
#pragma unroll
            for (int j = 0; j < 4; ++j) { v[j] = *(const f32x4*)(xr + lane * 4 + 256 * j); s += (v[j][0] * v[j][0] + v[j][1] * v[j][1]) + (v[j][2] * v[j][2] + v[j][3] * v[j][3]); }
            const float rs = rsqrtf(wave_sum(s) * (1.f / D) + EPS);
#pragma unroll
            for (int j = 0; j < 4; ++j) { u32x2 o; o.x = cvt_pk_bf16(v[j][0] * rs * gv[j][0], v[j][1] * rs * gv[j][1]); o.y = cvt_pk_bf16(v[j][2] * rs * gv[j][2], v[j][3] * rs * gv[j][3]);
                *(u32x2*)(S0 + (size_t)r * D + lane * 4 + 256 * j) = o; }
        }
    }
    grid.sync();

    for (int step = 0; step < NL * 10; ++step) {
        const int l = step / 10, ph = step - l * 10;
        int tid_s = threadIdx.x; asm volatile("" : "+v"(tid_s));
        const int lane = tid_s & 63, wid = tid_s >> 6, gw = (int)blockIdx.x * 8 + wid;
        unsigned char* wl = ws + WS_WL + (size_t)l * WL_BYTES;
        Gemm g{S0, WIN, D, D, D, MPAD / BM, D / BM, 0};
        Epi E{E_PLAIN, D, S1, nullptr, nullptr, nullptr, ws};
        bool is_gemm = true;
        switch (ph) {
        case 0:
            g.nN = DIN / BM; E.id = E_PROJ; E.vec = p.in[5] + (size_t)l * 2 * D; break;
        case 2:
            g.Bt = (const bf16_t*)(wl + WL_POOL); g.ldb = 256; g.K = 256; g.nN = 4; g.a_pn_off = 256;
            E.id = E_SCALE; E.o0 = S2; E.vec = p.in[9] + (size_t)l * D; break;
        case 3:
            g.A = S1; g.Bt = (const bf16_t*)(wl + WL_WC); E.id = E_GATE; E.o0 = S3; E.x0 = S4; break;
        case 4:
            g.A = S2; g.Bt = (const bf16_t*)(wl + WL_WP); E.id = E_GATEADD; E.o0 = S0; E.x0 = S5; E.x1 = S3; break;
        case 5:
            g.Bt = (const bf16_t*)(wl + WL_WO); break;
        case 7:
            g.Bt = (const bf16_t*)(wl + WL_UP); g.nN = DFF / BM; E.id = E_RELU2; E.ldc = DFF; break;
        case 8:
            g.A = S1; g.Bt = (const bf16_t*)(wl + WL_DOWN); g.lda = DFF; g.ldb = DFF; g.K = DFF; E.o0 = S5; break;
        default: is_gemm = false; break;
        }
        if (SKELETON || step > p.stop) { if (step == 0 && blockIdx.x == 0 && tid == 0) p.out[0] = 1.f; }
        else if (is_gemm) {
            StaticOrder S; S.init(g.nM, g.nN, G, (int)blockIdx.x);
            gemm_phase(lds, g, S, E);
        } else if (ph == 1) {
            const float* cw = p.in[6] + (size_t)l * 3 * D;
            const float* cconv = p.in[2] + (size_t)l * NB_S * 2 * D;
            const float* cpool = p.in[3] + (size_t)l * NB_S * 15 * D;
            float* o_csp = p.out + O_CSP + (size_t)l * 2 * D;
            float* o_psp = p.out + O_PSP + (size_t)l * 15 * D;
            float* o_css = p.out + O_CSS + (size_t)l * NB_S * 2 * D;
            float* o_pss = p.out + O_PSS + (size_t)l * NB_S * 15 * D;
            for (int it = gw; it < (MTOT / 2) * 4; it += NGW) {
                const int gi = it & 3, r = (it >> 2) * 2 + (lane >> 5), ch = gi * 256 + (lane & 31) * 8;
                const bool smp = r >= MP;
                const int sb = smp ? (r - MP) >> 4 : 0, t = smp ? (r - MP) & 15 : r;
                f32x4 b0, b1, z0a, z0b, z1a, z1b, z2a, z2b, p0a, p0b;
                ld8(S1 + (size_t)r * D + ch, b0, b1);
                ld8(S2 + (size_t)r * D + ch, z0a, z0b);
                ld8(S3 + (size_t)r * D + ch, p0a, p0b);
                if (t >= 1) ld8(S2 + (size_t)(r - 1) * D + ch, z1a, z1b);
                else if (smp) { const float* q = cconv + ((size_t)sb * 2 + 1) * D + ch; z1a = *(const f32x4*)q; z1b = *(const f32x4*)(q + 4); }
                else { z1a = (f32x4){0.f, 0.f, 0.f, 0.f}; z1b = z1a; }
                if (t >= 2) ld8(S2 + (size_t)(r - 2) * D + ch, z2a, z2b);
                else if (smp) { const float* q = cconv + ((size_t)sb * 2 + t) * D + ch; z2a = *(const f32x4*)q; z2b = *(const f32x4*)(q + 4); }
                else { z2a = (f32x4){0.f, 0.f, 0.f, 0.f}; z2b = z2a; }
                const f32x4 w0a = *(const f32x4*)(cw + ch), w0b = *(const f32x4*)(cw + ch + 4);
                const f32x4 w1a = *(const f32x4*)(cw + D + ch), w1b = *(const f32x4*)(cw + D + ch + 4);
                const f32x4 w2a = *(const f32x4*)(cw + 2 * D + ch), w2b = *(const f32x4*)(cw + 2 * D + ch + 4);
                const f32x4 ya0 = b0 * (w0a * z2a + w1a * z1a + w2a * z0a), ya1 = b1 * (w0b * z2b + w1b * z1b + w2b * z0b);
                const int w = 2 << gi;
                f32x4 sa = p0a, sb2 = p0b;
                for (int i = 1; i < w; ++i) {
                    f32x4 qa, qb;
                    if (t - i >= 0) ld8(S3 + (size_t)(r - i) * D + ch, qa, qb);
                    else if (smp) { const float* q = cpool + ((size_t)sb * 15 + (15 + t - i)) * D + ch; qa = *(const f32x4*)q; qb = *(const f32x4*)(q + 4); }
                    else { qa = (f32x4){0.f, 0.f, 0.f, 0.f}; qb = qa; }
                    sa += qa; sb2 += qb;
                }
                const int cnt = smp ? w : (t + 1 < w ? t + 1 : w);
                const float ic = 1.0f / (float)cnt;
                st8(S1 + (size_t)r * D + ch, ya0, ya1);
                st8(S0 + (size_t)r * D + ch, sa * ic - p0a, sb2 * ic - p0b);
                if (!smp) {
                    if (t >= MP - 2) { float* o = o_csp + (size_t)(t - (MP - 2)) * D + ch; *(f32x4*)o = z0a; *(f32x4*)(o + 4) = z0b; }
                    if (t >= MP - 15) { float* o = o_psp + (size_t)(t - (MP - 15)) * D + ch; *(f32x4*)o = p0a; *(f32x4*)(o + 4) = p0b; }
                } else {
                    if (t >= SEQ_S - 2) { float* o = o_css + ((size_t)sb * 2 + (t - (SEQ_S - 2))) * D + ch; *(f32x4*)o = z0a; *(f32x4*)(o + 4) = z0b; }
                    if (t >= 1) { float* o = o_pss + ((size_t)sb * 15 + (t - 1)) * D + ch; *(f32x4*)o = p0a; *(f32x4*)(o + 4) = p0b; }
                }
            }
            if (l + 1 < NL) {
                LAS float* scr = (LAS float*)(lds + wid * 16384);
                int off = 0;
                transpose_matrix(p.in[4] + (size_t)(l + 1) * D * DIN, D, DIN, WIN, 1, scr, gw, NGW, lane, off);
            }
        } else {
            const int half = ph == 6 ? 0 : 1;
            const bf16_t* Y = half == 0 ? S1 : S5;
            const float* gpost = (half == 0 ? p.in[13] : p.in[17]) + (size_t)l * D;
            const bool has_next = true;
            const float* gnext = half == 0 ? p.in[16] + (size_t)l * D : p.in[12] + (size_t)(l + 1 < NL ? l + 1 : l) * D;
            const bool from_input = (l == 0 && half == 0);
            f32x4 gp[4], gn[4];
#pragma unroll
            for (int j = 0; j < 4; ++j) { gp[j] = *(const f32x4*)(gpost + lane * 4 + 256 * j); gn[j] = *(const f32x4*)(gnext + lane * 4 + 256 * j); }
            for (int r = gw; r < MTOT; r += NGW) {
                const float* xr = from_input ? (r < MP ? p.in[0] + (size_t)r * D : p.in[1] + (size_t)(r - MP) * D) : X + (size_t)r * D;
                f32x4 xv[4], yv[4]; float s = 0.f;
#pragma unroll
                for (int j = 0; j < 4; ++j) {
                    xv[j] = *(const f32x4*)(xr + lane * 4 + 256 * j);
                    const u32x2 wv = *(const u32x2*)(Y + (size_t)r * D + lane * 4 + 256 * j);
                    yv[j][0] = bf_lo(wv.x); yv[j][1] = bf_hi(wv.x); yv[j][2] = bf_lo(wv.y); yv[j][3] = bf_hi(wv.y);
                    s += (yv[j][0] * yv[j][0] + yv[j][1] * yv[j][1]) + (yv[j][2] * yv[j][2] + yv[j][3] * yv[j][3]);
                }
                const float rs = rsqrtf(wave_sum(s) * (1.f / D) + EPS);
                float s2 = 0.f;
#pragma unroll
                for (int j = 0; j < 4; ++j) { xv[j] = xv[j] + yv[j] * rs * gp[j]; s2 += (xv[j][0] * xv[j][0] + xv[j][1] * xv[j][1]) + (xv[j][2] * xv[j][2] + xv[j][3] * xv[j][3]);
                    *(f32x4*)(X + (size_t)r * D + lane * 4 + 256 * j) = xv[j]; }
                if (has_next) {
                    const float rs2 = rsqrtf(wave_sum(s2) * (1.f / D) + EPS);
#pragma unroll
                    for (int j = 0; j < 4; ++j) { u32x2 o; o.x = cvt_pk_bf16(xv[j][0] * rs2 * gn[j][0], xv[j][1] * rs2 * gn[j][1]); o.y = cvt_pk_bf16(xv[j][2] * rs2 * gn[j][2], xv[j][3] * rs2 * gn[j][3]);
                        *(u32x2*)(S0 + (size_t)r * D + lane * 4 + 256 * j) = o; }
                }
            }
        }
        if (step + 1 < NL * 10) GRID_BAR();
    }
}

extern "C" void kernel_launch(void* const* d_in, const int* in_sizes, int n_in, void* d_out, int out_size, void* d_ws, size_t ws_size, hipStream_t stream) {
    static int grid = 0;
    if (grid == 0) {
        if (n_in != 18 || ws_size < WS_END) { fprintf(stderr, "kernel_launch: unexpected n_in %d or ws_size %zu (< %zu)\n", n_in, ws_size, (size_t)WS_END); grid = -1; return; }
        int dev = 0, cus = 0, per_cu = 0;
        hipGetDevice(&dev);
        hipDeviceGetAttribute(&cus, hipDeviceAttributeMultiprocessorCount, dev);
        if (hipFuncSetAttribute((const void*)fwd_megakernel, hipFuncAttributeMaxDynamicSharedMemorySize, LDS_BYTES) != hipSuccess) { fprintf(stderr, "kernel_launch: hipFuncSetAttribute failed\n"); grid = -1; return; }
        if (hipOccupancyMaxActiveBlocksPerMultiprocessor(&per_cu, (const void*)fwd_megakernel, 512, LDS_BYTES) != hipSuccess || per_cu < 1) { fprintf(stderr, "kernel_launch: occupancy query failed (%d)\n", per_cu); grid = -1; return; }
        grid = cus * per_cu;
    }
    if (grid < 0) return;
    (void)hipMemsetAsync((unsigned char*)d_ws + WS_BAR, 0, 16384, stream);
    Params p{};
    for (int i = 0; i < 18; ++i) p.in[i] = (const float*)d_in[i];
    p.out = (float*)d_out; p.ws = (unsigned char*)d_ws; p.stop = STOP_AFTER;
    void* args[] = {&p};
    hipError_t e = hipLaunchCooperativeKernel((const void*)fwd_megakernel, dim3(grid), dim3(512), args, LDS_BYTES, stream);
    if (e != hipSuccess) fprintf(stderr, "cooperative launch failed: %s (grid %d)\n", hipGetErrorString(e), grid);
}
```

```cpp
#include <hip/hip_runtime.h>
#include <hip/hip_cooperative_groups.h>
#include <cstdio>
namespace cg = cooperative_groups;

#ifndef SKELETON
#define SKELETON 0
#endif
#ifndef STOP_AFTER
#define STOP_AFTER 99
#endif
#ifndef USE_CG_ONLY
#define USE_CG_ONLY 0
#endif

#define LAS __attribute__((address_space(3)))
typedef unsigned short bf16_t;
typedef short bf16x8 __attribute__((ext_vector_type(8)));
typedef float f32x4 __attribute__((ext_vector_type(4)));
typedef unsigned u32x4 __attribute__((ext_vector_type(4)));
typedef unsigned u32x2 __attribute__((ext_vector_type(2)));

constexpr int D = 1024, DIN = 6144, DFF = 4096, NL = 2;
constexpr int MP = 16384, MS = 128, MTOT = MP + MS, MPAD = 16640;
constexpr int SEQ_S = 16, NB_S = 8, PAST = 2048;
constexpr int BM = 256, BK = 64, HALF = 128, HTB = HALF * BK * 2, STAGE_BYTES = 8 * HTB, NXCD = 8, WGM = 8;
constexpr int LDS_BYTES = STAGE_BYTES + 64;
constexpr float EPS = 1e-6f;

constexpr size_t SLOT = (size_t)MPAD * 1024 * 2;
constexpr size_t WS_WIN = 6 * SLOT;
constexpr size_t WIN_BYTES = (size_t)DIN * D * 2;
constexpr size_t WL_WC = 0, WL_WP = 2097152, WL_WO = 4194304, WL_POOL = 6291456, WL_UP = 6815744, WL_DOWN = 15204352, WL_BYTES = 23592960;
constexpr size_t WS_WL = WS_WIN + WIN_BYTES;
constexpr size_t WS_BAR = WS_WL + NL * WL_BYTES;
constexpr size_t WS_END = WS_BAR + 16384;

constexpr size_t O_Y = 0, O_CSP = (size_t)MTOT * D, O_PSP = O_CSP + NL * 2 * D, O_CSS = O_PSP + NL * 15 * D, O_PSS = O_CSS + (size_t)NL * NB_S * 2 * D;

struct Params {
    const float* in[18];
    float* out;
    unsigned char* ws;
    int stop, pad;
};

__device__ __forceinline__ unsigned cvt_pk_bf16(float lo, float hi) { unsigned r; asm volatile("v_cvt_pk_bf16_f32 %0, %1, %2" : "=v"(r) : "v"(lo), "v"(hi)); return r; }
__device__ __forceinline__ float bf_lo(unsigned w) { return __uint_as_float(w << 16); }
__device__ __forceinline__ float bf_hi(unsigned w) { return __uint_as_float(w & 0xffff0000u); }
__device__ __forceinline__ void st8(bf16_t* p, f32x4 a, f32x4 b) {
    u32x4 w; w.x = cvt_pk_bf16(a[0], a[1]); w.y = cvt_pk_bf16(a[2], a[3]); w.z = cvt_pk_bf16(b[0], b[1]); w.w = cvt_pk_bf16(b[2], b[3]);
    *(u32x4*)p = w;
}
__device__ __forceinline__ void ld8(const bf16_t* p, f32x4& a, f32x4& b) {
    const u32x4 w = *(const u32x4*)p;
    a[0] = bf_lo(w.x); a[1] = bf_hi(w.x); a[2] = bf_lo(w.y); a[3] = bf_hi(w.y);
    b[0] = bf_lo(w.z); b[1] = bf_hi(w.z); b[2] = bf_lo(w.w); b[3] = bf_hi(w.w);
}
__device__ __forceinline__ float sigmoidf_(float x) { return 1.0f / (1.0f + __expf(-x)); }
__device__ __forceinline__ float wave_sum(float v) {
#pragma unroll
    for (int o = 1; o < 64; o <<= 1) v += __shfl_xor(v, o);
    return v;
}
#define LDS_WAIT() asm volatile("s_waitcnt lgkmcnt(0)" ::: "memory")

#define XB_TMO      128
#define XB_XCNT(j)  (256  + 64 * (j))
#define XB_XSUB(j)  (1280 + 64 * (j))
#define XB_XGEN(j)  (2304 + 64 * (j))
#define XB_TOP      3328
#define XB_TOPGEN   3392
#define XCD_BAR_WORDS 3456
#define XB_SPIN_CAP (1u << 18)
__device__ __forceinline__ unsigned xb_ld(unsigned* p)              { return __hip_atomic_load(p, __ATOMIC_RELAXED, __HIP_MEMORY_SCOPE_AGENT); }
__device__ __forceinline__ unsigned xb_add(unsigned* p, unsigned v) { return __hip_atomic_fetch_add(p, v, __ATOMIC_RELAXED, __HIP_MEMORY_SCOPE_AGENT); }
__device__ __forceinline__ unsigned xb_xcc_id() { return (unsigned)__builtin_amdgcn_s_getreg((3 << 11) | 20) & 0xFu; }
#define XB_SPIN(cond, bar) do { unsigned _sp = 0; while (cond) { __builtin_amdgcn_s_sleep(1); \
    if ((++_sp & 255u) == 0u) { if (xb_ld(&(bar)[XB_TMO])) break; if (_sp > XB_SPIN_CAP) { atomicAdd(&(bar)[XB_TMO], 1u); break; } } } } while (0)
struct XcdBarrier { unsigned* bar; unsigned x; volatile LAS unsigned* st; };
__device__ __forceinline__ XcdBarrier xcd_barrier_post(unsigned* bar, volatile LAS unsigned* st) {
    XcdBarrier b; b.bar = bar; b.x = xb_xcc_id(); b.st = st;
    if (threadIdx.x == 0) (void)xb_add(&bar[XB_XCNT(b.x)], 1u);
    return b;
}
__device__ __forceinline__ void xcd_barrier_complete(unsigned* bar, unsigned x, unsigned& nloc, unsigned& nx) {
    const unsigned G = gridDim.x * gridDim.y * gridDim.z;
    unsigned sum, cnt, mine, sp = 0u;
    for (;;) {
        sum = 0u; cnt = 0u; mine = 0u;
#pragma unroll
        for (unsigned j = 0; j < 16; ++j) { const unsigned c = xb_ld(&bar[XB_XCNT(j)]); sum += c; cnt += (c > 0u) ? 1u : 0u; mine = (j == x) ? c : mine; }
        if (sum == G) break;
        __builtin_amdgcn_s_sleep(1);
        if ((++sp & 255u) == 0u) { if (xb_ld(&bar[XB_TMO])) break; if (sp > XB_SPIN_CAP) { atomicAdd(&bar[XB_TMO], 1u); break; } }
    }
    nloc = mine > 0u ? mine : 1u; nx = cnt > 0u ? cnt : 1u;
}
__device__ __forceinline__ void xcd_barrier(const XcdBarrier& b) {
    asm volatile("s_waitcnt vmcnt(0)" ::: "memory");
    __syncthreads();
    if (threadIdx.x == 0) {
        unsigned* bar = b.bar;
        __builtin_amdgcn_s_waitcnt(0);
        unsigned nloc = b.st[0], nx = b.st[1];
        if (nloc == 0u) { xcd_barrier_complete(bar, b.x, nloc, nx); b.st[0] = nloc; b.st[1] = nx; }
        const unsigned old = xb_add(&bar[XB_XSUB(b.x)], 1u);
        const unsigned gen = old / nloc;
        if (old + 1u == (gen + 1u) * nloc) {
            __builtin_amdgcn_fence(__ATOMIC_RELEASE, "agent");
            asm volatile("s_waitcnt vmcnt(0)" ::: "memory");
            const unsigned og = xb_add(&bar[XB_TOP], 1u);
            const unsigned tg = og / nx;
            if (og + 1u == (tg + 1u) * nx) xb_add(&bar[XB_TOPGEN], 1u);
            else XB_SPIN(xb_ld(&bar[XB_TOPGEN]) == tg, bar);
            __builtin_amdgcn_fence(__ATOMIC_ACQUIRE, "agent");
            xb_add(&bar[XB_XGEN(b.x)], 1u);
            asm volatile("s_waitcnt vmcnt(0)" ::: "memory");
        } else {
            XB_SPIN(xb_ld(&bar[XB_XGEN(b.x)]) == gen, bar);
            __builtin_amdgcn_fence(__ATOMIC_ACQUIRE, "agent");
            asm volatile("s_waitcnt vmcnt(0)" ::: "memory");
        }
    }
    __syncthreads();
}

__device__ __forceinline__ int lds_byte(int r, int c) { const int st = (r >> 4) * 2 + (c >> 5), rr = r & 15, cc = c & 31, ob = rr * 64 + cc * 2; return st * 1024 + (ob ^ (((ob >> 9) & 1) << 5)); }
__device__ __forceinline__ void stage_rc(int b, int& R, int& C) { const int st = b / 1024, sb = b % 1024, swz = sb ^ (((sb >> 9) & 1) << 5); R = (st >> 1) * 16 + swz / 64; C = (st & 1) * 32 + (swz % 64) / 2; }
__device__ __forceinline__ int perm32(int rho) { const int n = rho >> 4, i = rho & 15; return 8 * (i >> 2) + 4 * n + (i & 3); }

struct Unit { int pm, pn; };
struct Gemm { const bf16_t* A; const bf16_t* Bt; int lda, ldb, K, nM, nN, a_pn_off; };
struct StaticOrder {
    int nM, nN, nwg, G, c;
    __device__ void init(int nM_, int nN_, int G_, int c_) { nM = nM_; nN = nN_; nwg = nM * nN; G = G_; c = c_; }
    __device__ bool next(int i, Unit& u) const {
        const long L = (long)i * G + c; if (L >= nwg) return false;
        int wgid = (int)L; { const int q = nwg / NXCD, r = nwg % NXCD, xcd = wgid % NXCD, off = wgid / NXCD; wgid = (xcd < r ? xcd * (q + 1) : r * (q + 1) + (xcd - r) * q) + off; }
        const int nig = WGM * nN, gid = wgid / nig, fm = gid * WGM, gsz = (nM - fm) < WGM ? (nM - fm) : WGM;
        u.pm = fm + ((wgid % nig) % gsz); u.pn = (wgid % nig) / gsz; return true;
    }
};

enum { E_PROJ = 0, E_SCALE = 1, E_GATE = 2, E_GATEADD = 3, E_PLAIN = 4, E_RELU2 = 5 };
struct Epi { int id, ldc; bf16_t* o0; const bf16_t* x0; const bf16_t* x1; const float* vec; unsigned char* ws; };

__device__ __forceinline__ void epilogue(const Epi& E, const f32x4 (&acc)[2][2][4][2], const Unit& u) {
    int tl = threadIdx.x; asm volatile("" : "+v"(tl));
    const int wv = tl >> 6, ln = tl & 63, wr = wv >> 2, wc = wv & 3, fr = ln & 15, fq = ln >> 4;
    const int row0 = u.pm * BM + wr * 64 + fr;
    const int colw = wc * 32 + 8 * fq;
    if (E.id == E_PROJ) {
        if (u.pn >= 4 && u.pn < 12) {
            const int ch = (u.pn - 4) * 128 + colw;
#pragma unroll
            for (int ai = 0; ai < 2; ++ai)
#pragma unroll
                for (int m = 0; m < 4; ++m) {
                    const size_t r = (size_t)(row0 + ai * HALF + m * 16);
                    st8((bf16_t*)(E.ws + 2 * SLOT) + r * D + ch, acc[ai][0][m][0] * acc[ai][1][m][0], acc[ai][0][m][1] * acc[ai][1][m][1]);
                }
        } else if (u.pn >= 16) {
            const int gc0 = (u.pn - 16) * BM;
            bf16_t* O = (bf16_t*)(E.ws + (gc0 < D ? 4 : 5) * SLOT);
            const int oc0 = gc0 & (D - 1);
#pragma unroll
            for (int bj = 0; bj < 2; ++bj) {
                const f32x4 b0 = *(const f32x4*)(E.vec + gc0 + bj * HALF + colw), b1 = *(const f32x4*)(E.vec + gc0 + bj * HALF + colw + 4);
#pragma unroll
                for (int ai = 0; ai < 2; ++ai)
#pragma unroll
                    for (int m = 0; m < 4; ++m) {
                        const size_t r = (size_t)(row0 + ai * HALF + m * 16);
                        f32x4 v0 = acc[ai][bj][m][0] + b0, v1 = acc[ai][bj][m][1] + b1;
#pragma unroll
                        for (int j = 0; j < 4; ++j) { v0[j] = sigmoidf_(v0[j]); v1[j] = sigmoidf_(v1[j]); }
                        st8(O + r * D + oc0 + bj * HALF + colw, v0, v1);
                    }
            }
        } else {
            bf16_t* O = (bf16_t*)(E.ws + (u.pn < 4 ? 1 : 3) * SLOT);
            const int oc0 = (u.pn & 3) * BM;
#pragma unroll
            for (int ai = 0; ai < 2; ++ai)
#pragma unroll
                for (int m = 0; m < 4; ++m) {
                    const size_t r = (size_t)(row0 + ai * HALF + m * 16);
#pragma unroll
                    for (int bj = 0; bj < 2; ++bj) st8(O + r * D + oc0 + bj * HALF + colw, acc[ai][bj][m][0], acc[ai][bj][m][1]);
                }
        }
        return;
    }
    const int col0 = u.pn * BM + colw;
    if (E.id == E_SCALE) {
#pragma unroll
        for (int bj = 0; bj < 2; ++bj) {
            const f32x4 s0 = *(const f32x4*)(E.vec + col0 + bj * HALF), s1 = *(const f32x4*)(E.vec + col0 + bj * HALF + 4);
#pragma unroll
            for (int ai = 0; ai < 2; ++ai)
#pragma unroll
                for (int m = 0; m < 4; ++m) {
                    const size_t r = (size_t)(row0 + ai * HALF + m * 16);
                    st8(E.o0 + r * E.ldc + col0 + bj * HALF, acc[ai][bj][m][0] * s0, acc[ai][bj][m][1] * s1);
                }
        }
    } else if (E.id == E_GATE) {
#pragma unroll
        for (int ai = 0; ai < 2; ++ai)
#pragma unroll
            for (int m = 0; m < 4; ++m) {
                const size_t r = (size_t)(row0 + ai * HALF + m * 16);
#pragma unroll
                for (int bj = 0; bj < 2; ++bj) {
                    f32x4 g0, g1; ld8(E.x0 + r * D + col0 + bj * HALF, g0, g1);
                    st8(E.o0 + r * E.ldc + col0 + bj * HALF, acc[ai][bj][m][0] * g0, acc[ai][bj][m][1] * g1);
                }
                if (m == 3) asm volatile("" ::: "memory");
            }
    } else if (E.id == E_GATEADD) {
#pragma unroll
        for (int ai = 0; ai < 2; ++ai)
#pragma unroll
            for (int m = 0; m < 4; ++m) {
                const size_t r = (size_t)(row0 + ai * HALF + m * 16);
#pragma unroll
                for (int bj = 0; bj < 2; ++bj) {
                    f32x4 g0, g1, a0, a1; ld8(E.x0 + r * D + col0 + bj * HALF, g0, g1); ld8(E.x1 + r * D + col0 + bj * HALF, a0, a1);
                    st8(E.o0 + r * E.ldc + col0 + bj * HALF, a0 + acc[ai][bj][m][0] * g0, a1 + acc[ai][bj][m][1] * g1);
                }
                if (m & 1) asm volatile("" ::: "memory");
            }
    } else if (E.id == E_RELU2) {
#pragma unroll
        for (int ai = 0; ai < 2; ++ai)
#pragma unroll
            for (int m = 0; m < 4; ++m) {
                const size_t r = (size_t)(row0 + ai * HALF + m * 16);
#pragma unroll
                for (int bj = 0; bj < 2; ++bj) {
                    f32x4 v0 = acc[ai][bj][m][0], v1 = acc[ai][bj][m][1];
#pragma unroll
                    for (int j = 0; j < 4; ++j) { const float a = fmaxf(v0[j], 0.f), b = fmaxf(v1[j], 0.f); v0[j] = a * a; v1[j] = b * b; }
                    st8(E.o0 + r * E.ldc + col0 + bj * HALF, v0, v1);
                }
            }
    } else {
#pragma unroll
        for (int ai = 0; ai < 2; ++ai)
#pragma unroll
            for (int m = 0; m < 4; ++m) {
                const size_t r = (size_t)(row0 + ai * HALF + m * 16);
#pragma unroll
                for (int bj = 0; bj < 2; ++bj) st8(E.o0 + r * E.ldc + col0 + bj * HALF, acc[ai][bj][m][0], acc[ai][bj][m][1]);
            }
    }
}

__device__ __forceinline__ void gemm_phase(LAS unsigned char* lds, const Gemm g, const StaticOrder& S, const Epi& E) {
    const int tid = threadIdx.x, wid = __builtin_amdgcn_readfirstlane(tid >> 6), lane = tid & 63, wr = wid >> 2, wc = wid & 3, fr = lane & 15, fq = lane >> 4;
    const int nt = g.K / BK;
    unsigned voffA[2], voffB[2];
#pragma unroll
    for (int i = 0; i < 2; ++i) { int R, C; stage_rc(tid * 16 + i * 8192, R, C); const int Rb = (R & ~31) + perm32(R & 31);
        voffA[i] = (unsigned)(R * g.lda + C) * 2u; voffB[i] = (unsigned)(Rb * g.ldb + C) * 2u; }
    const size_t kstep = (size_t)(BK * 2);
    const size_t hstepA = (size_t)HALF * g.lda * 2, hstepB = (size_t)HALF * g.ldb * 2;
    const size_t tstepA = 2 * hstepA, tstepB = 2 * hstepB;
    const size_t pnoffA = (size_t)g.a_pn_off * 2;
    const unsigned ldsw = (unsigned)wid * 1024u;
    const int aoff = lds_byte(wr * 64 + fr, fq * 8), boff = lds_byte(wc * 32 + fr, fq * 8);
#define PG8_SA(b, h) (((b) * 2 + (h)) * HTB)
#define PG8_SB(b, h) ((4 + (b) * 2 + (h)) * HTB)
#define PG8_STAGE(bufoff, gbase, voff) do { _Pragma("unroll") for (int _i = 0; _i < 2; ++_i) \
        __builtin_amdgcn_global_load_lds((const unsigned*)((const char*)(gbase) + (voff)[_i]), (LAS unsigned*)(lds + (bufoff) + ldsw + _i * 8192), 16, 0, 0); } while (0)
#define PG8_LDA(dst, b, h) do { _Pragma("unroll") for (int m = 0; m < 4; ++m) _Pragma("unroll") for (int k = 0; k < 2; ++k) dst[m][k] = *(const LAS bf16x8*)(lds + PG8_SA(b, h) + aoff + m * 2048 + k * 1024); } while (0)
#define PG8_LDB(dst, b, h) do { _Pragma("unroll") for (int n = 0; n < 2; ++n) _Pragma("unroll") for (int k = 0; k < 2; ++k) dst[n][k] = *(const LAS bf16x8*)(lds + PG8_SB(b, h) + boff + n * 2048 + k * 1024); } while (0)
#define PG8_MMA(ai, bj, At, Bt) do { __builtin_amdgcn_s_setprio(1); _Pragma("unroll") for (int m = 0; m < 4; ++m) _Pragma("unroll") for (int n = 0; n < 2; ++n) _Pragma("unroll") for (int k = 0; k < 2; ++k) \
        acc[ai][bj][m][n] = __builtin_amdgcn_mfma_f32_16x16x32_bf16(Bt[n][k], At[m][k], acc[ai][bj][m][n], 0, 0, 0); __builtin_amdgcn_s_setprio(0); } while (0)
#define PG8_WAIT_V(n) asm volatile("s_waitcnt vmcnt(" #n ")" ::: "memory")
#define PG8_WAIT_L(n) asm volatile("s_waitcnt lgkmcnt(" #n ")" ::: "memory")
#define PG8_BAR __builtin_amdgcn_s_barrier()
#define PG8_SCHED __builtin_amdgcn_sched_barrier(0)
    Unit cur, nxt; int ui = 0;
    if (!S.next(0, cur)) return;
    f32x4 acc[2][2][4][2];
#pragma unroll
    for (int a = 0; a < 2; ++a)
#pragma unroll
        for (int b = 0; b < 2; ++b)
#pragma unroll
            for (int m = 0; m < 4; ++m)
#pragma unroll
                for (int n = 0; n < 2; ++n) acc[a][b][m][n] = (f32x4){0.f, 0.f, 0.f, 0.f};
    bf16x8 At[4][2], B0[2][2], B1[2][2];
    const char* cA = (const char*)g.A + (size_t)cur.pm * tstepA + (size_t)cur.pn * pnoffA; const char* cB = (const char*)g.Bt + (size_t)cur.pn * tstepB;
    PG8_STAGE(PG8_SB(0, 0), cB, voffB); PG8_STAGE(PG8_SA(0, 0), cA, voffA); PG8_STAGE(PG8_SB(0, 1), cB + hstepB, voffB); PG8_STAGE(PG8_SA(0, 1), cA + hstepA, voffA);
    if (wr == 1) PG8_BAR;
    PG8_WAIT_V(4); PG8_BAR;
    PG8_STAGE(PG8_SB(1, 0), cB + kstep, voffB); PG8_STAGE(PG8_SA(1, 0), cA + kstep, voffA); PG8_STAGE(PG8_SB(1, 1), cB + hstepB + kstep, voffB);
    PG8_WAIT_V(6); PG8_BAR;
    for (;;) {
        const bool has_next = S.next(ui + 1, nxt);
        const char* nA = has_next ? (const char*)g.A + (size_t)nxt.pm * tstepA + (size_t)nxt.pn * pnoffA : cA; const char* nB = has_next ? (const char*)g.Bt + (size_t)nxt.pn * tstepB : cB;
        for (int t = 0; t < nt; t += 2) {
            const bool last = (t == nt - 2);
            const char* a1 = cA + (size_t)(t + 1) * kstep;
            const char* a2 = last ? nA : cA + (size_t)(t + 2) * kstep; const char* b2 = last ? nB : cB + (size_t)(t + 2) * kstep;
            const char* a3 = a2 + kstep; const char* b3 = b2 + kstep;
            PG8_LDB(B0, 0, 0); PG8_SCHED; PG8_LDA(At, 0, 0); PG8_STAGE(PG8_SA(1, 1), a1 + hstepA, voffA);
            PG8_WAIT_L(8); PG8_BAR; PG8_WAIT_L(0); PG8_MMA(0, 0, At, B0); PG8_BAR; PG8_SCHED;
            PG8_LDB(B1, 0, 1); PG8_STAGE(PG8_SB(0, 0), b2, voffB);
            PG8_BAR; PG8_WAIT_L(0); PG8_MMA(0, 1, At, B1); PG8_BAR;
            PG8_LDA(At, 0, 1); PG8_STAGE(PG8_SA(0, 0), a2, voffA);
            PG8_BAR; PG8_WAIT_L(0); PG8_MMA(1, 0, At, B0); PG8_BAR; PG8_SCHED;
            PG8_STAGE(PG8_SB(0, 1), b2 + hstepB, voffB);
            PG8_WAIT_V(6); PG8_BAR; PG8_MMA(1, 1, At, B1); PG8_BAR;
            PG8_LDB(B0, 1, 0); PG8_SCHED; PG8_LDA(At, 1, 0); PG8_STAGE(PG8_SA(0, 1), a2 + hstepA, voffA);
            PG8_WAIT_L(8); PG8_BAR; PG8_WAIT_L(0); PG8_MMA(0, 0, At, B0); PG8_BAR; PG8_SCHED;
            PG8_LDB(B1, 1, 1); PG8_STAGE(PG8_SB(1, 0), b3, voffB);
            PG8_BAR; PG8_WAIT_L(0); PG8_MMA(0, 1, At, B1); PG8_BAR;
            PG8_LDA(At, 1, 1); PG8_STAGE(PG8_SA(1, 0), a3, voffA);
            PG8_BAR; PG8_WAIT_L(0); PG8_MMA(1, 0, At, B0); PG8_BAR; PG8_SCHED;
            PG8_STAGE(PG8_SB(1, 1), b3 + hstepB, voffB);
            PG8_WAIT_V(6); PG8_BAR; PG8_MMA(1, 1, At, B1); PG8_BAR;
        }
        epilogue(E, acc, cur);
        if (!has_next) break;
#pragma unroll
        for (int a = 0; a < 2; ++a)
#pragma unroll
            for (int b = 0; b < 2; ++b)
#pragma unroll
                for (int m = 0; m < 4; ++m)
#pragma unroll
                    for (int n = 0; n < 2; ++n) acc[a][b][m][n] = (f32x4){0.f, 0.f, 0.f, 0.f};
        cur = nxt; cA = nA; cB = nB; ++ui;
    }
    PG8_WAIT_V(0);
    if (wr == 0) PG8_BAR;
    PG8_BAR;
#undef PG8_SA
#undef PG8_SB
#undef PG8_STAGE
#undef PG8_LDA
#undef PG8_LDB
#undef PG8_MMA
#undef PG8_WAIT_V
#undef PG8_WAIT_L
#undef PG8_BAR
#undef PG8_SCHED
}

__device__ __forceinline__ int win_dst_row(int n0) {
    if (n0 < D || n0 >= 3 * D) return n0;
    const int isv = n0 >= 2 * D, ch = n0 - (isv ? 2 * D : D);
    return D + (ch >> 7) * 256 + isv * 128 + (ch & 127);
}
__device__ __forceinline__ void transpose_item(const float* W, int K, int N, bf16_t* WT, int wperm, LAS float* scr, int item, int lane) {
    const int nblk = N / 32, kb = item / nblk, nb = item % nblk, k0 = 64 * kb, n0 = 32 * nb;
#pragma unroll 8
    for (int i = 0; i < 32; ++i) { const int kk = 2 * i + (lane >> 5); scr[kk * 33 + (lane & 31)] = W[(size_t)(k0 + kk) * N + n0 + (lane & 31)]; }
    LDS_WAIT(); asm volatile("" ::: "memory");
    const int c = lane & 7;
    const int drow0 = wperm ? win_dst_row(n0) : n0;
#pragma unroll
    for (int j = 0; j < 4; ++j) { const int n = (lane >> 3) + 8 * j; const LAS float* s = scr + (8 * c) * 33 + n;
        u32x4 o; o.x = cvt_pk_bf16(s[0 * 33], s[1 * 33]); o.y = cvt_pk_bf16(s[2 * 33], s[3 * 33]); o.z = cvt_pk_bf16(s[4 * 33], s[5 * 33]); o.w = cvt_pk_bf16(s[6 * 33], s[7 * 33]);
        *(u32x4*)(WT + (size_t)(drow0 + n) * K + k0 + 8 * c) = o; }
    LDS_WAIT(); asm volatile("" ::: "memory");
}
__device__ __forceinline__ void transpose_matrix(const float* W, int K, int N, bf16_t* WT, int wperm, LAS float* scr, int gw, int NGW, int lane, int& off) {
    const int nitems = (K / 64) * (N / 32);
    int start = gw - (off % NGW); if (start < 0) start += NGW;
    for (int it = start; it < nitems; it += NGW) transpose_item(W, K, N, WT, wperm, scr, it, lane);
    off += nitems;
}

__global__ void __launch_bounds__(512, 2) fwd_megakernel(Params p) {
    extern __shared__ __attribute__((aligned(16))) unsigned char shm[];
    LAS unsigned char* lds = (LAS unsigned char*)shm;
    cg::grid_group grid = cg::this_grid();
    const int tid = threadIdx.x;
    const int G = (int)gridDim.x, NGW = G * 8;
    unsigned char* ws = p.ws;
    bf16_t* S0 = (bf16_t*)(ws + 0 * SLOT); bf16_t* S1 = (bf16_t*)(ws + 1 * SLOT); bf16_t* S2 = (bf16_t*)(ws + 2 * SLOT);
    bf16_t* S3 = (bf16_t*)(ws + 3 * SLOT); bf16_t* S4 = (bf16_t*)(ws + 4 * SLOT); bf16_t* S5 = (bf16_t*)(ws + 5 * SLOT);
    bf16_t* WIN = (bf16_t*)(ws + WS_WIN);
    float* X = p.out + O_Y;

#if !USE_CG_ONLY
    volatile LAS unsigned* xbst = (volatile LAS unsigned*)(lds + STAGE_BYTES);
    if (tid == 0) { xbst[0] = 0u; xbst[1] = 0u; xbst[2] = 0u; xbst[3] = 0u; }
    __syncthreads();
    XcdBarrier xb = xcd_barrier_post((unsigned*)(ws + WS_BAR), xbst);
#define GRID_BAR() xcd_barrier(xb)
#else
#define GRID_BAR() grid.sync()
#endif

    if (!SKELETON) {
        const int lane = tid & 63, wid = tid >> 6, gw = (int)blockIdx.x * 8 + wid;
        LAS float* scr = (LAS float*)(lds + wid * 16384);
        int off = 0;
        transpose_matrix(p.in[4], D, DIN, WIN, 1, scr, gw, NGW, lane, off);
        for (int l = 0; l < NL; ++l) {
            unsigned char* wl = ws + WS_WL + (size_t)l * WL_BYTES;
            transpose_matrix(p.in[7] + (size_t)l * D * D, D, D, (bf16_t*)(wl + WL_WC), 0, scr, gw, NGW, lane, off);
            transpose_matrix(p.in[10] + (size_t)l * D * D, D, D, (bf16_t*)(wl + WL_WP), 0, scr, gw, NGW, lane, off);
            transpose_matrix(p.in[11] + (size_t)l * D * D, D, D, (bf16_t*)(wl + WL_WO), 0, scr, gw, NGW, lane, off);
            for (int gi = 0; gi < 4; ++gi)
                transpose_matrix(p.in[8] + (size_t)l * 4 * 65536 + (size_t)gi * 65536, 256, 256, (bf16_t*)(wl + WL_POOL) + (size_t)gi * 65536, 0, scr, gw, NGW, lane, off);
            transpose_matrix(p.in[14] + (size_t)l * D * DFF, D, DFF, (bf16_t*)(wl + WL_UP), 0, scr, gw, NGW, lane, off);
            transpose_matrix(p.in[15] + (size_t)l * DFF * D, DFF, D, (bf16_t*)(wl + WL_DOWN), 0, scr, gw, NGW, lane, off);
        }
        for (int i = (int)blockIdx.x * 512 + tid; i < (MPAD - MTOT) * D / 8; i += G * 512) *(u32x4*)(S0 + (size_t)MTOT * D + (size_t)i * 8) = (u32x4){0u, 0u, 0u, 0u};
        const float* gpre = p.in[12];
        f32x4 gv[4];
#pragma unroll
        for (int j = 0; j < 4; ++j) gv[j] = *(const f32x4*)(gpre + lane * 4 + 256 * j);
        for (int r = gw; r < MTOT; r += NGW) {
            const float* xr = r < MP ? p.in[0] + (size_t)r * D : p.in[1] + (size_t)(r - MP) * D;
            f32x4 v[4]; float s = 0.f;
#pragma unroll
            for (int j = 0; j < 4; ++j) { v[j] = *(const f32x4*)(xr + lane * 4 + 256 * j); s += (v[j][0] * v[j][0] + v[j][1] * v[j][1]) + (v[j][2] * v[j][2] + v[j][3] * v[j][3]); }
            const float rs = rsqrtf(wave_sum(s) * (1.f / D) + EPS);
#pragma unroll
            for (int j = 0; j < 4; ++j) { u32x2 o; o.x = cvt_pk_bf16(v[j][0] * rs * gv[j][0], v[j][1] * rs * gv[j][1]); o.y = cvt_pk_bf16(v[j][2] * rs * gv[j][2], v[j][3] * rs * gv[j][3]);
                *(u32x2*)(S0 + (size_t)r * D + lane * 4 + 256 * j) = o; }
        }
    }
    grid.sync();

    for (int step = 0; step < NL * 10; ++step) {
        const int l = step / 10, ph = step - l * 10;
        int tid_s = threadIdx.x; asm volatile("" : "+v"(tid_s));
        const int lane = tid_s & 63, wid = tid_s >> 6, gw = (int)blockIdx.x * 8 + wid;
        unsigned char* wl = ws + WS_WL + (size_t)l * WL_BYTES;
        Gemm g{S0, WIN, D, D, D, MPAD / BM, D / BM, 0};
        Epi E{E_PLAIN, D, S1, nullptr, nullptr, nullptr, ws};
        bool is_gemm = true;
        switch (ph) {
        case 0:
            g.nN = DIN / BM; E.id = E_PROJ; E.vec = p.in[5] + (size_t)l * 2 * D; break;
        case 2:
            g.Bt = (const bf16_t*)(wl + WL_POOL); g.ldb = 256; g.K = 256; g.nN = 4; g.a_pn_off = 256;
            E.id = E_SCALE; E.o0 = S2; E.vec = p.in[9] + (size_t)l * D; break;
        case 3:
            g.A = S1; g.Bt = (const bf16_t*)(wl + WL_WC); E.id = E_GATE; E.o0 = S3; E.x0 = S4; break;
        case 4:
            g.A = S2; g.Bt = (const bf16_t*)(wl + WL_WP); E.id = E_GATEADD; E.o0 = S0; E.x0 = S5; E.x1 = S3; break;
        case 5:
            g.Bt = (const bf16_t*)(wl + WL_WO); break;
        case 7:
            g.Bt = (const bf16_t*)(wl + WL_UP); g.nN = DFF / BM; E.id = E_RELU2; E.ldc = DFF; break;
        case 8:
            g.A = S1; g.Bt = (const bf16_t*)(wl + WL_DOWN); g.lda = DFF; g.ldb = DFF; g.K = DFF; E.o0 = S5; break;
        default: is_gemm = false; break;
        }
        if (SKELETON || step > p.stop) { if (step == 0 && blockIdx.x == 0 && tid == 0) p.out[0] = 1.f; }
        else if (is_gemm) {
            StaticOrder S; S.init(g.nM, g.nN, G, (int)blockIdx.x);
            gemm_phase(lds, g, S, E);
        } else if (ph == 1) {
            const float* cw = p.in[6] + (size_t)l * 3 * D;
            const float* cconv = p.in[2] + (size_t)l * NB_S * 2 * D;
            const float* cpool = p.in[3] + (size_t)l * NB_S * 15 * D;
            float* o_csp = p.out + O_CSP + (size_t)l * 2 * D;
            float* o_psp = p.out + O_PSP + (size_t)l * 15 * D;
            float* o_css = p.out + O_CSS + (size_t)l * NB_S * 2 * D;
            float* o_pss = p.out + O_PSS + (size_t)l * NB_S * 15 * D;
            for (int it = gw; it < (MTOT / 2) * 4; it += NGW) {
                const int gi = it & 3, r = (it >> 2) * 2 + (lane >> 5), ch = gi * 256 + (lane & 31) * 8;
                const bool smp = r >= MP;
                const int sb = smp ? (r - MP) >> 4 : 0, t = smp ? (r - MP) & 15 : r;
                f32x4 b0, b1, z0a, z0b, z1a, z1b, z2a, z2b, p0a, p0b;
                ld8(S1 + (size_t)r * D + ch, b0, b1);
                ld8(S2 + (size_t)r * D + ch, z0a, z0b);
                ld8(S3 + (size_t)r * D + ch, p0a, p0b);
                if (t >= 1) ld8(S2 + (size_t)(r - 1) * D + ch, z1a, z1b);
                else if (smp) { const float* q = cconv + ((size_t)sb * 2 + 1) * D + ch; z1a = *(const f32x4*)q; z1b = *(const f32x4*)(q + 4); }
                else { z1a = (f32x4){0.f, 0.f, 0.f, 0.f}; z1b = z1a; }
                if (t >= 2) ld8(S2 + (size_t)(r - 2) * D + ch, z2a, z2b);
                else if (smp) { const float* q = cconv + ((size_t)sb * 2 + t) * D + ch; z2a = *(const f32x4*)q; z2b = *(const f32x4*)(q + 4); }
                else { z2a = (f32x4){0.f, 0.f, 0.f, 0.f}; z2b = z2a; }
                const f32x4 w0a = *(const f32x4*)(cw + ch), w0b = *(const f32x4*)(cw + ch + 4);
                const f32x4 w1a = *(const f32x4*)(cw + D + ch), w1b = *(const f32x4*)(cw + D + ch + 4);
                const f32x4 w2a = *(const f32x4*)(cw + 2 * D + ch), w2b = *(const f32x4*)(cw + 2 * D + ch + 4);
                const f32x4 ya0 = b0 * (w0a * z2a + w1a * z1a + w2a * z0a), ya1 = b1 * (w0b * z2b + w1b * z1b + w2b * z0b);
                const int w = 2 << gi;
                f32x4 sa = p0a, sb2 = p0b;
                for (int i = 1; i < w; ++i) {
                    f32x4 qa, qb;
                    if (t - i >= 0) ld8(S3 + (size_t)(r - i) * D + ch, qa, qb);
                    else if (smp) { const float* q = cpool + ((size_t)sb * 15 + (15 + t - i)) * D + ch; qa = *(const f32x4*)q; qb = *(const f32x4*)(q + 4); }
                    else { qa = (f32x4){0.f, 0.f, 0.f, 0.f}; qb = qa; }
                    sa += qa; sb2 += qb;
                }
                const int cnt = smp ? w : (t + 1 < w ? t + 1 : w);
                const float ic = 1.0f / (float)cnt;
                st8(S1 + (size_t)r * D + ch, ya0, ya1);
                st8(S0 + (size_t)r * D + ch, sa * ic - p0a, sb2 * ic - p0b);
                if (!smp) {
                    if (t >= MP - 2) { float* o = o_csp + (size_t)(t - (MP - 2)) * D + ch; *(f32x4*)o = z0a; *(f32x4*)(o + 4) = z0b; }
                    if (t >= MP - 15) { float* o = o_psp + (size_t)(t - (MP - 15)) * D + ch; *(f32x4*)o = p0a; *(f32x4*)(o + 4) = p0b; }
                } else {
                    if (t >= SEQ_S - 2) { float* o = o_css + ((size_t)sb * 2 + (t - (SEQ_S - 2))) * D + ch; *(f32x4*)o = z0a; *(f32x4*)(o + 4) = z0b; }
                    if (t >= 1) { float* o = o_pss + ((size_t)sb * 15 + (t - 1)) * D + ch; *(f32x4*)o = p0a; *(f32x4*)(o + 4) = p0b; }
                }
            }
            if (l + 1 < NL) {
                LAS float* scr = (LAS float*)(lds + wid * 16384);
                int off = 0;
                transpose_matrix(p.in[4] + (size_t)(l + 1) * D * DIN, D, DIN, WIN, 1, scr, gw, NGW, lane, off);
            }
        } else {
            const int half = ph == 6 ? 0 : 1;
            const bf16_t* Y = half == 0 ? S1 : S5;
            const float* gpost = (half == 0 ? p.in[13] : p.in[17]) + (size_t)l * D;
            const bool has_next = true;
            const float* gnext = half == 0 ? p.in[16] + (size_t)l * D : p.in[12] + (size_t)(l + 1 < NL ? l + 1 : l) * D;
            const bool from_input = (l == 0 && half == 0);
            f32x4 gp[4], gn[4];
#pragma unroll
            for (int j = 0; j < 4; ++j) { gp[j] = *(const f32x4*)(gpost + lane * 4 + 256 * j); gn[j] = *(const f32x4*)(gnext + lane * 4 + 256 * j); }
            for (int r = gw; r < MTOT; r += NGW) {
                const float* xr = from_input ? (r < MP ? p.in[0] + (size_t)r * D : p.in[1] + (size_t)(r - MP) * D) : X + (size_t)r * D;
                f32x4 xv[4], yv[4]; float s = 0.f;
#pragma unroll
                for (int j = 0; j < 4; ++j) {
                    xv[j] = *(const f32x4*)(xr + lane * 4 + 256 * j);
                    const u32x2 wv = *(const u32x2*)(Y + (size_t)r * D + lane * 4 + 256 * j);
                    yv[j][0] = bf_lo(wv.x); yv[j][1] = bf_hi(wv.x); yv[j][2] = bf_lo(wv.y); yv[j][3] = bf_hi(wv.y);
                    s += (yv[j][0] * yv[j][0] + yv[j][1] * yv[j][1]) + (yv[j][2] * yv[j][2] + yv[j][3] * yv[j][3]);
                }
                const float rs = rsqrtf(wave_sum(s) * (1.f / D) + EPS);
                float s2 = 0.f;
#pragma unroll
                for (int j = 0; j < 4; ++j) { xv[j] = xv[j] + yv[j] * rs * gp[j]; s2 += (xv[j][0] * xv[j][0] + xv[j][1] * xv[j][1]) + (xv[j][2] * xv[j][2] + xv[j][3] * xv[j][3]);
                    *(f32x4*)(X + (size_t)r * D + lane * 4 + 256 * j) = xv[j]; }
                if (has_next) {
                    const float rs2 = rsqrtf(wave_sum(s2) * (1.f / D) + EPS);
#pragma unroll
                    for (int j = 0; j < 4; ++j) { u32x2 o; o.x = cvt_pk_bf16(xv[j][0] * rs2 * gn[j][0], xv[j][1] * rs2 * gn[j][1]); o.y = cvt_pk_bf16(xv[j][2] * rs2 * gn[j][2], xv[j][3] * rs2 * gn[j][3]);
                        *(u32x2*)(S0 + (size_t)r * D + lane * 4 + 256 * j) = o; }
                }
            }
        }
        if (step + 1 < NL * 10) GRID_BAR();
    }
}

extern "C" void kernel_launch(void* const* d_in, const int* in_sizes, int n_in, void* d_out, int out_size, void* d_ws, size_t ws_size, hipStream_t stream) {
    static int grid = 0;
    if (grid == 0) {
        if (n_in != 18 || ws_size < WS_END) { fprintf(stderr, "kernel_launch: unexpected n_in %d or ws_size %zu (< %zu)\n", n_in, ws_size, (size_t)WS_END); grid = -1; return; }
        int dev = 0, cus = 0, per_cu = 0;
        hipGetDevice(&dev);
        hipDeviceGetAttribute(&cus, hipDeviceAttributeMultiprocessorCount, dev);
        if (hipFuncSetAttribute((const void*)fwd_megakernel, hipFuncAttributeMaxDynamicSharedMemorySize, LDS_BYTES) != hipSuccess) { fprintf(stderr, "kernel_launch: hipFuncSetAttribute failed\n"); grid = -1; return; }
        if (hipOccupancyMaxActiveBlocksPerMultiprocessor(&per_cu, (const void*)fwd_megakernel, 512, LDS_BYTES) != hipSuccess || per_cu < 1) { fprintf(stderr, "kernel_launch: occupancy query failed (%d)\n", per_cu); grid = -1; return; }
        grid = cus * per_cu;
    }
    if (grid < 0) return;
    (void)hipMemsetAsync((unsigned char*)d_ws + WS_BAR, 0, 16384, stream);
    Params p{};
    for (int i = 0; i < 18; ++i) p.in[i] = (const float*)d_in[i];
    p.out = (float*)d_out; p.ws = (unsigned char*)d_ws; p.stop = STOP_AFTER;
    void* args[] = {&p};
    hipError_t e = hipLaunchCooperativeKernel((const void*)fwd_megakernel, dim3(grid), dim3(512), args, LDS_BYTES, stream);
    if (e != hipSuccess) fprintf(stderr, "cooperative launch failed: %s (grid %d)\n", hipGetErrorString(e), grid);
}
```

```cpp
#include <hip/hip_runtime.h>
#include <hip/hip_cooperative_groups.h>
#include <cstdio>
namespace cg = cooperative_groups;

#ifndef SKELETON
#define SKELETON 0
#endif
#ifndef STOP_AFTER
#define STOP_AFTER 99
#endif
#ifndef PROBE
#define PROBE 0
#endif
#ifndef USE_CG_ONLY
#define USE_CG_ONLY 0
#endif

#define LAS __attribute__((address_space(3)))
typedef unsigned short bf16_t;
typedef short bf16x8 __attribute__((ext_vector_type(8)));
typedef float f32x4 __attribute__((ext_vector_type(4)));
typedef unsigned u32x4 __attribute__((ext_vector_type(4)));
typedef unsigned u32x2 __attribute__((ext_vector_type(2)));

constexpr int D = 1024, DIN = 6144, DFF = 4096, NL = 2;
constexpr int MP = 16384, MS = 128, MTOT = MP + MS, MPAD = 16640;
constexpr int SEQ_S = 16, NB_S = 8, PAST = 2048;
constexpr int BM = 256, BK = 64, HALF = 128, HTB = HALF * BK * 2, STAGE_BYTES = 8 * HTB, NXCD = 8, WGM = 8;
constexpr int LDS_BYTES = STAGE_BYTES + 64;
constexpr float EPS = 1e-6f;

constexpr size_t SLOT = (size_t)MPAD * 1024 * 2;
constexpr size_t WS_WIN = 6 * SLOT;
constexpr size_t WIN_BYTES = (size_t)DIN * D * 2;
constexpr size_t WL_WC = 0, WL_WP = 2097152, WL_WO = 4194304, WL_POOL = 6291456, WL_UP = 6815744, WL_DOWN = 15204352, WL_BYTES = 23592960;
constexpr size_t WS_WL = WS_WIN + WIN_BYTES;
constexpr size_t WS_BAR = WS_WL + NL * WL_BYTES;
constexpr size_t WS_END = WS_BAR + 16384;

constexpr size_t O_Y = 0, O_CSP = (size_t)MTOT * D, O_PSP = O_CSP + NL * 2 * D, O_CSS = O_PSP + NL * 15 * D, O_PSS = O_CSS + (size_t)NL * NB_S * 2 * D;

struct Params {
    const float* in[18];
    float* out;
    unsigned char* ws;
    int stop, pad;
};

__device__ __forceinline__ unsigned cvt_pk_bf16(float lo, float hi) { unsigned r; asm volatile("v_cvt_pk_bf16_f32 %0, %1, %2" : "=v"(r) : "v"(lo), "v"(hi)); return r; }
__device__ __forceinline__ float bf_lo(unsigned w) { return __uint_as_float(w << 16); }
__device__ __forceinline__ float bf_hi(unsigned w) { return __uint_as_float(w & 0xffff0000u); }
__device__ __forceinline__ void st8(bf16_t* p, f32x4 a, f32x4 b) {
    u32x4 w; w.x = cvt_pk_bf16(a[0], a[1]); w.y = cvt_pk_bf16(a[2], a[3]); w.z = cvt_pk_bf16(b[0], b[1]); w.w = cvt_pk_bf16(b[2], b[3]);
    *(u32x4*)p = w;
}
__device__ __forceinline__ void ld8(const bf16_t* p, f32x4& a, f32x4& b) {
    const u32x4 w = *(const u32x4*)p;
    a[0] = bf_lo(w.x); a[1] = bf_hi(w.x); a[2] = bf_lo(w.y); a[3] = bf_hi(w.y);
    b[0] = bf_lo(w.z); b[1] = bf_hi(w.z); b[2] = bf_lo(w.w); b[3] = bf_hi(w.w);
}
__device__ __forceinline__ float sigmoidf_(float x) { return 1.0f / (1.0f + __expf(-x)); }
__device__ __forceinline__ float wave_sum(float v) {
#pragma unroll
    for (int o = 1; o < 64; o <<= 1) v += __shfl_xor(v, o);
    return v;
}
#define LDS_WAIT() asm volatile("s_waitcnt lgkmcnt(0)" ::: "memory")

#define XB_TMO      128
#define XB_XCNT(j)  (256  + 64 * (j))
#define XB_XSUB(j)  (1280 + 64 * (j))
#define XB_XGEN(j)  (2304 + 64 * (j))
#define XB_TOP      3328
#define XB_TOPGEN   3392
#define XCD_BAR_WORDS 3456
#define XB_SPIN_CAP (1u << 18)
__device__ __forceinline__ unsigned xb_ld(unsigned* p)              { return __hip_atomic_load(p, __ATOMIC_RELAXED, __HIP_MEMORY_SCOPE_AGENT); }
__device__ __forceinline__ unsigned xb_add(unsigned* p, unsigned v) { return __hip_atomic_fetch_add(p, v, __ATOMIC_RELAXED, __HIP_MEMORY_SCOPE_AGENT); }
__device__ __forceinline__ unsigned xb_xcc_id() { return (unsigned)__builtin_amdgcn_s_getreg((3 << 11) | 20) & 0xFu; }
#define XB_SPIN(cond, bar) do { unsigned _sp = 0; while (cond) { __builtin_amdgcn_s_sleep(1); \
    if ((++_sp & 255u) == 0u) { if (xb_ld(&(bar)[XB_TMO])) break; if (_sp > XB_SPIN_CAP) { atomicAdd(&(bar)[XB_TMO], 1u); break; } } } } while (0)
struct XcdBarrier { unsigned* bar; unsigned x; volatile LAS unsigned* st; };
__device__ __forceinline__ XcdBarrier xcd_barrier_post(unsigned* bar, volatile LAS unsigned* st) {
    XcdBarrier b; b.bar = bar; b.x = xb_xcc_id(); b.st = st;
    if (threadIdx.x == 0) (void)xb_add(&bar[XB_XCNT(b.x)], 1u);
    return b;
}
__device__ __forceinline__ void xcd_barrier_complete(unsigned* bar, unsigned x, unsigned& nloc, unsigned& nx) {
    const unsigned G = gridDim.x * gridDim.y * gridDim.z;
    unsigned sum, cnt, mine, sp = 0u;
    for (;;) {
        sum = 0u; cnt = 0u; mine = 0u;
#pragma unroll
        for (unsigned j = 0; j < 16; ++j) { const unsigned c = xb_ld(&bar[XB_XCNT(j)]); sum += c; cnt += (c > 0u) ? 1u : 0u; mine = (j == x) ? c : mine; }
        if (sum == G) break;
        __builtin_amdgcn_s_sleep(1);
        if ((++sp & 255u) == 0u) { if (xb_ld(&bar[XB_TMO])) break; if (sp > XB_SPIN_CAP) { atomicAdd(&bar[XB_TMO], 1u); break; } }
    }
    nloc = mine > 0u ? mine : 1u; nx = cnt > 0u ? cnt : 1u;
}
__device__ __forceinline__ void xcd_barrier(const XcdBarrier& b) {
    asm volatile("s_waitcnt vmcnt(0)" ::: "memory");
    __syncthreads();
    if (threadIdx.x == 0) {
        unsigned* bar = b.bar;
        __builtin_amdgcn_s_waitcnt(0);
        unsigned nloc = b.st[0], nx = b.st[1];
        if (nloc == 0u) { xcd_barrier_complete(bar, b.x, nloc, nx); b.st[0] = nloc; b.st[1] = nx; }
        const unsigned old = xb_add(&bar[XB_XSUB(b.x)], 1u);
        const unsigned gen = old / nloc;
        if (old + 1u == (gen + 1u) * nloc) {
            __builtin_amdgcn_fence(__ATOMIC_RELEASE, "agent");
            asm volatile("s_waitcnt vmcnt(0)" ::: "memory");
            const unsigned og = xb_add(&bar[XB_TOP], 1u);
            const unsigned tg = og / nx;
            if (og + 1u == (tg + 1u) * nx) xb_add(&bar[XB_TOPGEN], 1u);
            else XB_SPIN(xb_ld(&bar[XB_TOPGEN]) == tg, bar);
            __builtin_amdgcn_fence(__ATOMIC_ACQUIRE, "agent");
            xb_add(&bar[XB_XGEN(b.x)], 1u);
            asm volatile("s_waitcnt vmcnt(0)" ::: "memory");
        } else {
            XB_SPIN(xb_ld(&bar[XB_XGEN(b.x)]) == gen, bar);
            __builtin_amdgcn_fence(__ATOMIC_ACQUIRE, "agent");
            asm volatile("s_waitcnt vmcnt(0)" ::: "memory");
        }
    }
    __syncthreads();
}

__device__ __forceinline__ int lds_byte(int r, int c) { const int st = (r >> 4) * 2 + (c >> 5), rr = r & 15, cc = c & 31, ob = rr * 64 + cc * 2; return st * 1024 + (ob ^ (((ob >> 9) & 1) << 5)); }
__device__ __forceinline__ void stage_rc(int b, int& R, int& C) { const int st = b / 1024, sb = b % 1024, swz = sb ^ (((sb >> 9) & 1) << 5); R = (st >> 1) * 16 + swz / 64; C = (st & 1) * 32 + (swz % 64) / 2; }
__device__ __forceinline__ int perm32(int rho) { const int n = rho >> 4, i = rho & 15; return 8 * (i >> 2) + 4 * n + (i & 3); }

struct Unit { int pm, pn; };
struct Gemm { const bf16_t* A; const bf16_t* Bt; int lda, ldb, K, nM, nN, a_pn_off; };
struct StaticOrder {
    int nM, nN, nwg, G, c;
    __device__ void init(int nM_, int nN_, int G_, int c_) { nM = nM_; nN = nN_; nwg = nM * nN; G = G_; c = c_; }
    __device__ bool next(int i, Unit& u) const {
        const long L = (long)i * G + c; if (L >= nwg) return false;
        int wgid = (int)L; { const int q = nwg / NXCD, r = nwg % NXCD, xcd = wgid % NXCD, off = wgid / NXCD; wgid = (xcd < r ? xcd * (q + 1) : r * (q + 1) + (xcd - r) * q) + off; }
        const int nig = WGM * nN, gid = wgid / nig, fm = gid * WGM, gsz = (nM - fm) < WGM ? (nM - fm) : WGM;
        u.pm = fm + ((wgid % nig) % gsz); u.pn = (wgid % nig) / gsz; return true;
    }
};

enum { E_PROJ = 0, E_SCALE = 1, E_GATE = 2, E_GATEADD = 3, E_PLAIN = 4, E_RELU2 = 5 };
struct Epi { int id, ldc; bf16_t* o0; const bf16_t* x0; const bf16_t* x1; const float* vec; unsigned char* ws; };

__device__ __forceinline__ void epilogue(const Epi& E, const f32x4 (&acc)[2][2][4][2], const Unit& u) {
    int tl = threadIdx.x; asm volatile("" : "+v"(tl));
    const int wv = tl >> 6, ln = tl & 63, wr = wv >> 2, wc = wv & 3, fr = ln & 15, fq = ln >> 4;
    const int row0 = u.pm * BM + wr * 64 + fr;
    const int colw = wc * 32 + 8 * fq;
    if (E.id == E_PROJ) {
        if (u.pn >= 4 && u.pn < 12) {
            const int ch = (u.pn - 4) * 128 + colw;
#pragma unroll
            for (int ai = 0; ai < 2; ++ai)
#pragma unroll
                for (int m = 0; m < 4; ++m) {
                    const size_t r = (size_t)(row0 + ai * HALF + m * 16);
                    st8((bf16_t*)(E.ws + 2 * SLOT) + r * D + ch, acc[ai][0][m][0] * acc[ai][1][m][0], acc[ai][0][m][1] * acc[ai][1][m][1]);
                }
        } else if (u.pn >= 16) {
            const int gc0 = (u.pn - 16) * BM;
            bf16_t* O = (bf16_t*)(E.ws + (gc0 < D ? 4 : 5) * SLOT);
            const int oc0 = gc0 & (D - 1);
#pragma unroll
            for (int bj = 0; bj < 2; ++bj) {
                const f32x4 b0 = *(const f32x4*)(E.vec + gc0 + bj * HALF + colw), b1 = *(const f32x4*)(E.vec + gc0 + bj * HALF + colw + 4);
#pragma unroll
                for (int ai = 0; ai < 2; ++ai)
#pragma unroll
                    for (int m = 0; m < 4; ++m) {
                        const size_t r = (size_t)(row0 + ai * HALF + m * 16);
                        f32x4 v0 = acc[ai][bj][m][0] + b0, v1 = acc[ai][bj][m][1] + b1;
#pragma unroll
                        for (int j = 0; j < 4; ++j) { v0[j] = sigmoidf_(v0[j]); v1[j] = sigmoidf_(v1[j]); }
                        st8(O + r * D + oc0 + bj * HALF + colw, v0, v1);
                    }
            }
        } else {
            bf16_t* O = (bf16_t*)(E.ws + (u.pn < 4 ? 1 : 3) * SLOT);
            const int oc0 = (u.pn & 3) * BM;
#pragma unroll
            for (int ai = 0; ai < 2; ++ai)
#pragma unroll
                for (int m = 0; m < 4; ++m) {
                    const size_t r = (size_t)(row0 + ai * HALF + m * 16);
#pragma unroll
                    for (int bj = 0; bj < 2; ++bj) st8(O + r * D + oc0 + bj * HALF + colw, acc[ai][bj][m][0], acc[ai][bj][m][1]);
                }
        }
        return;
    }
    const int col0 = u.pn * BM + colw;
    if (E.id == E_SCALE) {
#pragma unroll
        for (int bj = 0; bj < 2; ++bj) {
            const f32x4 s0 = *(const f32x4*)(E.vec + col0 + bj * HALF), s1 = *(const f32x4*)(E.vec + col0 + bj * HALF + 4);
#pragma unroll
            for (int ai = 0; ai < 2; ++ai)
#pragma unroll
                for (int m = 0; m < 4; ++m) {
                    const size_t r = (size_t)(row0 + ai * HALF + m * 16);
                    st8(E.o0 + r * E.ldc + col0 + bj * HALF, acc[ai][bj][m][0] * s0, acc[ai][bj][m][1] * s1);
                }
        }
    } else if (E.id == E_GATE) {
#pragma unroll
        for (int ai = 0; ai < 2; ++ai)
#pragma unroll
            for (int m = 0; m < 4; ++m) {
                const size_t r = (size_t)(row0 + ai * HALF + m * 16);
#pragma unroll
                for (int bj = 0; bj < 2; ++bj) {
                    f32x4 g0, g1; ld8(E.x0 + r * D + col0 + bj * HALF, g0, g1);
                    st8(E.o0 + r * E.ldc + col0 + bj * HALF, acc[ai][bj][m][0] * g0, acc[ai][bj][m][1] * g1);
                }
                if (m == 3) asm volatile("" ::: "memory");
            }
    } else if (E.id == E_GATEADD) {
#pragma unroll
        for (int ai = 0; ai < 2; ++ai)
#pragma unroll
            for (int m = 0; m < 4; ++m) {
                const size_t r = (size_t)(row0 + ai * HALF + m * 16);
#pragma unroll
                for (int bj = 0; bj < 2; ++bj) {
                    f32x4 g0, g1, a0, a1; ld8(E.x0 + r * D + col0 + bj * HALF, g0, g1); ld8(E.x1 + r * D + col0 + bj * HALF, a0, a1);
                    st8(E.o0 + r * E.ldc + col0 + bj * HALF, a0 + acc[ai][bj][m][0] * g0, a1 + acc[ai][bj][m][1] * g1);
                }
                if (m & 1) asm volatile("" ::: "memory");
            }
    } else if (E.id == E_RELU2) {
#pragma unroll
        for (int ai = 0; ai < 2; ++ai)
#pragma unroll
            for (int m = 0; m < 4; ++m) {
                const size_t r = (size_t)(row0 + ai * HALF + m * 16);
#pragma unroll
                for (int bj = 0; bj < 2; ++bj) {
                    f32x4 v0 = acc[ai][bj][m][0], v1 = acc[ai][bj][m][1];
#pragma unroll
                    for (int j = 0; j < 4; ++j) { const float a = fmaxf(v0[j], 0.f), b = fmaxf(v1[j], 0.f); v0[j] = a * a; v1[j] = b * b; }
                    st8(E.o0 + r * E.ldc + col0 + bj * HALF, v0, v1);
                }
            }
    } else {
#pragma unroll
        for (int ai = 0; ai < 2; ++ai)
#pragma unroll
            for (int m = 0; m < 4; ++m) {
                const size_t r = (size_t)(row0 + ai * HALF + m * 16);
#pragma unroll
                for (int bj = 0; bj < 2; ++bj) st8(E.o0 + r * E.ldc + col0 + bj * HALF, acc[ai][bj][m][0], acc[ai][bj][m][1]);
            }
    }
}

__device__ __forceinline__ void gemm_phase(LAS unsigned char* lds, const Gemm g, const StaticOrder& S, const Epi& E) {
    const int tid = threadIdx.x, wid = __builtin_amdgcn_readfirstlane(tid >> 6), lane = tid & 63, wr = wid >> 2, wc = wid & 3, fr = lane & 15, fq = lane >> 4;
    const int nt = g.K / BK;
    unsigned voffA[2], voffB[2];
#pragma unroll
    for (int i = 0; i < 2; ++i) { int R, C; stage_rc(tid * 16 + i * 8192, R, C); const int Rb = (R & ~31) + perm32(R & 31);
        voffA[i] = (unsigned)(R * g.lda + C) * 2u; voffB[i] = (unsigned)(Rb * g.ldb + C) * 2u; }
    const size_t kstep = (size_t)(BK * 2);
    const size_t hstepA = (size_t)HALF * g.lda * 2, hstepB = (size_t)HALF * g.ldb * 2;
    const size_t tstepA = 2 * hstepA, tstepB = 2 * hstepB;
    const size_t pnoffA = (size_t)g.a_pn_off * 2;
    const unsigned ldsw = (unsigned)wid * 1024u;
    const int aoff = lds_byte(wr * 64 + fr, fq * 8), boff = lds_byte(wc * 32 + fr, fq * 8);
#define PG8_SA(b, h) (((b) * 2 + (h)) * HTB)
#define PG8_SB(b, h) ((4 + (b) * 2 + (h)) * HTB)
#define PG8_STAGE(bufoff, gbase, voff) do { _Pragma("unroll") for (int _i = 0; _i < 2; ++_i) \
        __builtin_amdgcn_global_load_lds((const unsigned*)((const char*)(gbase) + (voff)[_i]), (LAS unsigned*)(lds + (bufoff) + ldsw + _i * 8192), 16, 0, 0); } while (0)
#define PG8_LDA(dst, b, h) do { _Pragma("unroll") for (int m = 0; m < 4; ++m) _Pragma("unroll") for (int k = 0; k < 2; ++k) dst[m][k] = *(const LAS bf16x8*)(lds + PG8_SA(b, h) + aoff + m * 2048 + k * 1024); } while (0)
#define PG8_LDB(dst, b, h) do { _Pragma("unroll") for (int n = 0; n < 2; ++n) _Pragma("unroll") for (int k = 0; k < 2; ++k) dst[n][k] = *(const LAS bf16x8*)(lds + PG8_SB(b, h) + boff + n * 2048 + k * 1024); } while (0)
#define PG8_MMA(ai, bj, At, Bt) do { __builtin_amdgcn_s_setprio(1); _Pragma("unroll") for (int m = 0; m < 4; ++m) _Pragma("unroll") for (int n = 0; n < 2; ++n) _Pragma("unroll") for (int k = 0; k < 2; ++k) \
        acc[ai][bj][m][n] = __builtin_amdgcn_mfma_f32_16x16x32_bf16(Bt[n][k], At[m][k], acc[ai][bj][m][n], 0, 0, 0); __builtin_amdgcn_s_setprio(0); } while (0)
#define PG8_WAIT_V(n) asm volatile("s_waitcnt vmcnt(" #n ")" ::: "memory")
#define PG8_WAIT_L(n) asm volatile("s_waitcnt lgkmcnt(" #n ")" ::: "memory")
#define PG8_BAR __builtin_amdgcn_s_barrier()
#define PG8_SCHED __builtin_amdgcn_sched_barrier(0)
    Unit cur, nxt; int ui = 0;
    if (!S.next(0, cur)) return;
    f32x4 acc[2][2][4][2];
#pragma unroll
    for (int a = 0; a < 2; ++a)
#pragma unroll
        for (int b = 0; b < 2; ++b)
#pragma unroll
            for (int m = 0; m < 4; ++m)
#pragma unroll
                for (int n = 0; n < 2; ++n) acc[a][b][m][n] = (f32x4){0.f, 0.f, 0.f, 0.f};
    bf16x8 At[4][2], B0[2][2], B1[2][2];
    const char* cA = (const char*)g.A + (size_t)cur.pm * tstepA + (size_t)cur.pn * pnoffA; const char* cB = (const char*)g.Bt + (size_t)cur.pn * tstepB;
    PG8_STAGE(PG8_SB(0, 0), cB, voffB); PG8_STAGE(PG8_SA(0, 0), cA, voffA); PG8_STAGE(PG8_SB(0, 1), cB + hstepB, voffB); PG8_STAGE(PG8_SA(0, 1), cA + hstepA, voffA);
    if (wr == 1) PG8_BAR;
    PG8_WAIT_V(4); PG8_BAR;
    PG8_STAGE(PG8_SB(1, 0), cB + kstep, voffB); PG8_STAGE(PG8_SA(1, 0), cA + kstep, voffA); PG8_STAGE(PG8_SB(1, 1), cB + hstepB + kstep, voffB);
    PG8_WAIT_V(6); PG8_BAR;
    for (;;) {
        const bool has_next = S.next(ui + 1, nxt);
        const char* nA = has_next ? (const char*)g.A + (size_t)nxt.pm * tstepA + (size_t)nxt.pn * pnoffA : cA; const char* nB = has_next ? (const char*)g.Bt + (size_t)nxt.pn * tstepB : cB;
        for (int t = 0; t < nt; t += 2) {
            const bool last = (t == nt - 2);
            const char* a1 = cA + (size_t)(t + 1) * kstep;
            const char* a2 = last ? nA : cA + (size_t)(t + 2) * kstep; const char* b2 = last ? nB : cB + (size_t)(t + 2) * kstep;
            const char* a3 = a2 + kstep; const char* b3 = b2 + kstep;
            PG8_LDB(B0, 0, 0); PG8_SCHED; PG8_LDA(At, 0, 0); PG8_STAGE(PG8_SA(1, 1), a1 + hstepA, voffA);
            PG8_WAIT_L(8); PG8_BAR; PG8_WAIT_L(0); PG8_MMA(0, 0, At, B0); PG8_BAR; PG8_SCHED;
            PG8_LDB(B1, 0, 1); PG8_STAGE(PG8_SB(0, 0), b2, voffB);
            PG8_BAR; PG8_WAIT_L(0); PG8_MMA(0, 1, At, B1); PG8_BAR;
            PG8_LDA(At, 0, 1); PG8_STAGE(PG8_SA(0, 0), a2, voffA);
            PG8_BAR; PG8_WAIT_L(0); PG8_MMA(1, 0, At, B0); PG8_BAR; PG8_SCHED;
            PG8_STAGE(PG8_SB(0, 1), b2 + hstepB, voffB);
            PG8_WAIT_V(6); PG8_BAR; PG8_MMA(1, 1, At, B1); PG8_BAR;
            PG8_LDB(B0, 1, 0); PG8_SCHED; PG8_LDA(At, 1, 0); PG8_STAGE(PG8_SA(0, 1), a2 + hstepA, voffA);
            PG8_WAIT_L(8); PG8_BAR; PG8_WAIT_L(0); PG8_MMA(0, 0, At, B0); PG8_BAR; PG8_SCHED;
            PG8_LDB(B1, 1, 1); PG8_STAGE(PG8_SB(1, 0), b3, voffB);
            PG8_BAR; PG8_WAIT_L(0); PG8_MMA(0, 1, At, B1); PG8_BAR;
            PG8_LDA(At, 1, 1); PG8_STAGE(PG8_SA(1, 0), a3, voffA);
            PG8_BAR; PG8_WAIT_L(0); PG8_MMA(1, 0, At, B0); PG8_BAR; PG8_SCHED;
            PG8_STAGE(PG8_SB(1, 1), b3 + hstepB, voffB);
            PG8_WAIT_V(6); PG8_BAR; PG8_MMA(1, 1, At, B1); PG8_BAR;
        }
        epilogue(E, acc, cur);
        if (!has_next) break;
#pragma unroll
        for (int a = 0; a < 2; ++a)
#pragma unroll
            for (int b = 0; b < 2; ++b)
#pragma unroll
                for (int m = 0; m < 4; ++m)
#pragma unroll
                    for (int n = 0; n < 2; ++n) acc[a][b][m][n] = (f32x4){0.f, 0.f, 0.f, 0.f};
        cur = nxt; cA = nA; cB = nB; ++ui;
    }
    PG8_WAIT_V(0);
    if (wr == 0) PG8_BAR;
    PG8_BAR;
#undef PG8_SA
#undef PG8_SB
#undef PG8_STAGE
#undef PG8_LDA
#undef PG8_LDB
#undef PG8_MMA
#undef PG8_WAIT_V
#undef PG8_WAIT_L
#undef PG8_BAR
#undef PG8_SCHED
}

__device__ __forceinline__ int win_dst_row(int n0) {
    if (n0 < D || n0 >= 3 * D) return n0;
    const int isv = n0 >= 2 * D, ch = n0 - (isv ? 2 * D : D);
    return D + (ch >> 7) * 256 + isv * 128 + (ch & 127);
}
__device__ __forceinline__ void transpose_item(const float* W, int K, int N, bf16_t* WT, int wperm, LAS float* scr, int item, int lane) {
    const int nblk = N / 32, kb = item / nblk, nb = item % nblk, k0 = 64 * kb, n0 = 32 * nb;
#pragma unroll 8
    for (int i = 0; i < 32; ++i) { const int kk = 2 * i + (lane >> 5); scr[kk * 33 + (lane & 31)] = W[(size_t)(k0 + kk) * N + n0 + (lane & 31)]; }
    LDS_WAIT(); asm volatile("" ::: "memory");
    const int c = lane & 7;
    const int drow0 = wperm ? win_dst_row(n0) : n0;
#pragma unroll
    for (int j = 0; j < 4; ++j) { const int n = (lane >> 3) + 8 * j; const LAS float* s = scr + (8 * c) * 33 + n;
        u32x4 o; o.x = cvt_pk_bf16(s[0 * 33], s[1 * 33]); o.y = cvt_pk_bf16(s[2 * 33], s[3 * 33]); o.z = cvt_pk_bf16(s[4 * 33], s[5 * 33]); o.w = cvt_pk_bf16(s[6 * 33], s[7 * 33]);
        *(u32x4*)(WT + (size_t)(drow0 + n) * K + k0 + 8 * c) = o; }
    LDS_WAIT(); asm volatile("" ::: "memory");
}
__device__ __forceinline__ void transpose_matrix(const float* W, int K, int N, bf16_t* WT, int wperm, LAS float* scr, int gw, int NGW, int lane, int& off) {
    const int nitems = (K / 64) * (N / 32);
    int start = gw - (off % NGW); if (start < 0) start += NGW;
    for (int it = start; it < nitems; it += NGW) transpose_item(W, K, N, WT, wperm, scr, it, lane);
    off += nitems;
}

__global__ void __launch_bounds__(512, 2) fwd_megakernel(Params p) {
    extern __shared__ __attribute__((aligned(16))) unsigned char shm[];
    LAS unsigned char* lds = (LAS unsigned char*)shm;
    cg::grid_group grid = cg::this_grid();
    const int tid = threadIdx.x;
    const int G = (int)gridDim.x, NGW = G * 8;
    unsigned char* ws = p.ws;
    bf16_t* S0 = (bf16_t*)(ws + 0 * SLOT); bf16_t* S1 = (bf16_t*)(ws + 1 * SLOT); bf16_t* S2 = (bf16_t*)(ws + 2 * SLOT);
    bf16_t* S3 = (bf16_t*)(ws + 3 * SLOT); bf16_t* S4 = (bf16_t*)(ws + 4 * SLOT); bf16_t* S5 = (bf16_t*)(ws + 5 * SLOT);
    bf16_t* WIN = (bf16_t*)(ws + WS_WIN);
    float* X = p.out + O_Y;

#if !USE_CG_ONLY
    volatile LAS unsigned* xbst = (volatile LAS unsigned*)(lds + STAGE_BYTES);
    if (tid == 0) { xbst[0] = 0u; xbst[1] = 0u; xbst[2] = 0u; xbst[3] = 0u; }
    __syncthreads();
    XcdBarrier xb = xcd_barrier_post((unsigned*)(ws + WS_BAR), xbst);
#define GRID_BAR() xcd_barrier(xb)
#else
#define GRID_BAR() grid.sync()
#endif

    for (int rep0 = 0; rep0 < (p.pad == 1 ? 2 : 1); ++rep0) {
        const int lane = tid & 63, wid = tid >> 6, gw = (int)blockIdx.x * 8 + wid;
        LAS float* scr = (LAS float*)(lds + wid * 16384);
        int off = 0;
        transpose_matrix(p.in[4], D, DIN, WIN, 1, scr, gw, NGW, lane, off);
        for (int l = 0; l < NL; ++l) {
            unsigned char* wl = ws + WS_WL + (size_t)l * WL_BYTES;
            transpose_matrix(p.in[7] + (size_t)l * D * D, D, D, (bf16_t*)(wl + WL_WC), 0, scr, gw, NGW, lane, off);
            transpose_matrix(p.in[10] + (size_t)l * D * D, D, D, (bf16_t*)(wl + WL_WP), 0, scr, gw, NGW, lane, off);
            transpose_matrix(p.in[11] + (size_t)l * D * D, D, D, (bf16_t*)(wl + WL_WO), 0, scr, gw, NGW, lane, off);
            for (int gi = 0; gi < 4; ++gi)
                transpose_matrix(p.in[8] + (size_t)l * 4 * 65536 + (size_t)gi * 65536, 256, 256, (bf16_t*)(wl + WL_POOL) + (size_t)gi * 65536, 0, scr, gw, NGW, lane, off);
            transpose_matrix(p.in[14] + (size_t)l * D * DFF, D, DFF, (bf16_t*)(wl + WL_UP), 0, scr, gw, NGW, lane, off);
            transpose_matrix(p.in[15] + (size_t)l * DFF * D, DFF, D, (bf16_t*)(wl + WL_DOWN), 0, scr, gw, NGW, lane, off);
        }
        for (int i = (int)blockIdx.x * 512 + tid; i < (MPAD - MTOT) * D / 8; i += G * 512) *(u32x4*)(S0 + (size_t)MTOT * D + (size_t)i * 8) = (u32x4){0u, 0u, 0u, 0u};
        const float* gpre = p.in[12];
        f32x4 gv[4];
#pragma unroll
        for (int j = 0; j < 4; ++j) gv[j] = *(const f32x4*)(gpre + lane * 4 + 256 * j);
        for (int r = gw; r < MTOT; r += NGW) {
            const float* xr = r < MP ? p.in[0] + (size_t)r * D : p.in[1] + (size_t)(r - MP) * D;
            f32x4 v[4]; float s = 0.f;
#pragma unroll
            for (int j = 0; j < 4; ++j) { v[j] = *(const f32x4*)(xr + lane * 4 + 256 * j); s += (v[j][0] * v[j][0] + v[j][1] * v[j][1]) + (v[j][2] * v[j][2] + v[j][3] * v[j][3]); }
            const float rs = rsqrtf(wave_sum(s) * (1.f / D) + EPS);
#pragma unroll
            for (int j = 0; j < 4; ++j) { u32x2 o; o.x = cvt_pk_bf16(v[j][0] * rs * gv[j][0], v[j][1] * rs * gv[j][1]); o.y = cvt_pk_bf16(v[j][2] * rs * gv[j][2], v[j][3] * rs * gv[j][3]);
                *(u32x2*)(S0 + (size_t)r * D + lane * 4 + 256 * j) = o; }
        }
    }
    grid.sync();

    for (int step = 0; step < NL * 10; ++step) {
        const int l = step / 10, ph = step - l * 10;
        int tid_s = threadIdx.x; asm volatile("" : "+v"(tid_s));
        const int lane = tid_s & 63, wid = tid_s >> 6, gw = (int)blockIdx.x * 8 + wid;
        unsigned char* wl = ws + WS_WL + (size_t)l * WL_BYTES;
        Gemm g{S0, WIN, D, D, D, MPAD / BM, D / BM, 0};
        Epi E{E_PLAIN, D, S1, nullptr, nullptr, nullptr, ws};
        bool is_gemm = true;
        switch (ph) {
        case 0:
            g.nN = DIN / BM; E.id = E_PROJ; E.vec = p.in[5] + (size_t)l * 2 * D; break;
        case 2:
            g.Bt = (const bf16_t*)(wl + WL_POOL); g.ldb = 256; g.K = 256; g.nN = 4; g.a_pn_off = 256;
            E.id = E_SCALE; E.o0 = S2; E.vec = p.in[9] + (size_t)l * D; break;
        case 3:
            g.A = S1; g.Bt = (const bf16_t*)(wl + WL_WC); E.id = E_GATE; E.o0 = S3; E.x0 = S4; break;
        case 4:
            g.A = S2; g.Bt = (const bf16_t*)(wl + WL_WP); E.id = E_GATEADD; E.o0 = S0; E.x0 = S5; E.x1 = S3; break;
        case 5:
            g.Bt = (const bf16_t*)(wl + WL_WO); break;
        case 7:
            g.Bt = (const bf16_t*)(wl + WL_UP); g.nN = DFF / BM; E.id = E_RELU2; E.ldc = DFF; break;
        case 8:
            g.A = S1; g.Bt = (const bf16_t*)(wl + WL_DOWN); g.lda = DFF; g.ldb = DFF; g.K = DFF; E.o0 = S5; break;
        default: is_gemm = false; break;
        }
        if (SKELETON || step > p.stop) { if (step == 0 && blockIdx.x == 0 && tid == 0) p.out[0] = 1.f; }
        else if (is_gemm) {
            StaticOrder S; S.init(g.nM, g.nN, G, (int)blockIdx.x);
            for (int rep = 0; rep < (p.pad == 10 + ph ? 2 : 1); ++rep) gemm_phase(lds, g, S, E);
        } else if (ph == 1) {
            const float* cw = p.in[6] + (size_t)l * 3 * D;
            const float* cconv = p.in[2] + (size_t)l * NB_S * 2 * D;
            const float* cpool = p.in[3] + (size_t)l * NB_S * 15 * D;
            float* o_csp = p.out + O_CSP + (size_t)l * 2 * D;
            float* o_psp = p.out + O_PSP + (size_t)l * 15 * D;
            float* o_css = p.out + O_CSS + (size_t)l * NB_S * 2 * D;
            float* o_pss = p.out + O_PSS + (size_t)l * NB_S * 15 * D;
            constexpr int NSLOW = (16 + MS) / 2 * 4;
            constexpr int NFAST = ((MP / 16 - 1) * 4 + 1) / 2;
            for (int it = gw; it < NSLOW + NFAST; it += NGW) {
                if (it < NSLOW) {
                    const int gi = it & 3, rr = (it >> 2) * 2 + (lane >> 5), r = rr < 16 ? rr : MP + (rr - 16), ch = gi * 256 + (lane & 31) * 8;
                    const bool smp = r >= MP;
                    const int sb = smp ? (r - MP) >> 4 : 0, t = smp ? (r - MP) & 15 : r;
                    f32x4 b0, b1, z0a, z0b, z1a, z1b, z2a, z2b, p0a, p0b;
                    ld8(S1 + (size_t)r * D + ch, b0, b1);
                    ld8(S2 + (size_t)r * D + ch, z0a, z0b);
                    ld8(S3 + (size_t)r * D + ch, p0a, p0b);
                    if (t >= 1) ld8(S2 + (size_t)(r - 1) * D + ch, z1a, z1b);
                    else if (smp) { const float* q = cconv + ((size_t)sb * 2 + 1) * D + ch; z1a = *(const f32x4*)q; z1b = *(const f32x4*)(q + 4); }
                    else { z1a = (f32x4){0.f, 0.f, 0.f, 0.f}; z1b = z1a; }
                    if (t >= 2) ld8(S2 + (size_t)(r - 2) * D + ch, z2a, z2b);
                    else if (smp) { const float* q = cconv + ((size_t)sb * 2 + t) * D + ch; z2a = *(const f32x4*)q; z2b = *(const f32x4*)(q + 4); }
                    else { z2a = (f32x4){0.f, 0.f, 0.f, 0.f}; z2b = z2a; }
                    const f32x4 w0a = *(const f32x4*)(cw + ch), w0b = *(const f32x4*)(cw + ch + 4);
                    const f32x4 w1a = *(const f32x4*)(cw + D + ch), w1b = *(const f32x4*)(cw + D + ch + 4);
                    const f32x4 w2a = *(const f32x4*)(cw + 2 * D + ch), w2b = *(const f32x4*)(cw + 2 * D + ch + 4);
                    const f32x4 ya0 = b0 * (w0a * z2a + w1a * z1a + w2a * z0a), ya1 = b1 * (w0b * z2b + w1b * z1b + w2b * z0b);
                    const int w = 2 << gi;
                    f32x4 sa = p0a, sb2 = p0b;
                    for (int i = 1; i < w; ++i) {
                        f32x4 qa, qb;
                        if (t - i >= 0) ld8(S3 + (size_t)(r - i) * D + ch, qa, qb);
                        else if (smp) { const float* q = cpool + ((size_t)sb * 15 + (15 + t - i)) * D + ch; qa = *(const f32x4*)q; qb = *(const f32x4*)(q + 4); }
                        else { qa = (f32x4){0.f, 0.f, 0.f, 0.f}; qb = qa; }
                        sa += qa; sb2 += qb;
                    }
                    const int cnt = smp ? w : (t + 1 < w ? t + 1 : w);
                    const float ic = 1.0f / (float)cnt;
                    st8(S1 + (size_t)r * D + ch, ya0, ya1);
                    st8(S0 + (size_t)r * D + ch, sa * ic - p0a, sb2 * ic - p0b);
                    if (smp) {
                        if (t >= SEQ_S - 2) { float* o = o_css + ((size_t)sb * 2 + (t - (SEQ_S - 2))) * D + ch; *(f32x4*)o = z0a; *(f32x4*)(o + 4) = z0b; }
                        if (t >= 1) { float* o = o_pss + ((size_t)sb * 15 + (t - 1)) * D + ch; *(f32x4*)o = p0a; *(f32x4*)(o + 4) = p0b; }
                    }
                } else {
                    const int hi = (it - NSLOW) * 2 + (lane >> 5);
                    if (hi < (MP / 16 - 1) * 4) {
                        const int gi = hi & 3, r0 = ((hi >> 2) + 1) * 16, ch = gi * 256 + (lane & 31) * 8, w = 2 << gi;
                        const float ic = 1.0f / (float)w;
                        const f32x4 w0a = *(const f32x4*)(cw + ch), w0b = *(const f32x4*)(cw + ch + 4);
                        const f32x4 w1a = *(const f32x4*)(cw + D + ch), w1b = *(const f32x4*)(cw + D + ch + 4);
                        const f32x4 w2a = *(const f32x4*)(cw + 2 * D + ch), w2b = *(const f32x4*)(cw + 2 * D + ch + 4);
                        f32x4 z1a, z1b, z2a, z2b;
                        ld8(S2 + (size_t)(r0 - 1) * D + ch, z1a, z1b);
                        ld8(S2 + (size_t)(r0 - 2) * D + ch, z2a, z2b);
                        f32x4 sa = (f32x4){0.f, 0.f, 0.f, 0.f}, sb2 = sa;
                        for (int i = 1; i < w; ++i) { f32x4 qa, qb; ld8(S3 + (size_t)(r0 - i) * D + ch, qa, qb); sa += qa; sb2 += qb; }
#pragma unroll 4
                        for (int k = 0; k < 16; ++k) {
                            const size_t ro = (size_t)(r0 + k) * D + ch;
                            f32x4 b0, b1, z0a, z0b, p0a, p0b, oa, ob;
                            ld8(S1 + ro, b0, b1);
                            ld8(S2 + ro, z0a, z0b);
                            ld8(S3 + ro, p0a, p0b);
                            ld8(S3 + ro - (size_t)(w - 1) * D, oa, ob);
                            sa += p0a; sb2 += p0b;
                            st8(S1 + ro, b0 * (w0a * z2a + w1a * z1a + w2a * z0a), b1 * (w0b * z2b + w1b * z1b + w2b * z0b));
                            st8(S0 + ro, sa * ic - p0a, sb2 * ic - p0b);
                            sa -= oa; sb2 -= ob;
                            z2a = z1a; z2b = z1b; z1a = z0a; z1b = z0b;
                            const int t = r0 + k;
                            if (t >= MP - 2) { float* o = o_csp + (size_t)(t - (MP - 2)) * D + ch; *(f32x4*)o = z0a; *(f32x4*)(o + 4) = z0b; }
                            if (t >= MP - 15) { float* o = o_psp + (size_t)(t - (MP - 15)) * D + ch; *(f32x4*)o = p0a; *(f32x4*)(o + 4) = p0b; }
                        }
                    }
                }
            }
            if (l + 1 < NL) {
                LAS float* scr = (LAS float*)(lds + wid * 16384);
                int off = 0;
                transpose_matrix(p.in[4] + (size_t)(l + 1) * D * DIN, D, DIN, WIN, 1, scr, gw, NGW, lane, off);
            }
        } else {
            const int half = ph == 6 ? 0 : 1;
            const bf16_t* Y = half == 0 ? S1 : S5;
            const float* gpost = (half == 0 ? p.in[13] : p.in[17]) + (size_t)l * D;
            const bool has_next = true;
            const float* gnext = half == 0 ? p.in[16] + (size_t)l * D : p.in[12] + (size_t)(l + 1 < NL ? l + 1 : l) * D;
            const bool from_input = (l == 0 && half == 0);
            f32x4 gp[4], gn[4];
#pragma unroll
            for (int j = 0; j < 4; ++j) { gp[j] = *(const f32x4*)(gpost + lane * 4 + 256 * j); gn[j] = *(const f32x4*)(gnext + lane * 4 + 256 * j); }
            for (int r = gw; r < MTOT; r += NGW) {
                const float* xr = from_input ? (r < MP ? p.in[0] + (size_t)r * D : p.in[1] + (size_t)(r - MP) * D) : X + (size_t)r * D;
                f32x4 xv[4], yv[4]; float s = 0.f;
#pragma unroll
                for (int j = 0; j < 4; ++j) {
                    xv[j] = *(const f32x4*)(xr + lane * 4 + 256 * j);
                    const u32x2 wv = *(const u32x2*)(Y + (size_t)r * D + lane * 4 + 256 * j);
                    yv[j][0] = bf_lo(wv.x); yv[j][1] = bf_hi(wv.x); yv[j][2] = bf_lo(wv.y); yv[j][3] = bf_hi(wv.y);
                    s += (yv[j][0] * yv[j][0] + yv[j][1] * yv[j][1]) + (yv[j][2] * yv[j][2] + yv[j][3] * yv[j][3]);
                }
                const float rs = rsqrtf(wave_sum(s) * (1.f / D) + EPS);
                float s2 = 0.f;
#pragma unroll
                for (int j = 0; j < 4; ++j) { xv[j] = xv[j] + yv[j] * rs * gp[j]; s2 += (xv[j][0] * xv[j][0] + xv[j][1] * xv[j][1]) + (xv[j][2] * xv[j][2] + xv[j][3] * xv[j][3]);
                    *(f32x4*)(X + (size_t)r * D + lane * 4 + 256 * j) = xv[j]; }
                if (has_next) {
                    const float rs2 = rsqrtf(wave_sum(s2) * (1.f / D) + EPS);
#pragma unroll
                    for (int j = 0; j < 4; ++j) { u32x2 o; o.x = cvt_pk_bf16(xv[j][0] * rs2 * gn[j][0], xv[j][1] * rs2 * gn[j][1]); o.y = cvt_pk_bf16(xv[j][2] * rs2 * gn[j][2], xv[j][3] * rs2 * gn[j][3]);
                        *(u32x2*)(S0 + (size_t)r * D + lane * 4 + 256 * j) = o; }
                }
            }
        }
        if (step + 1 < NL * 10) GRID_BAR();
    }
}

extern "C" void kernel_launch(void* const* d_in, const int* in_sizes, int n_in, void* d_out, int out_size, void* d_ws, size_t ws_size, hipStream_t stream) {
    static int grid = 0;
    if (grid == 0) {
        if (n_in != 18 || ws_size < WS_END) { fprintf(stderr, "kernel_launch: unexpected n_in %d or ws_size %zu (< %zu)\n", n_in, ws_size, (size_t)WS_END); grid = -1; return; }
        int dev = 0, cus = 0, per_cu = 0;
        hipGetDevice(&dev);
        hipDeviceGetAttribute(&cus, hipDeviceAttributeMultiprocessorCount, dev);
        if (hipFuncSetAttribute((const void*)fwd_megakernel, hipFuncAttributeMaxDynamicSharedMemorySize, LDS_BYTES) != hipSuccess) { fprintf(stderr, "kernel_launch: hipFuncSetAttribute failed\n"); grid = -1; return; }
        if (hipOccupancyMaxActiveBlocksPerMultiprocessor(&per_cu, (const void*)fwd_megakernel, 512, LDS_BYTES) != hipSuccess || per_cu < 1) { fprintf(stderr, "kernel_launch: occupancy query failed (%d)\n", per_cu); grid = -1; return; }
        grid = cus * per_cu;
    }
    if (grid < 0) return;
    (void)hipMemsetAsync((unsigned char*)d_ws + WS_BAR, 0, 16384, stream);
    Params p{};
    for (int i = 0; i < 18; ++i) p.in[i] = (const float*)d_in[i];
    p.out = (float*)d_out; p.ws = (unsigned char*)d_ws; p.stop = STOP_AFTER; p.pad = PROBE;
    void* args[] = {&p};
    hipError_t e = hipLaunchCooperativeKernel((const void*)fwd_megakernel, dim3(grid), dim3(512), args, LDS_BYTES, stream);
    if (e != hipSuccess) fprintf(stderr, "cooperative launch failed: %s (grid %d)\n", hipGetErrorString(e), grid);
}
```

```cpp
#include <hip/hip_runtime.h>
#include <hip/hip_cooperative_groups.h>
#include <cstdio>
namespace cg = cooperative_groups;

#ifndef SKELETON
#define SKELETON 0
#endif
#ifndef STOP_AFTER
#define STOP_AFTER 99
#endif
#ifndef PROBE
#define PROBE 0
#endif
#ifndef USE_CG_ONLY
#define USE_CG_ONLY 0
#endif

#define LAS __attribute__((address_space(3)))
typedef unsigned short bf16_t;
typedef short bf16x8 __attribute__((ext_vector_type(8)));
typedef float f32x4 __attribute__((ext_vector_type(4)));
typedef unsigned u32x4 __attribute__((ext_vector_type(4)));
typedef unsigned u32x2 __attribute__((ext_vector_type(2)));

constexpr int D = 1024, DIN = 6144, DFF = 4096, NL = 2;
constexpr int MP = 16384, MS = 128, MTOT = MP + MS, MPAD = MP;
constexpr int SEQ_S = 16, NB_S = 8, PAST = 2048;
constexpr int BM = 256, BK = 64, HALF = 128, HTB = HALF * BK * 2, STAGE_BYTES = 8 * HTB, NXCD = 8, WGM = 8;
constexpr int LDS_BYTES = STAGE_BYTES + 64;
constexpr float EPS = 1e-6f;

constexpr size_t SLOT = (size_t)MPAD * 1024 * 2;
constexpr size_t WS_WIN = 6 * SLOT;
constexpr size_t WIN_BYTES = (size_t)DIN * D * 2;
constexpr size_t WL_WC = 0, WL_WP = 2097152, WL_WO = 4194304, WL_POOL = 6291456, WL_UP = 6815744, WL_DOWN = 15204352, WL_BYTES = 23592960;
constexpr size_t WS_WL = WS_WIN + WIN_BYTES;
constexpr size_t WS_BAR = WS_WL + NL * WL_BYTES;
constexpr size_t WS_SM = WS_BAR + 16384;
constexpr size_t SM_PROJ = 0, SM_M1 = 3145728, SM_YACC = 3670016, SM_FACC = 4194304, SM_HS = 4718592, SM_YAS = 4980736, SM_DDS = 5242880, SM_YBS = 5505024, SM_MRG = 5767168, SM_US = 6029312, SM_BYTES = 7077888;
constexpr size_t WS_END = WS_SM + SM_BYTES;

constexpr size_t O_Y = 0, O_CSP = (size_t)MTOT * D, O_PSP = O_CSP + NL * 2 * D, O_CSS = O_PSP + NL * 15 * D, O_PSS = O_CSS + (size_t)NL * NB_S * 2 * D;

struct Params {
    const float* in[18];
    float* out;
    unsigned char* ws;
    int nsteps, pad;
};

__device__ __forceinline__ unsigned cvt_pk_bf16(float lo, float hi) { unsigned r; asm volatile("v_cvt_pk_bf16_f32 %0, %1, %2" : "=v"(r) : "v"(lo), "v"(hi)); return r; }
__device__ __forceinline__ float bf_lo(unsigned w) { return __uint_as_float(w << 16); }
__device__ __forceinline__ float bf_hi(unsigned w) { return __uint_as_float(w & 0xffff0000u); }
__device__ __forceinline__ void st8(bf16_t* p, f32x4 a, f32x4 b) {
    u32x4 w; w.x = cvt_pk_bf16(a[0], a[1]); w.y = cvt_pk_bf16(a[2], a[3]); w.z = cvt_pk_bf16(b[0], b[1]); w.w = cvt_pk_bf16(b[2], b[3]);
    *(u32x4*)p = w;
}
__device__ __forceinline__ void ld8(const bf16_t* p, f32x4& a, f32x4& b) {
    const u32x4 w = *(const u32x4*)p;
    a[0] = bf_lo(w.x); a[1] = bf_hi(w.x); a[2] = bf_lo(w.y); a[3] = bf_hi(w.y);
    b[0] = bf_lo(w.z); b[1] = bf_hi(w.z); b[2] = bf_lo(w.w); b[3] = bf_hi(w.w);
}
__device__ __forceinline__ float sigmoidf_(float x) { return 1.0f / (1.0f + __expf(-x)); }
__device__ __forceinline__ float wave_sum(float v) {
#pragma unroll
    for (int o = 1; o < 64; o <<= 1) v += __shfl_xor(v, o);
    return v;
}
#define LDS_WAIT() asm volatile("s_waitcnt lgkmcnt(0)" ::: "memory")

#define XB_TMO      128
#define XB_XCNT(j)  (256  + 64 * (j))
#define XB_XSUB(j)  (1280 + 64 * (j))
#define XB_XGEN(j)  (2304 + 64 * (j))
#define XB_TOP      3328
#define XB_TOPGEN   3392
#define XCD_BAR_WORDS 3456
#define XB_SPIN_CAP (1u << 18)
__device__ __forceinline__ unsigned xb_ld(unsigned* p)              { return __hip_atomic_load(p, __ATOMIC_RELAXED, __HIP_MEMORY_SCOPE_AGENT); }
__device__ __forceinline__ unsigned xb_add(unsigned* p, unsigned v) { return __hip_atomic_fetch_add(p, v, __ATOMIC_RELAXED, __HIP_MEMORY_SCOPE_AGENT); }
__device__ __forceinline__ unsigned xb_xcc_id() { return (unsigned)__builtin_amdgcn_s_getreg((3 << 11) | 20) & 0xFu; }
#define XB_SPIN(cond, bar) do { unsigned _sp = 0; while (cond) { __builtin_amdgcn_s_sleep(1); \
    if ((++_sp & 255u) == 0u) { if (xb_ld(&(bar)[XB_TMO])) break; if (_sp > XB_SPIN_CAP) { atomicAdd(&(bar)[XB_TMO], 1u); break; } } } } while (0)
struct XcdBarrier { unsigned* bar; unsigned x; volatile LAS unsigned* st; };
__device__ __forceinline__ XcdBarrier xcd_barrier_post(unsigned* bar, volatile LAS unsigned* st) {
    XcdBarrier b; b.bar = bar; b.x = xb_xcc_id(); b.st = st;
    if (threadIdx.x == 0) (void)xb_add(&bar[XB_XCNT(b.x)], 1u);
    return b;
}
__device__ __forceinline__ void xcd_barrier_complete(unsigned* bar, unsigned x, unsigned& nloc, unsigned& nx) {
    const unsigned G = gridDim.x * gridDim.y * gridDim.z;
    unsigned sum, cnt, mine, sp = 0u;
    for (;;) {
        sum = 0u; cnt = 0u; mine = 0u;
#pragma unroll
        for (unsigned j = 0; j < 16; ++j) { const unsigned c = xb_ld(&bar[XB_XCNT(j)]); sum += c; cnt += (c > 0u) ? 1u : 0u; mine = (j == x) ? c : mine; }
        if (sum == G) break;
        __builtin_amdgcn_s_sleep(1);
        if ((++sp & 255u) == 0u) { if (xb_ld(&bar[XB_TMO])) break; if (sp > XB_SPIN_CAP) { atomicAdd(&bar[XB_TMO], 1u); break; } }
    }
    nloc = mine > 0u ? mine : 1u; nx = cnt > 0u ? cnt : 1u;
}
__device__ __forceinline__ void xcd_barrier(const XcdBarrier& b) {
    asm volatile("s_waitcnt vmcnt(0)" ::: "memory");
    __syncthreads();
    if (threadIdx.x == 0) {
        unsigned* bar = b.bar;
        __builtin_amdgcn_s_waitcnt(0);
        unsigned nloc = b.st[0], nx = b.st[1];
        if (nloc == 0u) { xcd_barrier_complete(bar, b.x, nloc, nx); b.st[0] = nloc; b.st[1] = nx; }
        const unsigned old = xb_add(&bar[XB_XSUB(b.x)], 1u);
        const unsigned gen = old / nloc;
        if (old + 1u == (gen + 1u) * nloc) {
            __builtin_amdgcn_fence(__ATOMIC_RELEASE, "agent");
            asm volatile("s_waitcnt vmcnt(0)" ::: "memory");
            const unsigned og = xb_add(&bar[XB_TOP], 1u);
            const unsigned tg = og / nx;
            if (og + 1u == (tg + 1u) * nx) xb_add(&bar[XB_TOPGEN], 1u);
            else XB_SPIN(xb_ld(&bar[XB_TOPGEN]) == tg, bar);
            __builtin_amdgcn_fence(__ATOMIC_ACQUIRE, "agent");
            xb_add(&bar[XB_XGEN(b.x)], 1u);
            asm volatile("s_waitcnt vmcnt(0)" ::: "memory");
        } else {
            XB_SPIN(xb_ld(&bar[XB_XGEN(b.x)]) == gen, bar);
            __builtin_amdgcn_fence(__ATOMIC_ACQUIRE, "agent");
            asm volatile("s_waitcnt vmcnt(0)" ::: "memory");
        }
    }
    __syncthreads();
}

__device__ __forceinline__ int lds_byte(int r, int c) { const int st = (r >> 4) * 2 + (c >> 5), rr = r & 15, cc = c & 31, ob = rr * 64 + cc * 2; return st * 1024 + (ob ^ (((ob >> 9) & 1) << 5)); }
__device__ __forceinline__ void stage_rc(int b, int& R, int& C) { const int st = b / 1024, sb = b % 1024, swz = sb ^ (((sb >> 9) & 1) << 5); R = (st >> 1) * 16 + swz / 64; C = (st & 1) * 32 + (swz % 64) / 2; }
__device__ __forceinline__ int perm32(int rho) { const int n = rho >> 4, i = rho & 15; return 8 * (i >> 2) + 4 * n + (i & 3); }

struct Unit { int pm, pn; };
struct Gemm { const bf16_t* A; const bf16_t* Bt; int lda, ldb, K, nM, nN, a_pn_off; };
struct StaticOrder {
    int nM, nN, nwg, G, c;
    __device__ void init(int nM_, int nN_, int G_, int c_) { nM = nM_; nN = nN_; nwg = nM * nN; G = G_; c = c_; }
    __device__ bool next(int i, Unit& u) const {
        const long L = (long)i * G + c; if (L >= nwg) return false;
        int wgid = (int)L; { const int q = nwg / NXCD, r = nwg % NXCD, xcd = wgid % NXCD, off = wgid / NXCD; wgid = (xcd < r ? xcd * (q + 1) : r * (q + 1) + (xcd - r) * q) + off; }
        const int nig = WGM * nN, gid = wgid / nig, fm = gid * WGM, gsz = (nM - fm) < WGM ? (nM - fm) : WGM;
        u.pm = fm + ((wgid % nig) % gsz); u.pn = (wgid % nig) / gsz; return true;
    }
};

enum { E_PROJ = 0, E_SCALE = 1, E_GATE = 2, E_GATEADD = 3, E_PLAIN = 4, E_RELU2 = 5 };
struct Epi { int id, ldc; bf16_t* o0; const bf16_t* x0; const bf16_t* x1; const float* vec; unsigned char* ws; };

__device__ __forceinline__ void epilogue(const Epi& E, const f32x4 (&acc)[2][2][4][2], const Unit& u) {
    int tl = threadIdx.x; asm volatile("" : "+v"(tl));
    const int wv = tl >> 6, ln = tl & 63, wr = wv >> 2, wc = wv & 3, fr = ln & 15, fq = ln >> 4;
    const int row0 = u.pm * BM + wr * 64 + fr;
    const int colw = wc * 32 + 8 * fq;
    if (E.id == E_PROJ) {
        if (u.pn >= 4 && u.pn < 12) {
            const int ch = (u.pn - 4) * 128 + colw;
#pragma unroll
            for (int ai = 0; ai < 2; ++ai)
#pragma unroll
                for (int m = 0; m < 4; ++m) {
                    const size_t r = (size_t)(row0 + ai * HALF + m * 16);
                    st8((bf16_t*)(E.ws + 2 * SLOT) + r * D + ch, acc[ai][0][m][0] * acc[ai][1][m][0], acc[ai][0][m][1] * acc[ai][1][m][1]);
                }
        } else if (u.pn >= 16) {
            const int gc0 = (u.pn - 16) * BM;
            bf16_t* O = (bf16_t*)(E.ws + (gc0 < D ? 4 : 5) * SLOT);
            const int oc0 = gc0 & (D - 1);
#pragma unroll
            for (int bj = 0; bj < 2; ++bj) {
                const f32x4 b0 = *(const f32x4*)(E.vec + gc0 + bj * HALF + colw), b1 = *(const f32x4*)(E.vec + gc0 + bj * HALF + colw + 4);
#pragma unroll
                for (int ai = 0; ai < 2; ++ai)
#pragma unroll
                    for (int m = 0; m < 4; ++m) {
                        const size_t r = (size_t)(row0 + ai * HALF + m * 16);
                        f32x4 v0 = acc[ai][bj][m][0] + b0, v1 = acc[ai][bj][m][1] + b1;
#pragma unroll
                        for (int j = 0; j < 4; ++j) { v0[j] = sigmoidf_(v0[j]); v1[j] = sigmoidf_(v1[j]); }
                        st8(O + r * D + oc0 + bj * HALF + colw, v0, v1);
                    }
            }
        } else {
            bf16_t* O = (bf16_t*)(E.ws + (u.pn < 4 ? 1 : 3) * SLOT);
            const int oc0 = (u.pn & 3) * BM;
#pragma unroll
            for (int ai = 0; ai < 2; ++ai)
#pragma unroll
                for (int m = 0; m < 4; ++m) {
                    const size_t r = (size_t)(row0 + ai * HALF + m * 16);
#pragma unroll
                    for (int bj = 0; bj < 2; ++bj) st8(O + r * D + oc0 + bj * HALF + colw, acc[ai][bj][m][0], acc[ai][bj][m][1]);
                }
        }
        return;
    }
    const int col0 = u.pn * BM + colw;
    if (E.id == E_SCALE) {
#pragma unroll
        for (int bj = 0; bj < 2; ++bj) {
            const f32x4 s0 = *(const f32x4*)(E.vec + col0 + bj * HALF), s1 = *(const f32x4*)(E.vec + col0 + bj * HALF + 4);
#pragma unroll
            for (int ai = 0; ai < 2; ++ai)
#pragma unroll
                for (int m = 0; m < 4; ++m) {
                    const size_t r = (size_t)(row0 + ai * HALF + m * 16);
                    st8(E.o0 + r * E.ldc + col0 + bj * HALF, acc[ai][bj][m][0] * s0, acc[ai][bj][m][1] * s1);
                }
        }
    } else if (E.id == E_GATE) {
#pragma unroll
        for (int ai = 0; ai < 2; ++ai)
#pragma unroll
            for (int m = 0; m < 4; ++m) {
                const size_t r = (size_t)(row0 + ai * HALF + m * 16);
#pragma unroll
                for (int bj = 0; bj < 2; ++bj) {
                    f32x4 g0, g1; ld8(E.x0 + r * D + col0 + bj * HALF, g0, g1);
                    st8(E.o0 + r * E.ldc + col0 + bj * HALF, acc[ai][bj][m][0] * g0, acc[ai][bj][m][1] * g1);
                }
                if (m == 3) asm volatile("" ::: "memory");
            }
    } else if (E.id == E_GATEADD) {
#pragma unroll
        for (int ai = 0; ai < 2; ++ai)
#pragma unroll
            for (int m = 0; m < 4; ++m) {
                const size_t r = (size_t)(row0 + ai * HALF + m * 16);
#pragma unroll
                for (int bj = 0; bj < 2; ++bj) {
                    f32x4 g0, g1, a0, a1; ld8(E.x0 + r * D + col0 + bj * HALF, g0, g1); ld8(E.x1 + r * D + col0 + bj * HALF, a0, a1);
                    st8(E.o0 + r * E.ldc + col0 + bj * HALF, a0 + acc[ai][bj][m][0] * g0, a1 + acc[ai][bj][m][1] * g1);
                }
                if (m & 1) asm volatile("" ::: "memory");
            }
    } else if (E.id == E_RELU2) {
#pragma unroll
        for (int ai = 0; ai < 2; ++ai)
#pragma unroll
            for (int m = 0; m < 4; ++m) {
                const size_t r = (size_t)(row0 + ai * HALF + m * 16);
#pragma unroll
                for (int bj = 0; bj < 2; ++bj) {
                    f32x4 v0 = acc[ai][bj][m][0], v1 = acc[ai][bj][m][1];
#pragma unroll
                    for (int j = 0; j < 4; ++j) { const float a = fmaxf(v0[j], 0.f), b = fmaxf(v1[j], 0.f); v0[j] = a * a; v1[j] = b * b; }
                    st8(E.o0 + r * E.ldc + col0 + bj * HALF, v0, v1);
                }
            }
    } else {
#pragma unroll
        for (int ai = 0; ai < 2; ++ai)
#pragma unroll
            for (int m = 0; m < 4; ++m) {
                const size_t r = (size_t)(row0 + ai * HALF + m * 16);
#pragma unroll
                for (int bj = 0; bj < 2; ++bj) st8(E.o0 + r * E.ldc + col0 + bj * HALF, acc[ai][bj][m][0], acc[ai][bj][m][1]);
            }
    }
}

__device__ __forceinline__ void gemm_phase(LAS unsigned char* lds, const Gemm g, const StaticOrder& S, const Epi& E) {
    const int tid = threadIdx.x, wid = __builtin_amdgcn_readfirstlane(tid >> 6), lane = tid & 63, wr = wid >> 2, wc = wid & 3, fr = lane & 15, fq = lane >> 4;
    const int nt = g.K / BK;
    unsigned voffA[2], voffB[2];
#pragma unroll
    for (int i = 0; i < 2; ++i) { int R, C; stage_rc(tid * 16 + i * 8192, R, C); const int Rb = (R & ~31) + perm32(R & 31);
        voffA[i] = (unsigned)(R * g.lda + C) * 2u; voffB[i] = (unsigned)(Rb * g.ldb + C) * 2u; }
    const size_t kstep = (size_t)(BK * 2);
    const size_t hstepA = (size_t)HALF * g.lda * 2, hstepB = (size_t)HALF * g.ldb * 2;
    const size_t tstepA = 2 * hstepA, tstepB = 2 * hstepB;
    const size_t pnoffA = (size_t)g.a_pn_off * 2;
    const unsigned ldsw = (unsigned)wid * 1024u;
    const int aoff = lds_byte(wr * 64 + fr, fq * 8), boff = lds_byte(wc * 32 + fr, fq * 8);
#define PG8_SA(b, h) (((b) * 2 + (h)) * HTB)
#define PG8_SB(b, h) ((4 + (b) * 2 + (h)) * HTB)
#define PG8_STAGE(bufoff, gbase, voff) do { _Pragma("unroll") for (int _i = 0; _i < 2; ++_i) \
        __builtin_amdgcn_global_load_lds((const unsigned*)((const char*)(gbase) + (voff)[_i]), (LAS unsigned*)(lds + (bufoff) + ldsw + _i * 8192), 16, 0, 0); } while (0)
#define PG8_LDA(dst, b, h) do { _Pragma("unroll") for (int m = 0; m < 4; ++m) _Pragma("unroll") for (int k = 0; k < 2; ++k) dst[m][k] = *(const LAS bf16x8*)(lds + PG8_SA(b, h) + aoff + m * 2048 + k * 1024); } while (0)
#define PG8_LDB(dst, b, h) do { _Pragma("unroll") for (int n = 0; n < 2; ++n) _Pragma("unroll") for (int k = 0; k < 2; ++k) dst[n][k] = *(const LAS bf16x8*)(lds + PG8_SB(b, h) + boff + n * 2048 + k * 1024); } while (0)
#define PG8_MMA(ai, bj, At, Bt) do { __builtin_amdgcn_s_setprio(1); _Pragma("unroll") for (int m = 0; m < 4; ++m) _Pragma("unroll") for (int n = 0; n < 2; ++n) _Pragma("unroll") for (int k = 0; k < 2; ++k) \
        acc[ai][bj][m][n] = __builtin_amdgcn_mfma_f32_16x16x32_bf16(Bt[n][k], At[m][k], acc[ai][bj][m][n], 0, 0, 0); __builtin_amdgcn_s_setprio(0); } while (0)
#define PG8_WAIT_V(n) asm volatile("s_waitcnt vmcnt(" #n ")" ::: "memory")
#define PG8_WAIT_L(n) asm volatile("s_waitcnt lgkmcnt(" #n ")" ::: "memory")
#define PG8_BAR __builtin_amdgcn_s_barrier()
#define PG8_SCHED __builtin_amdgcn_sched_barrier(0)
    Unit cur, nxt; int ui = 0;
    if (!S.next(0, cur)) return;
    f32x4 acc[2][2][4][2];
#pragma unroll
    for (int a = 0; a < 2; ++a)
#pragma unroll
        for (int b = 0; b < 2; ++b)
#pragma unroll
            for (int m = 0; m < 4; ++m)
#pragma unroll
                for (int n = 0; n < 2; ++n) acc[a][b][m][n] = (f32x4){0.f, 0.f, 0.f, 0.f};
    bf16x8 At[4][2], B0[2][2], B1[2][2];
    const char* cA = (const char*)g.A + (size_t)cur.pm * tstepA + (size_t)cur.pn * pnoffA; const char* cB = (const char*)g.Bt + (size_t)cur.pn * tstepB;
    PG8_STAGE(PG8_SB(0, 0), cB, voffB); PG8_STAGE(PG8_SA(0, 0), cA, voffA); PG8_STAGE(PG8_SB(0, 1), cB + hstepB, voffB); PG8_STAGE(PG8_SA(0, 1), cA + hstepA, voffA);
    if (wr == 1) PG8_BAR;
    PG8_WAIT_V(4); PG8_BAR;
    PG8_STAGE(PG8_SB(1, 0), cB + kstep, voffB); PG8_STAGE(PG8_SA(1, 0), cA + kstep, voffA); PG8_STAGE(PG8_SB(1, 1), cB + hstepB + kstep, voffB);
    PG8_WAIT_V(6); PG8_BAR;
    for (;;) {
        const bool has_next = S.next(ui + 1, nxt);
        const char* nA = has_next ? (const char*)g.A + (size_t)nxt.pm * tstepA + (size_t)nxt.pn * pnoffA : cA; const char* nB = has_next ? (const char*)g.Bt + (size_t)nxt.pn * tstepB : cB;
        for (int t = 0; t < nt; t += 2) {
            const bool last = (t == nt - 2);
            const char* a1 = cA + (size_t)(t + 1) * kstep;
            const char* a2 = last ? nA : cA + (size_t)(t + 2) * kstep; const char* b2 = last ? nB : cB + (size_t)(t + 2) * kstep;
            const char* a3 = a2 + kstep; const char* b3 = b2 + kstep;
            PG8_LDB(B0, 0, 0); PG8_SCHED; PG8_LDA(At, 0, 0); PG8_STAGE(PG8_SA(1, 1), a1 + hstepA, voffA);
            PG8_WAIT_L(8); PG8_BAR; PG8_WAIT_L(0); PG8_MMA(0, 0, At, B0); PG8_BAR; PG8_SCHED;
            PG8_LDB(B1, 0, 1); PG8_STAGE(PG8_SB(0, 0), b2, voffB);
            PG8_BAR; PG8_WAIT_L(0); PG8_MMA(0, 1, At, B1); PG8_BAR;
            PG8_LDA(At, 0, 1); PG8_STAGE(PG8_SA(0, 0), a2, voffA);
            PG8_BAR; PG8_WAIT_L(0); PG8_MMA(1, 0, At, B0); PG8_BAR; PG8_SCHED;
            PG8_STAGE(PG8_SB(0, 1), b2 + hstepB, voffB);
            PG8_WAIT_V(6); PG8_BAR; PG8_MMA(1, 1, At, B1); PG8_BAR;
            PG8_LDB(B0, 1, 0); PG8_SCHED; PG8_LDA(At, 1, 0); PG8_STAGE(PG8_SA(0, 1), a2 + hstepA, voffA);
            PG8_WAIT_L(8); PG8_BAR; PG8_WAIT_L(0); PG8_MMA(0, 0, At, B0); PG8_BAR; PG8_SCHED;
            PG8_LDB(B1, 1, 1); PG8_STAGE(PG8_SB(1, 0), b3, voffB);
            PG8_BAR; PG8_WAIT_L(0); PG8_MMA(0, 1, At, B1); PG8_BAR;
            PG8_LDA(At, 1, 1); PG8_STAGE(PG8_SA(1, 0), a3, voffA);
            PG8_BAR; PG8_WAIT_L(0); PG8_MMA(1, 0, At, B0); PG8_BAR; PG8_SCHED;
            PG8_STAGE(PG8_SB(1, 1), b3 + hstepB, voffB);
            PG8_WAIT_V(6); PG8_BAR; PG8_MMA(1, 1, At, B1); PG8_BAR;
        }
        epilogue(E, acc, cur);
        if (!has_next) break;
#pragma unroll
        for (int a = 0; a < 2; ++a)
#pragma unroll
            for (int b = 0; b < 2; ++b)
#pragma unroll
                for (int m = 0; m < 4; ++m)
#pragma unroll
                    for (int n = 0; n < 2; ++n) acc[a][b][m][n] = (f32x4){0.f, 0.f, 0.f, 0.f};
        cur = nxt; cA = nA; cB = nB; ++ui;
    }
    PG8_WAIT_V(0);
    if (wr == 0) PG8_BAR;
    PG8_BAR;
#undef PG8_SA
#undef PG8_SB
#undef PG8_STAGE
#undef PG8_LDA
#undef PG8_LDB
#undef PG8_MMA
#undef PG8_WAIT_V
#undef PG8_WAIT_L
#undef PG8_BAR
#undef PG8_SCHED
}

__device__ __forceinline__ int win_dst_row(int n0) {
    if (n0 < D || n0 >= 3 * D) return n0;
    const int isv = n0 >= 2 * D, ch = n0 - (isv ? 2 * D : D);
    return D + (ch >> 7) * 256 + isv * 128 + (ch & 127);
}
__device__ __forceinline__ void transpose_item(const float* W, int K, int N, bf16_t* WT, int wperm, LAS float* scr, int item, int lane) {
    const int nblk = N / 32, kb = item / nblk, nb = item % nblk, k0 = 64 * kb, n0 = 32 * nb;
#pragma unroll 8
    for (int i = 0; i < 32; ++i) { const int kk = 2 * i + (lane >> 5); scr[kk * 33 + (lane & 31)] = W[(size_t)(k0 + kk) * N + n0 + (lane & 31)]; }
    LDS_WAIT(); asm volatile("" ::: "memory");
    const int c = lane & 7;
    const int drow0 = wperm ? win_dst_row(n0) : n0;
#pragma unroll
    for (int j = 0; j < 4; ++j) { const int n = (lane >> 3) + 8 * j; const LAS float* s = scr + (8 * c) * 33 + n;
        u32x4 o; o.x = cvt_pk_bf16(s[0 * 33], s[1 * 33]); o.y = cvt_pk_bf16(s[2 * 33], s[3 * 33]); o.z = cvt_pk_bf16(s[4 * 33], s[5 * 33]); o.w = cvt_pk_bf16(s[6 * 33], s[7 * 33]);
        *(u32x4*)(WT + (size_t)(drow0 + n) * K + k0 + 8 * c) = o; }
    LDS_WAIT(); asm volatile("" ::: "memory");
}
__device__ __forceinline__ void transpose_matrix(const float* W, int K, int N, bf16_t* WT, int wperm, LAS float* scr, int gw, int NGW, int lane, int& off) {
    const int nitems = (K / 64) * (N / 32);
    int start = gw - (off % NGW); if (start < 0) start += NGW;
    for (int it = start; it < nitems; it += NGW) transpose_item(W, K, N, WT, wperm, scr, it, lane);
    off += nitems;
}

enum { SE_F32 = 0, SE_SCALE = 1, SE_GATE = 2, SE_GATEADD = 3, SE_RELU2 = 4 };
struct SkGemm { int emode, lda, ldb, ldc, nCB, K, cbPerGrp, grpK; const bf16_t* A; const bf16_t* Bt; void* C; const float* projs; const float* vec; float* m1; };
__device__ __forceinline__ void skinny_gemm(LAS unsigned char* lds, const SkGemm& g, int task0, int tstride) {
    int tl = threadIdx.x; asm volatile("" : "+v"(tl));
    const int lane = tl & 63, wid = tl >> 6, fr = lane & 15, fq = lane >> 4;
    const int kw = g.K >> 3, nks = kw >> 5;
    for (int cb = task0; cb < g.nCB; cb += tstride) {
        const int kB = wid * kw, kA = kB + (cb / g.cbPerGrp) * g.grpK;
        f32x4 acc[8][2];
#pragma unroll
        for (int rb = 0; rb < 8; ++rb) { acc[rb][0] = (f32x4){0.f, 0.f, 0.f, 0.f}; acc[rb][1] = acc[rb][0]; }
        const bf16_t* bp = g.Bt + (size_t)(cb * 32 + fr) * g.ldb + kB + fq * 8;
        const bf16_t* ap = g.A + (size_t)fr * g.lda + kA + fq * 8;
        bf16x8 a[8], b0, b1;
        b0 = *(const bf16x8*)bp; b1 = *(const bf16x8*)(bp + (size_t)16 * g.ldb);
#pragma unroll
        for (int rb = 0; rb < 8; ++rb) a[rb] = *(const bf16x8*)(ap + (size_t)rb * 16 * g.lda);
        for (int ks = 0; ks < nks; ++ks) {
            bf16x8 an[8], bn0 = b0, bn1 = b1;
            const int kn = (ks + 1 < nks ? ks + 1 : ks) * 32;
            bn0 = *(const bf16x8*)(bp + kn); bn1 = *(const bf16x8*)(bp + (size_t)16 * g.ldb + kn);
#pragma unroll
            for (int rb = 0; rb < 8; ++rb) an[rb] = *(const bf16x8*)(ap + (size_t)rb * 16 * g.lda + kn);
#pragma unroll
            for (int rb = 0; rb < 8; ++rb) {
                acc[rb][0] = __builtin_amdgcn_mfma_f32_16x16x32_bf16(b0, a[rb], acc[rb][0], 0, 0, 0);
                acc[rb][1] = __builtin_amdgcn_mfma_f32_16x16x32_bf16(b1, a[rb], acc[rb][1], 0, 0, 0);
            }
            b0 = bn0; b1 = bn1;
#pragma unroll
            for (int rb = 0; rb < 8; ++rb) a[rb] = an[rb];
        }
#pragma unroll
        for (int rb = 0; rb < 8; ++rb)
#pragma unroll
            for (int c2 = 0; c2 < 2; ++c2) *(LAS f32x4*)(lds + wid * 16384 + ((rb * 2 + c2) * 64 + lane) * 16) = acc[rb][c2];
        __syncthreads();
#pragma unroll
        for (int h = 0; h < 2; ++h) {
            const int q = tl + h * 512, i = q >> 6, ls = q & 63;
            f32x4 v = *(const LAS f32x4*)(lds + q * 16);
#pragma unroll
            for (int w = 1; w < 8; ++w) v += *(const LAS f32x4*)(lds + w * 16384 + q * 16);
            const int row = (i >> 1) * 16 + (ls & 15), col = cb * 32 + (i & 1) * 16 + 4 * (ls >> 4);
            if (g.emode == SE_F32) *(f32x4*)((float*)g.C + (size_t)row * g.ldc + col) = v;
            else if (g.emode == SE_GATE || g.emode == SE_GATEADD) {
                const int go = g.emode == SE_GATE ? 0 : D;
                f32x4 gt = *(const f32x4*)(g.projs + (size_t)row * DIN + 4 * D + go + col) + *(const f32x4*)(g.vec + go + col);
#pragma unroll
                for (int j = 0; j < 4; ++j) gt[j] = sigmoidf_(gt[j]);
                if (g.emode == SE_GATE) *(f32x4*)(g.m1 + (size_t)row * D + col) = gt * v;
                else { const f32x4 o = *(const f32x4*)(g.m1 + (size_t)row * D + col) + gt * v;
                    u32x2 w2; w2.x = cvt_pk_bf16(o[0], o[1]); w2.y = cvt_pk_bf16(o[2], o[3]); *(u32x2*)((bf16_t*)g.C + (size_t)row * g.ldc + col) = w2; }
            } else {
                f32x4 o;
                if (g.emode == SE_SCALE) o = v * *(const f32x4*)(g.vec + col);
                else {
#pragma unroll
                    for (int j = 0; j < 4; ++j) { const float u = fmaxf(v[j], 0.f); o[j] = u * u; }
                }
                u32x2 w2; w2.x = cvt_pk_bf16(o[0], o[1]); w2.y = cvt_pk_bf16(o[2], o[3]); *(u32x2*)((bf16_t*)g.C + (size_t)row * g.ldc + col) = w2;
            }
        }
        __syncthreads();
    }
}

__global__ void __launch_bounds__(512, 2) fwd_megakernel(Params p) {
    extern __shared__ __attribute__((aligned(16))) unsigned char shm[];
    LAS unsigned char* lds = (LAS unsigned char*)shm;
    cg::grid_group grid = cg::this_grid();
    const int tid = threadIdx.x;
    const int G = (int)gridDim.x, NGW = G * 8;
    unsigned char* ws = p.ws;
    bf16_t* S0 = (bf16_t*)(ws + 0 * SLOT); bf16_t* S1 = (bf16_t*)(ws + 1 * SLOT); bf16_t* S2 = (bf16_t*)(ws + 2 * SLOT);
    bf16_t* S3 = (bf16_t*)(ws + 3 * SLOT); bf16_t* S5 = (bf16_t*)(ws + 5 * SLOT);
    bf16_t* WIN = (bf16_t*)(ws + WS_WIN);
    unsigned char* sm = ws + WS_SM;
    float* PROJS = (float*)(sm + SM_PROJ); float* M1S = (float*)(sm + SM_M1); float* YACC = (float*)(sm + SM_YACC); float* FACC = (float*)(sm + SM_FACC);
    bf16_t* HS = (bf16_t*)(sm + SM_HS); bf16_t* YAS = (bf16_t*)(sm + SM_YAS); bf16_t* DDS = (bf16_t*)(sm + SM_DDS);
    bf16_t* YBS = (bf16_t*)(sm + SM_YBS); bf16_t* MRGS = (bf16_t*)(sm + SM_MRG); bf16_t* US = (bf16_t*)(sm + SM_US);
    float* X = p.out + O_Y;

    volatile LAS unsigned* xbst = (volatile LAS unsigned*)(lds + STAGE_BYTES);
    if (tid == 0) { xbst[0] = 0u; xbst[1] = 0u; xbst[2] = 0u; xbst[3] = 0u; }
    __syncthreads();
    XcdBarrier xb = xcd_barrier_post((unsigned*)(ws + WS_BAR), xbst);
#define GRID_BAR() xcd_barrier(xb)

    {
        const int lane = tid & 63, wid = tid >> 6, gw = (int)blockIdx.x * 8 + wid;
        LAS float* scr = (LAS float*)(lds + wid * 16384);
        int off = 0;
        transpose_matrix(p.in[4], D, DIN, WIN, 1, scr, gw, NGW, lane, off);
        for (int l = 0; l < NL; ++l) {
            unsigned char* wl = ws + WS_WL + (size_t)l * WL_BYTES;
            transpose_matrix(p.in[7] + (size_t)l * D * D, D, D, (bf16_t*)(wl + WL_WC), 0, scr, gw, NGW, lane, off);
            transpose_matrix(p.in[10] + (size_t)l * D * D, D, D, (bf16_t*)(wl + WL_WP), 0, scr, gw, NGW, lane, off);
            transpose_matrix(p.in[11] + (size_t)l * D * D, D, D, (bf16_t*)(wl + WL_WO), 0, scr, gw, NGW, lane, off);
            for (int gi = 0; gi < 4; ++gi)
                transpose_matrix(p.in[8] + (size_t)l * 4 * 65536 + (size_t)gi * 65536, 256, 256, (bf16_t*)(wl + WL_POOL) + (size_t)gi * 65536, 0, scr, gw, NGW, lane, off);
            transpose_matrix(p.in[14] + (size_t)l * D * DFF, D, DFF, (bf16_t*)(wl + WL_UP), 0, scr, gw, NGW, lane, off);
            transpose_matrix(p.in[15] + (size_t)l * DFF * D, DFF, D, (bf16_t*)(wl + WL_DOWN), 0, scr, gw, NGW, lane, off);
        }
        const float* gpre = p.in[12];
        f32x4 gv[4];
#pragma unroll
        for (int j = 0; j < 4; ++j) gv[j] = *(const f32x4*)(gpre + lane * 4 + 256 * j);
        for (int r = gw; r < MTOT; r += NGW) {
            const float* xr = r < MP ? p.in[0] + (size_t)r * D : p.in[1] + (size_t)(r - MP) * D;
            bf16_t* hr = r < MP ? S0 + (size_t)r * D : HS + (size_t)(r - MP) * D;
            f32x4 v[4]; float s = 0.f;
#pragma unroll
            for (int j = 0; j < 4; ++j) { v[j] = *(const f32x4*)(xr + lane * 4 + 256 * j); s += (v[j][0] * v[j][0] + v[j][1] * v[j][1]) + (v[j][2] * v[j][2] + v[j][3] * v[j][3]); }
            const float rs = rsqrtf(wave_sum(s) * (1.f / D) + EPS);
#pragma unroll
            for (int j = 0; j < 4; ++j) { u32x2 o; o.x = cvt_pk_bf16(v[j][0] * rs * gv[j][0], v[j][1] * rs * gv[j][1]); o.y = cvt_pk_bf16(v[j][2] * rs * gv[j][2], v[j][3] * rs * gv[j][3]);
                *(u32x2*)(hr + lane * 4 + 256 * j) = o; }
        }
    }
    grid.sync();

    for (int step = 0; step < p.nsteps; ++step) {
        const int l = step / 10, ph = step - l * 10;
        int tid_s = threadIdx.x; asm volatile("" : "+v"(tid_s));
        const int lane = tid_s & 63, wid = tid_s >> 6, gw = (int)blockIdx.x * 8 + wid;
        unsigned char* wl = ws + WS_WL + (size_t)l * WL_BYTES;
        const float* bgate = p.in[5] + (size_t)l * 2 * D;
        Gemm g{S0, WIN, D, D, D, MP / BM, D / BM, 0};
        Epi E{E_PLAIN, D, S1, nullptr, nullptr, nullptr, ws};
        SkGemm sk{SE_F32, D, D, D, D / 32, D, 1 << 20, 0, HS, WIN, YACC, PROJS, bgate, M1S};
        bool is_gemm = true;
        switch (ph) {
        case 0:
            g.nN = DIN / BM; E.id = E_PROJ; E.vec = bgate;
            sk.ldc = DIN; sk.nCB = DIN / 32; sk.C = PROJS; break;
        case 2:
            g.Bt = (const bf16_t*)(wl + WL_POOL); g.ldb = 256; g.K = 256; g.nN = 4; g.a_pn_off = 256;
            E.id = E_SCALE; E.o0 = S2; E.vec = p.in[9] + (size_t)l * D;
            sk.emode = SE_SCALE; sk.A = DDS; sk.Bt = g.Bt; sk.ldb = 256; sk.K = 256; sk.cbPerGrp = 8; sk.grpK = 256; sk.C = YBS; sk.vec = E.vec; break;
        case 3:
            g.A = S1; g.Bt = (const bf16_t*)(wl + WL_WC); E.id = E_GATE; E.o0 = S3; E.x0 = (const bf16_t*)(ws + 4 * SLOT);
            sk.emode = SE_GATE; sk.A = YAS; sk.Bt = g.Bt; break;
        case 4:
            g.A = S2; g.Bt = (const bf16_t*)(wl + WL_WP); E.id = E_GATEADD; E.o0 = S0; E.x0 = S5; E.x1 = S3;
            sk.emode = SE_GATEADD; sk.A = YBS; sk.Bt = g.Bt; sk.C = MRGS; break;
        case 5:
            g.Bt = (const bf16_t*)(wl + WL_WO);
            sk.A = MRGS; sk.Bt = g.Bt; sk.C = YACC; break;
        case 7:
            g.Bt = (const bf16_t*)(wl + WL_UP); g.nN = DFF / BM; E.id = E_RELU2; E.ldc = DFF;
            sk.emode = SE_RELU2; sk.Bt = g.Bt; sk.ldc = DFF; sk.nCB = DFF / 32; sk.C = US; break;
        case 8:
            g.A = S1; g.Bt = (const bf16_t*)(wl + WL_DOWN); g.lda = DFF; g.ldb = DFF; g.K = DFF; E.o0 = S5;
            sk.A = US; sk.lda = DFF; sk.Bt = g.Bt; sk.ldb = DFF; sk.K = DFF; sk.C = FACC; break;
        default: is_gemm = false; break;
        }
        if (is_gemm) {
            skinny_gemm(lds, sk, (int)blockIdx.x, G);
            StaticOrder S; S.init(g.nM, g.nN, G, (int)blockIdx.x);
            gemm_phase(lds, g, S, E);
        } else if (ph == 1) {
            const float* cw = p.in[6] + (size_t)l * 3 * D;
            const float* cconv = p.in[2] + (size_t)l * NB_S * 2 * D;
            const float* cpool = p.in[3] + (size_t)l * NB_S * 15 * D;
            float* o_csp = p.out + O_CSP + (size_t)l * 2 * D;
            float* o_psp = p.out + O_PSP + (size_t)l * 15 * D;
            float* o_css = p.out + O_CSS + (size_t)l * NB_S * 2 * D;
            float* o_pss = p.out + O_PSS + (size_t)l * NB_S * 15 * D;
            constexpr int NSMP = MS / 2 * 4;
            constexpr int NSLOW = NSMP + 16 / 2 * 4;
            constexpr int NFAST = ((MP / 16 - 1) * 4 + 1) / 2;
            for (int it = gw; it < NSLOW + NFAST; it += NGW) {
                if (it < NSLOW) {
                    const int gi = it & 3, ch = gi * 256 + (lane & 31) * 8, w = 2 << gi;
                    const f32x4 w0a = *(const f32x4*)(cw + ch), w0b = *(const f32x4*)(cw + ch + 4);
                    const f32x4 w1a = *(const f32x4*)(cw + D + ch), w1b = *(const f32x4*)(cw + D + ch + 4);
                    const f32x4 w2a = *(const f32x4*)(cw + 2 * D + ch), w2b = *(const f32x4*)(cw + 2 * D + ch + 4);
                    const f32x4 zero4 = (f32x4){0.f, 0.f, 0.f, 0.f};
                    if (it < NSMP) {
                        const int rs = (it >> 2) * 2 + (lane >> 5), sb = rs >> 4, t = rs & 15;
                        const int cc = D + (ch >> 7) * 256 + (ch & 127);
                        const float* pr = PROJS + (size_t)rs * DIN;
                        const f32x4 b0 = *(const f32x4*)(pr + ch), b1 = *(const f32x4*)(pr + ch + 4);
                        const f32x4 z0a = *(const f32x4*)(pr + cc) * *(const f32x4*)(pr + cc + 128), z0b = *(const f32x4*)(pr + cc + 4) * *(const f32x4*)(pr + cc + 132);
                        const f32x4 p0a = *(const f32x4*)(pr + 3 * D + ch), p0b = *(const f32x4*)(pr + 3 * D + ch + 4);
                        f32x4 z1a, z1b, z2a, z2b;
                        if (t >= 1) { const float* q = pr - DIN; z1a = *(const f32x4*)(q + cc) * *(const f32x4*)(q + cc + 128); z1b = *(const f32x4*)(q + cc + 4) * *(const f32x4*)(q + cc + 132); }
                        else { const float* q = cconv + ((size_t)sb * 2 + 1) * D + ch; z1a = *(const f32x4*)q; z1b = *(const f32x4*)(q + 4); }
                        if (t >= 2) { const float* q = pr - 2 * DIN; z2a = *(const f32x4*)(q + cc) * *(const f32x4*)(q + cc + 128); z2b = *(const f32x4*)(q + cc + 4) * *(const f32x4*)(q + cc + 132); }
                        else { const float* q = cconv + ((size_t)sb * 2 + t) * D + ch; z2a = *(const f32x4*)q; z2b = *(const f32x4*)(q + 4); }
                        f32x4 sa = p0a, sb2 = p0b;
                        for (int i = 1; i < w; ++i) {
                            const float* q = (t - i >= 0) ? pr - (size_t)i * DIN + 3 * D + ch : cpool + ((size_t)sb * 15 + (15 + t - i)) * D + ch;
                            sa += *(const f32x4*)q; sb2 += *(const f32x4*)(q + 4);
                        }
                        const float ic = 1.0f / (float)w;
                        st8(YAS + (size_t)rs * D + ch, b0 * (w0a * z2a + w1a * z1a + w2a * z0a), b1 * (w0b * z2b + w1b * z1b + w2b * z0b));
                        st8(DDS + (size_t)rs * D + ch, sa * ic - p0a, sb2 * ic - p0b);
                        if (t >= SEQ_S - 2) { float* o = o_css + ((size_t)sb * 2 + (t - (SEQ_S - 2))) * D + ch; *(f32x4*)o = z0a; *(f32x4*)(o + 4) = z0b; }
                        if (t >= 1) { float* o = o_pss + ((size_t)sb * 15 + (t - 1)) * D + ch; *(f32x4*)o = p0a; *(f32x4*)(o + 4) = p0b; }
                    } else {
                        const int r = ((it - NSMP) >> 2) * 2 + (lane >> 5), t = r;
                        f32x4 b0, b1, z0a, z0b, z1a = zero4, z1b = zero4, z2a = zero4, z2b = zero4, p0a, p0b;
                        ld8(S1 + (size_t)r * D + ch, b0, b1);
                        ld8(S2 + (size_t)r * D + ch, z0a, z0b);
                        ld8(S3 + (size_t)r * D + ch, p0a, p0b);
                        if (t >= 1) ld8(S2 + (size_t)(r - 1) * D + ch, z1a, z1b);
                        if (t >= 2) ld8(S2 + (size_t)(r - 2) * D + ch, z2a, z2b);
                        f32x4 sa = p0a, sb2 = p0b;
                        for (int i = 1; i < w; ++i) if (t - i >= 0) { f32x4 qa, qb; ld8(S3 + (size_t)(r - i) * D + ch, qa, qb); sa += qa; sb2 += qb; }
                        const int cnt = t + 1 < w ? t + 1 : w;
                        const float ic = 1.0f / (float)cnt;
                        st8(S1 + (size_t)r * D + ch, b0 * (w0a * z2a + w1a * z1a + w2a * z0a), b1 * (w0b * z2b + w1b * z1b + w2b * z0b));
                        st8(S0 + (size_t)r * D + ch, sa * ic - p0a, sb2 * ic - p0b);
                    }
                } else {
                    const int hi = (it - NSLOW) * 2 + (lane >> 5);
                    if (hi < (MP / 16 - 1) * 4) {
                        const int gi = hi & 3, r0 = ((hi >> 2) + 1) * 16, ch = gi * 256 + (lane & 31) * 8, w = 2 << gi;
                        const float ic = 1.0f / (float)w;
                        const f32x4 w0a = *(const f32x4*)(cw + ch), w0b = *(const f32x4*)(cw + ch + 4);
                        const f32x4 w1a = *(const f32x4*)(cw + D + ch), w1b = *(const f32x4*)(cw + D + ch + 4);
                        const f32x4 w2a = *(const f32x4*)(cw + 2 * D + ch), w2b = *(const f32x4*)(cw + 2 * D + ch + 4);
                        f32x4 z1a, z1b, z2a, z2b;
                        ld8(S2 + (size_t)(r0 - 1) * D + ch, z1a, z1b);
                        ld8(S2 + (size_t)(r0 - 2) * D + ch, z2a, z2b);
                        f32x4 sa = (f32x4){0.f, 0.f, 0.f, 0.f}, sb2 = sa;
                        for (int i = 1; i < w; ++i) { f32x4 qa, qb; ld8(S3 + (size_t)(r0 - i) * D + ch, qa, qb); sa += qa; sb2 += qb; }
#pragma unroll 4
                        for (int k = 0; k < 16; ++k) {
                            const size_t ro = (size_t)(r0 + k) * D + ch;
                            f32x4 b0, b1, z0a, z0b, p0a, p0b, oa, ob;
                            ld8(S1 + ro, b0, b1);
                            ld8(S2 + ro, z0a, z0b);
                            ld8(S3 + ro, p0a, p0b);
                            ld8(S3 + ro - (size_t)(w - 1) * D, oa, ob);
                            sa += p0a; sb2 += p0b;
                            st8(S1 + ro, b0 * (w0a * z2a + w1a * z1a + w2a * z0a), b1 * (w0b * z2b + w1b * z1b + w2b * z0b));
                            st8(S0 + ro, sa * ic - p0a, sb2 * ic - p0b);
                            sa -= oa; sb2 -= ob;
                            z2a = z1a; z2b = z1b; z1a = z0a; z1b = z0b;
                            const int t = r0 + k;
                            if (t >= MP - 2) { float* o = o_csp + (size_t)(t - (MP - 2)) * D + ch; *(f32x4*)o = z0a; *(f32x4*)(o + 4) = z0b; }
                            if (t >= MP - 15) { float* o = o_psp + (size_t)(t - (MP - 15)) * D + ch; *(f32x4*)o = p0a; *(f32x4*)(o + 4) = p0b; }
                        }
                    }
                }
            }
            if (l + 1 < NL) {
                LAS float* scr = (LAS float*)(lds + wid * 16384);
                int off = 0;
                transpose_matrix(p.in[4] + (size_t)(l + 1) * D * DIN, D, DIN, WIN, 1, scr, gw, NGW, lane, off);
            }
        } else {
            const int half = ph == 6 ? 0 : 1;
            const bf16_t* Y = half == 0 ? S1 : S5;
            const float* Yf = half == 0 ? YACC : FACC;
            const float* gpost = (half == 0 ? p.in[13] : p.in[17]) + (size_t)l * D;
            const float* gnext = half == 0 ? p.in[16] + (size_t)l * D : p.in[12] + (size_t)(l + 1 < NL ? l + 1 : l) * D;
            const bool from_input = (l == 0 && half == 0);
            f32x4 gp[4], gn[4];
#pragma unroll
            for (int j = 0; j < 4; ++j) { gp[j] = *(const f32x4*)(gpost + lane * 4 + 256 * j); gn[j] = *(const f32x4*)(gnext + lane * 4 + 256 * j); }
            for (int r = gw; r < MTOT; r += NGW) {
                const float* xr = from_input ? (r < MP ? p.in[0] + (size_t)r * D : p.in[1] + (size_t)(r - MP) * D) : X + (size_t)r * D;
                bf16_t* hr = r < MP ? S0 + (size_t)r * D : HS + (size_t)(r - MP) * D;
                f32x4 xv[4], yv[4]; float s = 0.f;
#pragma unroll
                for (int j = 0; j < 4; ++j) {
                    xv[j] = *(const f32x4*)(xr + lane * 4 + 256 * j);
                    if (r < MP) {
                        const u32x2 wv = *(const u32x2*)(Y + (size_t)r * D + lane * 4 + 256 * j);
                        yv[j][0] = bf_lo(wv.x); yv[j][1] = bf_hi(wv.x); yv[j][2] = bf_lo(wv.y); yv[j][3] = bf_hi(wv.y);
                    } else yv[j] = *(const f32x4*)(Yf + (size_t)(r - MP) * D + lane * 4 + 256 * j);
                    s += (yv[j][0] * yv[j][0] + yv[j][1] * yv[j][1]) + (yv[j][2] * yv[j][2] + yv[j][3] * yv[j][3]);
                }
                const float rs = rsqrtf(wave_sum(s) * (1.f / D) + EPS);
                float s2 = 0.f;
#pragma unroll
                for (int j = 0; j < 4; ++j) { xv[j] = xv[j] + yv[j] * rs * gp[j]; s2 += (xv[j][0] * xv[j][0] + xv[j][1] * xv[j][1]) + (xv[j][2] * xv[j][2] + xv[j][3] * xv[j][3]);
                    *(f32x4*)(X + (size_t)r * D + lane * 4 + 256 * j) = xv[j]; }
                const float rs2 = rsqrtf(wave_sum(s2) * (1.f / D) + EPS);
#pragma unroll
                for (int j = 0; j < 4; ++j) { u32x2 o; o.x = cvt_pk_bf16(xv[j][0] * rs2 * gn[j][0], xv[j][1] * rs2 * gn[j][1]); o.y = cvt_pk_bf16(xv[j][2] * rs2 * gn[j][2], xv[j][3] * rs2 * gn[j][3]);
                    *(u32x2*)(hr + lane * 4 + 256 * j) = o; }
            }
        }
        if (step + 1 < p.nsteps) GRID_BAR();
    }
}

extern "C" void kernel_launch(void* const* d_in, const int* in_sizes, int n_in, void* d_out, int out_size, void* d_ws, size_t ws_size, hipStream_t stream) {
    static int grid = 0;
    if (grid == 0) {
        if (n_in != 18 || ws_size < WS_END) { fprintf(stderr, "kernel_launch: unexpected n_in %d or ws_size %zu (< %zu)\n", n_in, ws_size, (size_t)WS_END); grid = -1; return; }
        int dev = 0, cus = 0, per_cu = 0;
        hipGetDevice(&dev);
        hipDeviceGetAttribute(&cus, hipDeviceAttributeMultiprocessorCount, dev);
        if (hipFuncSetAttribute((const void*)fwd_megakernel, hipFuncAttributeMaxDynamicSharedMemorySize, LDS_BYTES) != hipSuccess) { fprintf(stderr, "kernel_launch: hipFuncSetAttribute failed\n"); grid = -1; return; }
        if (hipOccupancyMaxActiveBlocksPerMultiprocessor(&per_cu, (const void*)fwd_megakernel, 512, LDS_BYTES) != hipSuccess || per_cu < 1) { fprintf(stderr, "kernel_launch: occupancy query failed (%d)\n", per_cu); grid = -1; return; }
        grid = cus * per_cu;
    }
    if (grid < 0) return;
    (void)hipMemsetAsync((unsigned char*)d_ws + WS_BAR, 0, 16384, stream);
    Params p{};
    for (int i = 0; i < 18; ++i) p.in[i] = (const float*)d_in[i];
    p.out = (float*)d_out; p.ws = (unsigned char*)d_ws; p.nsteps = NL * 10; p.pad = 0;
    void* args[] = {&p};
    hipError_t e = hipLaunchCooperativeKernel((const void*)fwd_megakernel, dim3(grid), dim3(512), args, LDS_BYTES, stream);
    if (e != hipSuccess) fprintf(stderr, "cooperative launch failed: %s (grid %d)\n", hipGetErrorString(e), grid);
}
```

```cpp
#include <hip/hip_runtime.h>
#include <hip/hip_cooperative_groups.h>
#include <cstdio>
namespace cg = cooperative_groups;

#ifndef SKELETON
#define SKELETON 0
#endif
#ifndef STOP_AFTER
#define STOP_AFTER 99
#endif
#ifndef PROBE
#define PROBE 0
#ifndef STAGGER_TICKS
#define STAGGER_TICKS 350
#endif
#endif
#ifndef USE_CG_ONLY
#define USE_CG_ONLY 0
#endif

#define LAS __attribute__((address_space(3)))
typedef unsigned short bf16_t;
typedef short bf16x8 __attribute__((ext_vector_type(8)));
typedef float f32x4 __attribute__((ext_vector_type(4)));
typedef unsigned u32x4 __attribute__((ext_vector_type(4)));
typedef unsigned u32x2 __attribute__((ext_vector_type(2)));

constexpr int D = 1024, DIN = 6144, DFF = 4096, NL = 2;
constexpr int MP = 16384, MS = 128, MTOT = MP + MS, MPAD = MP;
constexpr int SEQ_S = 16, NB_S = 8, PAST = 2048;
constexpr int BM = 256, BK = 64, HALF = 128, HTB = HALF * BK * 2, STAGE_BYTES = 8 * HTB, NXCD = 8, WGM = 8;
constexpr int LDS_BYTES = STAGE_BYTES + 64;
constexpr float EPS = 1e-6f;

constexpr size_t SLOT = (size_t)MPAD * 1024 * 2;
constexpr size_t WS_WIN = 6 * SLOT;
constexpr size_t WIN_BYTES = (size_t)DIN * D * 2;
constexpr size_t WL_WC = 0, WL_WP = 2097152, WL_WO = 4194304, WL_POOL = 6291456, WL_UP = 6815744, WL_DOWN = 15204352, WL_BYTES = 23592960;
constexpr size_t WS_WL = WS_WIN + WIN_BYTES;
constexpr size_t WS_BAR = WS_WL + NL * WL_BYTES;
constexpr size_t WS_SM = WS_BAR + 16384;
constexpr size_t SM_PROJ = 0, SM_M1 = 3145728, SM_YACC = 3670016, SM_FACC = 4194304, SM_HS = 4718592, SM_YAS = 4980736, SM_DDS = 5242880, SM_YBS = 5505024, SM_MRG = 5767168, SM_US = 6029312, SM_BYTES = 7077888;
constexpr size_t WS_END = WS_SM + SM_BYTES;

constexpr size_t O_Y = 0, O_CSP = (size_t)MTOT * D, O_PSP = O_CSP + NL * 2 * D, O_CSS = O_PSP + NL * 15 * D, O_PSS = O_CSS + (size_t)NL * NB_S * 2 * D;

struct Params {
    const float* in[18];
    float* out;
    unsigned char* ws;
    int nsteps, pad;
};

__device__ __forceinline__ unsigned cvt_pk_bf16(float lo, float hi) { unsigned r; asm volatile("v_cvt_pk_bf16_f32 %0, %1, %2" : "=v"(r) : "v"(lo), "v"(hi)); return r; }
__device__ __forceinline__ float bf_lo(unsigned w) { return __uint_as_float(w << 16); }
__device__ __forceinline__ float bf_hi(unsigned w) { return __uint_as_float(w & 0xffff0000u); }
__device__ __forceinline__ void st8(bf16_t* p, f32x4 a, f32x4 b) {
    u32x4 w; w.x = cvt_pk_bf16(a[0], a[1]); w.y = cvt_pk_bf16(a[2], a[3]); w.z = cvt_pk_bf16(b[0], b[1]); w.w = cvt_pk_bf16(b[2], b[3]);
    *(u32x4*)p = w;
}
__device__ __forceinline__ void ld8(const bf16_t* p, f32x4& a, f32x4& b) {
    const u32x4 w = *(const u32x4*)p;
    a[0] = bf_lo(w.x); a[1] = bf_hi(w.x); a[2] = bf_lo(w.y); a[3] = bf_hi(w.y);
    b[0] = bf_lo(w.z); b[1] = bf_hi(w.z); b[2] = bf_lo(w.w); b[3] = bf_hi(w.w);
}
__device__ __forceinline__ float sigmoidf_(float x) { return 1.0f / (1.0f + __expf(-x)); }
__device__ __forceinline__ float wave_sum(float v) {
#pragma unroll
    for (int o = 1; o < 64; o <<= 1) v += __shfl_xor(v, o);
    return v;
}
#define LDS_WAIT() asm volatile("s_waitcnt lgkmcnt(0)" ::: "memory")

#define XB_TMO      128
#define XB_XCNT(j)  (256  + 64 * (j))
#define XB_XSUB(j)  (1280 + 64 * (j))
#define XB_XGEN(j)  (2304 + 64 * (j))
#define XB_TOP      3328
#define XB_TOPGEN   3392
#define XCD_BAR_WORDS 3456
#define XB_SPIN_CAP (1u << 18)
__device__ __forceinline__ unsigned xb_ld(unsigned* p)              { return __hip_atomic_load(p, __ATOMIC_RELAXED, __HIP_MEMORY_SCOPE_AGENT); }
__device__ __forceinline__ unsigned xb_add(unsigned* p, unsigned v) { return __hip_atomic_fetch_add(p, v, __ATOMIC_RELAXED, __HIP_MEMORY_SCOPE_AGENT); }
__device__ __forceinline__ unsigned xb_xcc_id() { return (unsigned)__builtin_amdgcn_s_getreg((3 << 11) | 20) & 0xFu; }
#define XB_SPIN(cond, bar) do { unsigned _sp = 0; while (cond) { __builtin_amdgcn_s_sleep(1); \
    if ((++_sp & 255u) == 0u) { if (xb_ld(&(bar)[XB_TMO])) break; if (_sp > XB_SPIN_CAP) { atomicAdd(&(bar)[XB_TMO], 1u); break; } } } } while (0)
struct XcdBarrier { unsigned* bar; unsigned x; volatile LAS unsigned* st; };
__device__ __forceinline__ XcdBarrier xcd_barrier_post(unsigned* bar, volatile LAS unsigned* st) {
    XcdBarrier b; b.bar = bar; b.x = xb_xcc_id(); b.st = st;
    if (threadIdx.x == 0) (void)xb_add(&bar[XB_XCNT(b.x)], 1u);
    return b;
}
__device__ __forceinline__ void xcd_barrier_complete(unsigned* bar, unsigned x, unsigned& nloc, unsigned& nx) {
    const unsigned G = gridDim.x * gridDim.y * gridDim.z;
    unsigned sum, cnt, mine, sp = 0u;
    for (;;) {
        sum = 0u; cnt = 0u; mine = 0u;
#pragma unroll
        for (unsigned j = 0; j < 16; ++j) { const unsigned c = xb_ld(&bar[XB_XCNT(j)]); sum += c; cnt += (c > 0u) ? 1u : 0u; mine = (j == x) ? c : mine; }
        if (sum == G) break;
        __builtin_amdgcn_s_sleep(1);
        if ((++sp & 255u) == 0u) { if (xb_ld(&bar[XB_TMO])) break; if (sp > XB_SPIN_CAP) { atomicAdd(&bar[XB_TMO], 1u); break; } }
    }
    nloc = mine > 0u ? mine : 1u; nx = cnt > 0u ? cnt : 1u;
}
__device__ __forceinline__ void xcd_barrier(const XcdBarrier& b) {
    asm volatile("s_waitcnt vmcnt(0)" ::: "memory");
    __syncthreads();
    if (threadIdx.x == 0) {
        unsigned* bar = b.bar;
        __builtin_amdgcn_s_waitcnt(0);
        unsigned nloc = b.st[0], nx = b.st[1];
        if (nloc == 0u) { xcd_barrier_complete(bar, b.x, nloc, nx); b.st[0] = nloc; b.st[1] = nx; }
        const unsigned old = xb_add(&bar[XB_XSUB(b.x)], 1u);
        const unsigned gen = old / nloc;
        if (old + 1u == (gen + 1u) * nloc) {
            __builtin_amdgcn_fence(__ATOMIC_RELEASE, "agent");
            asm volatile("s_waitcnt vmcnt(0)" ::: "memory");
            const unsigned og = xb_add(&bar[XB_TOP], 1u);
            const unsigned tg = og / nx;
            if (og + 1u == (tg + 1u) * nx) xb_add(&bar[XB_TOPGEN], 1u);
            else XB_SPIN(xb_ld(&bar[XB_TOPGEN]) == tg, bar);
            __builtin_amdgcn_fence(__ATOMIC_ACQUIRE, "agent");
            xb_add(&bar[XB_XGEN(b.x)], 1u);
            asm volatile("s_waitcnt vmcnt(0)" ::: "memory");
        } else {
            XB_SPIN(xb_ld(&bar[XB_XGEN(b.x)]) == gen, bar);
            __builtin_amdgcn_fence(__ATOMIC_ACQUIRE, "agent");
            asm volatile("s_waitcnt vmcnt(0)" ::: "memory");
        }
    }
    __syncthreads();
}

__device__ __forceinline__ int lds_byte(int r, int c) { const int st = (r >> 4) * 2 + (c >> 5), rr = r & 15, cc = c & 31, ob = rr * 64 + cc * 2; return st * 1024 + (ob ^ (((ob >> 9) & 1) << 5)); }
__device__ __forceinline__ void stage_rc(int b, int& R, int& C) { const int st = b / 1024, sb = b % 1024, swz = sb ^ (((sb >> 9) & 1) << 5); R = (st >> 1) * 16 + swz / 64; C = (st & 1) * 32 + (swz % 64) / 2; }
__device__ __forceinline__ int perm32(int rho) { const int n = rho >> 4, i = rho & 15; return 8 * (i >> 2) + 4 * n + (i & 3); }

struct Unit { int pm, pn; };
struct Gemm { const bf16_t* A; const bf16_t* Bt; int lda, ldb, K, nM, nN, a_pn_off; };
struct StaticOrder {
    int nM, nN, nwg, G, c;
    __device__ void init(int nM_, int nN_, int G_, int c_) { nM = nM_; nN = nN_; nwg = nM * nN; G = G_; c = c_; }
    __device__ bool next(int i, Unit& u) const {
        const long L = (long)i * G + c; if (L >= nwg) return false;
        int wgid = (int)L; { const int q = nwg / NXCD, r = nwg % NXCD, xcd = wgid % NXCD, off = wgid / NXCD; wgid = (xcd < r ? xcd * (q + 1) : r * (q + 1) + (xcd - r) * q) + off; }
        const int nig = WGM * nN, gid = wgid / nig, fm = gid * WGM, gsz = (nM - fm) < WGM ? (nM - fm) : WGM;
        u.pm = fm + ((wgid % nig) % gsz); u.pn = (wgid % nig) / gsz; return true;
    }
};

enum { E_PROJ = 0, E_SCALE = 1, E_GATE = 2, E_GATEADD = 3, E_PLAIN = 4, E_RELU2 = 5 };
struct Epi { int id, ldc; bf16_t* o0; const bf16_t* x0; const bf16_t* x1; const float* vec; unsigned char* ws; };

__device__ __forceinline__ void epilogue(const Epi& E, const f32x4 (&acc)[2][2][4][2], const Unit& u) {
    int tl = threadIdx.x; asm volatile("" : "+v"(tl));
    const int wv = tl >> 6, ln = tl & 63, wr = wv >> 2, wc = wv & 3, fr = ln & 15, fq = ln >> 4;
    if (E.id == 99) return;
    const int row0 = u.pm * BM + wr * 64 + fr;
    const int colw = wc * 32 + 8 * fq;
    if (E.id == E_PROJ) {
        if (u.pn >= 4 && u.pn < 12) {
            const int ch = (u.pn - 4) * 128 + colw;
#pragma unroll
            for (int ai = 0; ai < 2; ++ai)
#pragma unroll
                for (int m = 0; m < 4; ++m) {
                    const size_t r = (size_t)(row0 + ai * HALF + m * 16);
                    st8((bf16_t*)(E.ws + 2 * SLOT) + r * D + ch, acc[ai][0][m][0] * acc[ai][1][m][0], acc[ai][0][m][1] * acc[ai][1][m][1]);
                }
        } else if (u.pn >= 16) {
            const int gc0 = (u.pn - 16) * BM;
            bf16_t* O = (bf16_t*)(E.ws + (gc0 < D ? 4 : 5) * SLOT);
            const int oc0 = gc0 & (D - 1);
#pragma unroll
            for (int bj = 0; bj < 2; ++bj) {
                const f32x4 b0 = *(const f32x4*)(E.vec + gc0 + bj * HALF + colw), b1 = *(const f32x4*)(E.vec + gc0 + bj * HALF + colw + 4);
#pragma unroll
                for (int ai = 0; ai < 2; ++ai)
#pragma unroll
                    for (int m = 0; m < 4; ++m) {
                        const size_t r = (size_t)(row0 + ai * HALF + m * 16);
                        f32x4 v0 = acc[ai][bj][m][0] + b0, v1 = acc[ai][bj][m][1] + b1;
#pragma unroll
                        for (int j = 0; j < 4; ++j) { v0[j] = sigmoidf_(v0[j]); v1[j] = sigmoidf_(v1[j]); }
                        st8(O + r * D + oc0 + bj * HALF + colw, v0, v1);
                    }
            }
        } else {
            bf16_t* O = (bf16_t*)(E.ws + (u.pn < 4 ? 1 : 3) * SLOT);
            const int oc0 = (u.pn & 3) * BM;
#pragma unroll
            for (int ai = 0; ai < 2; ++ai)
#pragma unroll
                for (int m = 0; m < 4; ++m) {
                    const size_t r = (size_t)(row0 + ai * HALF + m * 16);
#pragma unroll
                    for (int bj = 0; bj < 2; ++bj) st8(O + r * D + oc0 + bj * HALF + colw, acc[ai][bj][m][0], acc[ai][bj][m][1]);
                }
        }
        return;
    }
    const int col0 = u.pn * BM + colw;
    if (E.id == E_SCALE) {
#pragma unroll
        for (int bj = 0; bj < 2; ++bj) {
            const f32x4 s0 = *(const f32x4*)(E.vec + col0 + bj * HALF), s1 = *(const f32x4*)(E.vec + col0 + bj * HALF + 4);
#pragma unroll
            for (int ai = 0; ai < 2; ++ai)
#pragma unroll
                for (int m = 0; m < 4; ++m) {
                    const size_t r = (size_t)(row0 + ai * HALF + m * 16);
                    st8(E.o0 + r * E.ldc + col0 + bj * HALF, acc[ai][bj][m][0] * s0, acc[ai][bj][m][1] * s1);
                }
        }
    } else if (E.id == E_GATE) {
#pragma unroll
        for (int ai = 0; ai < 2; ++ai)
#pragma unroll
            for (int m = 0; m < 4; ++m) {
                const size_t r = (size_t)(row0 + ai * HALF + m * 16);
#pragma unroll
                for (int bj = 0; bj < 2; ++bj) {
                    f32x4 g0, g1; ld8(E.x0 + r * D + col0 + bj * HALF, g0, g1);
                    st8(E.o0 + r * E.ldc + col0 + bj * HALF, acc[ai][bj][m][0] * g0, acc[ai][bj][m][1] * g1);
                }
                if (m == 3) asm volatile("" ::: "memory");
            }
    } else if (E.id == E_GATEADD) {
#pragma unroll
        for (int ai = 0; ai < 2; ++ai)
#pragma unroll
            for (int m = 0; m < 4; ++m) {
                const size_t r = (size_t)(row0 + ai * HALF + m * 16);
#pragma unroll
                for (int bj = 0; bj < 2; ++bj) {
                    f32x4 g0, g1, a0, a1; ld8(E.x0 + r * D + col0 + bj * HALF, g0, g1); ld8(E.x1 + r * D + col0 + bj * HALF, a0, a1);
                    st8(E.o0 + r * E.ldc + col0 + bj * HALF, a0 + acc[ai][bj][m][0] * g0, a1 + acc[ai][bj][m][1] * g1);
                }
                if (m & 1) asm volatile("" ::: "memory");
            }
    } else if (E.id == E_RELU2) {
#pragma unroll
        for (int ai = 0; ai < 2; ++ai)
#pragma unroll
            for (int m = 0; m < 4; ++m) {
                const size_t r = (size_t)(row0 + ai * HALF + m * 16);
#pragma unroll
                for (int bj = 0; bj < 2; ++bj) {
                    f32x4 v0 = acc[ai][bj][m][0], v1 = acc[ai][bj][m][1];
#pragma unroll
                    for (int j = 0; j < 4; ++j) { const float a = fmaxf(v0[j], 0.f), b = fmaxf(v1[j], 0.f); v0[j] = a * a; v1[j] = b * b; }
                    st8(E.o0 + r * E.ldc + col0 + bj * HALF, v0, v1);
                }
            }
    } else {
#pragma unroll
        for (int ai = 0; ai < 2; ++ai)
#pragma unroll
            for (int m = 0; m < 4; ++m) {
                const size_t r = (size_t)(row0 + ai * HALF + m * 16);
#pragma unroll
                for (int bj = 0; bj < 2; ++bj) st8(E.o0 + r * E.ldc + col0 + bj * HALF, acc[ai][bj][m][0], acc[ai][bj][m][1]);
            }
    }
}

__device__ __forceinline__ void gemm_phase(LAS unsigned char* lds, const Gemm g, const StaticOrder& S, const Epi& E) {
    const int tid = threadIdx.x, wid = __builtin_amdgcn_readfirstlane(tid >> 6), lane = tid & 63, wr = wid >> 2, wc = wid & 3, fr = lane & 15, fq = lane >> 4;
    const int nt = g.K / BK;
    unsigned voffA[2], voffB[2];
#pragma unroll
    for (int i = 0; i < 2; ++i) { int R, C; stage_rc(tid * 16 + i * 8192, R, C); const int Rb = (R & ~31) + perm32(R & 31);
        voffA[i] = (unsigned)(R * g.lda + C) * 2u; voffB[i] = (unsigned)(Rb * g.ldb + C) * 2u; }
    const size_t kstep = (size_t)(BK * 2);
    const size_t hstepA = (size_t)HALF * g.lda * 2, hstepB = (size_t)HALF * g.ldb * 2;
    const size_t tstepA = 2 * hstepA, tstepB = 2 * hstepB;
    const size_t pnoffA = (size_t)g.a_pn_off * 2;
    const unsigned ldsw = (unsigned)wid * 1024u;
    const int aoff = lds_byte(wr * 64 + fr, fq * 8), boff = lds_byte(wc * 32 + fr, fq * 8);
#define PG8_SA(b, h) (((b) * 2 + (h)) * HTB)
#define PG8_SB(b, h) ((4 + (b) * 2 + (h)) * HTB)
#define PG8_STAGE(bufoff, gbase, voff) do { _Pragma("unroll") for (int _i = 0; _i < 2; ++_i) \
        __builtin_amdgcn_global_load_lds((const unsigned*)((const char*)(gbase) + (voff)[_i]), (LAS unsigned*)(lds + (bufoff) + ldsw + _i * 8192), 16, 0, 0); } while (0)
#define PG8_LDA(dst, b, h) do { _Pragma("unroll") for (int m = 0; m < 4; ++m) _Pragma("unroll") for (int k = 0; k < 2; ++k) dst[m][k] = *(const LAS bf16x8*)(lds + PG8_SA(b, h) + aoff + m * 2048 + k * 1024); } while (0)
#define PG8_LDB(dst, b, h) do { _Pragma("unroll") for (int n = 0; n < 2; ++n) _Pragma("unroll") for (int k = 0; k < 2; ++k) dst[n][k] = *(const LAS bf16x8*)(lds + PG8_SB(b, h) + boff + n * 2048 + k * 1024); } while (0)
#define PG8_MMA(ai, bj, At, Bt) do { __builtin_amdgcn_s_setprio(1); _Pragma("unroll") for (int m = 0; m < 4; ++m) _Pragma("unroll") for (int n = 0; n < 2; ++n) _Pragma("unroll") for (int k = 0; k < 2; ++k) \
        acc[ai][bj][m][n] = __builtin_amdgcn_mfma_f32_16x16x32_bf16(Bt[n][k], At[m][k], acc[ai][bj][m][n], 0, 0, 0); __builtin_amdgcn_s_setprio(0); } while (0)
#define PG8_WAIT_V(n) asm volatile("s_waitcnt vmcnt(" #n ")" ::: "memory")
#define PG8_WAIT_L(n) asm volatile("s_waitcnt lgkmcnt(" #n ")" ::: "memory")
#define PG8_BAR __builtin_amdgcn_s_barrier()
#define PG8_SCHED __builtin_amdgcn_sched_barrier(0)
    Unit cur, nxt; int ui = 0;
    if (!S.next(0, cur)) return;
    f32x4 acc[2][2][4][2];
#pragma unroll
    for (int a = 0; a < 2; ++a)
#pragma unroll
        for (int b = 0; b < 2; ++b)
#pragma unroll
            for (int m = 0; m < 4; ++m)
#pragma unroll
                for (int n = 0; n < 2; ++n) acc[a][b][m][n] = (f32x4){0.f, 0.f, 0.f, 0.f};
    bf16x8 At[4][2], B0[2][2], B1[2][2];
    const char* cA = (const char*)g.A + (size_t)cur.pm * tstepA + (size_t)cur.pn * pnoffA; const char* cB = (const char*)g.Bt + (size_t)cur.pn * tstepB;
    PG8_STAGE(PG8_SB(0, 0), cB, voffB); PG8_STAGE(PG8_SA(0, 0), cA, voffA); PG8_STAGE(PG8_SB(0, 1), cB + hstepB, voffB); PG8_STAGE(PG8_SA(0, 1), cA + hstepA, voffA);
    if (wr == 1) PG8_BAR;
    PG8_WAIT_V(4); PG8_BAR;
    PG8_STAGE(PG8_SB(1, 0), cB + kstep, voffB); PG8_STAGE(PG8_SA(1, 0), cA + kstep, voffA); PG8_STAGE(PG8_SB(1, 1), cB + hstepB + kstep, voffB);
    PG8_WAIT_V(6); PG8_BAR;
    for (;;) {
        const bool has_next = S.next(ui + 1, nxt);
        const char* nA = has_next ? (const char*)g.A + (size_t)nxt.pm * tstepA + (size_t)nxt.pn * pnoffA : cA; const char* nB = has_next ? (const char*)g.Bt + (size_t)nxt.pn * tstepB : cB;
        for (int t = 0; t < nt; t += 2) {
            const bool last = (t == nt - 2);
            const char* a1 = cA + (size_t)(t + 1) * kstep;
            const char* a2 = last ? nA : cA + (size_t)(t + 2) * kstep; const char* b2 = last ? nB : cB + (size_t)(t + 2) * kstep;
            const char* a3 = a2 + kstep; const char* b3 = b2 + kstep;
            PG8_LDB(B0, 0, 0); PG8_SCHED; PG8_LDA(At, 0, 0); PG8_STAGE(PG8_SA(1, 1), a1 + hstepA, voffA);
            PG8_WAIT_L(8); PG8_BAR; PG8_WAIT_L(0); PG8_MMA(0, 0, At, B0); PG8_BAR; PG8_SCHED;
            PG8_LDB(B1, 0, 1); PG8_STAGE(PG8_SB(0, 0), b2, voffB);
            PG8_BAR; PG8_WAIT_L(0); PG8_MMA(0, 1, At, B1); PG8_BAR;
            PG8_LDA(At, 0, 1); PG8_STAGE(PG8_SA(0, 0), a2, voffA);
            PG8_BAR; PG8_WAIT_L(0); PG8_MMA(1, 0, At, B0); PG8_BAR; PG8_SCHED;
            PG8_STAGE(PG8_SB(0, 1), b2 + hstepB, voffB);
            PG8_WAIT_V(6); PG8_BAR; PG8_MMA(1, 1, At, B1); PG8_BAR;
            PG8_LDB(B0, 1, 0); PG8_SCHED; PG8_LDA(At, 1, 0); PG8_STAGE(PG8_SA(0, 1), a2 + hstepA, voffA);
            PG8_WAIT_L(8); PG8_BAR; PG8_WAIT_L(0); PG8_MMA(0, 0, At, B0); PG8_BAR; PG8_SCHED;
            PG8_LDB(B1, 1, 1); PG8_STAGE(PG8_SB(1, 0), b3, voffB);
            PG8_BAR; PG8_WAIT_L(0); PG8_MMA(0, 1, At, B1); PG8_BAR;
            PG8_LDA(At, 1, 1); PG8_STAGE(PG8_SA(1, 0), a3, voffA);
            PG8_BAR; PG8_WAIT_L(0); PG8_MMA(1, 0, At, B0); PG8_BAR; PG8_SCHED;
            PG8_STAGE(PG8_SB(1, 1), b3 + hstepB, voffB);
            PG8_WAIT_V(6); PG8_BAR; PG8_MMA(1, 1, At, B1); PG8_BAR;
        }
        epilogue(E, acc, cur);
        if (!has_next) break;
#pragma unroll
        for (int a = 0; a < 2; ++a)
#pragma unroll
            for (int b = 0; b < 2; ++b)
#pragma unroll
                for (int m = 0; m < 4; ++m)
#pragma unroll
                    for (int n = 0; n < 2; ++n) acc[a][b][m][n] = (f32x4){0.f, 0.f, 0.f, 0.f};
        cur = nxt; cA = nA; cB = nB; ++ui;
    }
    PG8_WAIT_V(0);
    if (wr == 0) PG8_BAR;
    PG8_BAR;
#undef PG8_SA
#undef PG8_SB
#undef PG8_STAGE
#undef PG8_LDA
#undef PG8_LDB
#undef PG8_MMA
#undef PG8_WAIT_V
#undef PG8_WAIT_L
#undef PG8_BAR
#undef PG8_SCHED
}

__device__ __forceinline__ int win_dst_row(int n0) {
    if (n0 < D || n0 >= 3 * D) return n0;
    const int isv = n0 >= 2 * D, ch = n0 - (isv ? 2 * D : D);
    return D + (ch >> 7) * 256 + isv * 128 + (ch & 127);
}
__device__ __forceinline__ void transpose_item(const float* W, int K, int N, bf16_t* WT, int wperm, LAS float* scr, int item, int lane) {
    const int nblk = N / 32, kb = item / nblk, nb = item % nblk, k0 = 64 * kb, n0 = 32 * nb;
#pragma unroll 8
    for (int i = 0; i < 32; ++i) { const int kk = 2 * i + (lane >> 5); scr[kk * 33 + (lane & 31)] = W[(size_t)(k0 + kk) * N + n0 + (lane & 31)]; }
    LDS_WAIT(); asm volatile("" ::: "memory");
    const int c = lane & 7;
    const int drow0 = wperm ? win_dst_row(n0) : n0;
#pragma unroll
    for (int j = 0; j < 4; ++j) { const int n = (lane >> 3) + 8 * j; const LAS float* s = scr + (8 * c) * 33 + n;
        u32x4 o; o.x = cvt_pk_bf16(s[0 * 33], s[1 * 33]); o.y = cvt_pk_bf16(s[2 * 33], s[3 * 33]); o.z = cvt_pk_bf16(s[4 * 33], s[5 * 33]); o.w = cvt_pk_bf16(s[6 * 33], s[7 * 33]);
        *(u32x4*)(WT + (size_t)(drow0 + n) * K + k0 + 8 * c) = o; }
    LDS_WAIT(); asm volatile("" ::: "memory");
}
__device__ __forceinline__ void transpose_matrix(const float* W, int K, int N, bf16_t* WT, int wperm, LAS float* scr, int gw, int NGW, int lane, int& off) {
    const int nitems = (K / 64) * (N / 32);
    int start = gw - (off % NGW); if (start < 0) start += NGW;
    for (int it = start; it < nitems; it += NGW) transpose_item(W, K, N, WT, wperm, scr, it, lane);
    off += nitems;
}

enum { SE_F32 = 0, SE_SCALE = 1, SE_GATE = 2, SE_GATEADD = 3, SE_RELU2 = 4 };
struct SkGemm { int emode, lda, ldb, ldc, nCB, K, cbPerGrp, grpK, nKS; const bf16_t* A; const bf16_t* Bt; void* C; const float* projs; const float* vec; float* m1; };
__device__ __forceinline__ void skinny_gemm(LAS unsigned char* lds, const SkGemm& g, int task0, int tstride) {
    int tl = threadIdx.x; asm volatile("" : "+v"(tl));
    const int lane = tl & 63, wid = tl >> 6, fr = lane & 15, fq = lane >> 4;
    const int kw = g.K >> 3, nks = kw >> 5;
    for (int t = task0; t < g.nCB * g.nKS; t += tstride) {
        const int cb = t % g.nCB, ksl = t / g.nCB;
        const int kB = ksl * g.K + wid * kw, kA = kB + (cb / g.cbPerGrp) * g.grpK;
        f32x4 acc[8][2];
#pragma unroll
        for (int rb = 0; rb < 8; ++rb) { acc[rb][0] = (f32x4){0.f, 0.f, 0.f, 0.f}; acc[rb][1] = acc[rb][0]; }
        const bf16_t* bp = g.Bt + (size_t)(cb * 32 + fr) * g.ldb + kB + fq * 8;
        const bf16_t* ap = g.A + (size_t)fr * g.lda + kA + fq * 8;
        for (int ks = 0; ks < nks; ks += 2) {
            const bool two = ks + 1 < nks;
            bf16x8 a0[8], a1[8], b00, b01, b10, b11;
            b00 = *(const bf16x8*)(bp + ks * 32); b01 = *(const bf16x8*)(bp + (size_t)16 * g.ldb + ks * 32);
#pragma unroll
            for (int rb = 0; rb < 8; ++rb) a0[rb] = *(const bf16x8*)(ap + (size_t)rb * 16 * g.lda + ks * 32);
            if (two) {
                b10 = *(const bf16x8*)(bp + ks * 32 + 32); b11 = *(const bf16x8*)(bp + (size_t)16 * g.ldb + ks * 32 + 32);
#pragma unroll
                for (int rb = 0; rb < 8; ++rb) a1[rb] = *(const bf16x8*)(ap + (size_t)rb * 16 * g.lda + ks * 32 + 32);
            }
#pragma unroll
            for (int rb = 0; rb < 8; ++rb) {
                acc[rb][0] = __builtin_amdgcn_mfma_f32_16x16x32_bf16(b00, a0[rb], acc[rb][0], 0, 0, 0);
                acc[rb][1] = __builtin_amdgcn_mfma_f32_16x16x32_bf16(b01, a0[rb], acc[rb][1], 0, 0, 0);
            }
            if (two) {
#pragma unroll
                for (int rb = 0; rb < 8; ++rb) {
                    acc[rb][0] = __builtin_amdgcn_mfma_f32_16x16x32_bf16(b10, a1[rb], acc[rb][0], 0, 0, 0);
                    acc[rb][1] = __builtin_amdgcn_mfma_f32_16x16x32_bf16(b11, a1[rb], acc[rb][1], 0, 0, 0);
                }
            }
        }
#pragma unroll
        for (int rb = 0; rb < 8; ++rb)
#pragma unroll
            for (int c2 = 0; c2 < 2; ++c2) *(LAS f32x4*)(lds + wid * 16384 + ((rb * 2 + c2) * 64 + lane) * 16) = acc[rb][c2];
        __syncthreads();
#pragma unroll
        for (int h = 0; h < 2; ++h) {
            const int q = tl + h * 512, i = q >> 6, ls = q & 63;
            f32x4 v = *(const LAS f32x4*)(lds + q * 16);
#pragma unroll
            for (int w = 1; w < 8; ++w) v += *(const LAS f32x4*)(lds + w * 16384 + q * 16);
            const int row = (i >> 1) * 16 + (ls & 15), col = cb * 32 + (i & 1) * 16 + 4 * (ls >> 4);
            if (g.emode == SE_F32) *(f32x4*)((float*)g.C + (size_t)ksl * 128 * g.ldc + (size_t)row * g.ldc + col) = v;
            else if (g.emode == SE_GATE || g.emode == SE_GATEADD) {
                const int go = g.emode == SE_GATE ? 0 : D;
                f32x4 gt = *(const f32x4*)(g.projs + (size_t)row * DIN + 4 * D + go + col) + *(const f32x4*)(g.vec + go + col);
#pragma unroll
                for (int j = 0; j < 4; ++j) gt[j] = sigmoidf_(gt[j]);
                if (g.emode == SE_GATE) *(f32x4*)(g.m1 + (size_t)row * D + col) = gt * v;
                else { const f32x4 o = *(const f32x4*)(g.m1 + (size_t)row * D + col) + gt * v;
                    u32x2 w2; w2.x = cvt_pk_bf16(o[0], o[1]); w2.y = cvt_pk_bf16(o[2], o[3]); *(u32x2*)((bf16_t*)g.C + (size_t)row * g.ldc + col) = w2; }
            } else {
                f32x4 o;
                if (g.emode == SE_SCALE) o = v * *(const f32x4*)(g.vec + col);
                else {
#pragma unroll
                    for (int j = 0; j < 4; ++j) { const float u = fmaxf(v[j], 0.f); o[j] = u * u; }
                }
                u32x2 w2; w2.x = cvt_pk_bf16(o[0], o[1]); w2.y = cvt_pk_bf16(o[2], o[3]); *(u32x2*)((bf16_t*)g.C + (size_t)row * g.ldc + col) = w2;
            }
        }
        __syncthreads();
    }
}

__global__ void __launch_bounds__(512, 2) fwd_megakernel(Params p) {
    extern __shared__ __attribute__((aligned(16))) unsigned char shm[];
    LAS unsigned char* lds = (LAS unsigned char*)shm;
    cg::grid_group grid = cg::this_grid();
    const int tid = threadIdx.x;
    const int G = (int)gridDim.x, NGW = G * 8;
    unsigned char* ws = p.ws;
    bf16_t* S0 = (bf16_t*)(ws + 0 * SLOT); bf16_t* S1 = (bf16_t*)(ws + 1 * SLOT); bf16_t* S2 = (bf16_t*)(ws + 2 * SLOT);
    bf16_t* S3 = (bf16_t*)(ws + 3 * SLOT); bf16_t* S5 = (bf16_t*)(ws + 5 * SLOT);
    bf16_t* WIN = (bf16_t*)(ws + WS_WIN);
    unsigned char* sm = ws + WS_SM;
    float* PROJS = (float*)(sm + SM_PROJ); float* M1S = (float*)(sm + SM_M1);
    bf16_t* HS = (bf16_t*)(sm + SM_HS); bf16_t* YAS = (bf16_t*)(sm + SM_YAS); bf16_t* DDS = (bf16_t*)(sm + SM_DDS);
    bf16_t* YBS = (bf16_t*)(sm + SM_YBS); bf16_t* MRGS = (bf16_t*)(sm + SM_MRG); bf16_t* US = (bf16_t*)(sm + SM_US);
    float* X = p.out + O_Y;

    volatile LAS unsigned* xbst = (volatile LAS unsigned*)(lds + STAGE_BYTES);
    if (tid == 0) { xbst[0] = 0u; xbst[1] = 0u; xbst[2] = 0u; xbst[3] = 0u; }
    __syncthreads();
    XcdBarrier xb = xcd_barrier_post((unsigned*)(ws + WS_BAR), xbst);
#define GRID_BAR() xcd_barrier(xb)

    {
        const int lane = tid & 63, wid = tid >> 6, gw = (int)blockIdx.x * 8 + wid;
        LAS float* scr = (LAS float*)(lds + wid * 16384);
        int off = 0;
        transpose_matrix(p.in[4], D, DIN, WIN, 1, scr, gw, NGW, lane, off);
        for (int l = 0; l < NL; ++l) {
            unsigned char* wl = ws + WS_WL + (size_t)l * WL_BYTES;
            transpose_matrix(p.in[7] + (size_t)l * D * D, D, D, (bf16_t*)(wl + WL_WC), 0, scr, gw, NGW, lane, off);
            transpose_matrix(p.in[10] + (size_t)l * D * D, D, D, (bf16_t*)(wl + WL_WP), 0, scr, gw, NGW, lane, off);
            transpose_matrix(p.in[11] + (size_t)l * D * D, D, D, (bf16_t*)(wl + WL_WO), 0, scr, gw, NGW, lane, off);
            for (int gi = 0; gi < 4; ++gi)
                transpose_matrix(p.in[8] + (size_t)l * 4 * 65536 + (size_t)gi * 65536, 256, 256, (bf16_t*)(wl + WL_POOL) + (size_t)gi * 65536, 0, scr, gw, NGW, lane, off);
            transpose_matrix(p.in[14] + (size_t)l * D * DFF, D, DFF, (bf16_t*)(wl + WL_UP), 0, scr, gw, NGW, lane, off);
            transpose_matrix(p.in[15] + (size_t)l * DFF * D, DFF, D, (bf16_t*)(wl + WL_DOWN), 0, scr, gw, NGW, lane, off);
        }
        const float* gpre = p.in[12];
        f32x4 gv[4];
#pragma unroll
        for (int j = 0; j < 4; ++j) gv[j] = *(const f32x4*)(gpre + lane * 4 + 256 * j);
        for (int r = gw; r < MTOT; r += NGW) {
            const float* xr = r < MP ? p.in[0] + (size_t)r * D : p.in[1] + (size_t)(r - MP) * D;
            bf16_t* hr = r < MP ? S0 + (size_t)r * D : HS + (size_t)(r - MP) * D;
            f32x4 v[4]; float s = 0.f;
#pragma unroll
            for (int j = 0; j < 4; ++j) { v[j] = *(const f32x4*)(xr + lane * 4 + 256 * j); s += (v[j][0] * v[j][0] + v[j][1] * v[j][1]) + (v[j][2] * v[j][2] + v[j][3] * v[j][3]); }
            const float rs = rsqrtf(wave_sum(s) * (1.f / D) + EPS);
#pragma unroll
            for (int j = 0; j < 4; ++j) { u32x2 o; o.x = cvt_pk_bf16(v[j][0] * rs * gv[j][0], v[j][1] * rs * gv[j][1]); o.y = cvt_pk_bf16(v[j][2] * rs * gv[j][2], v[j][3] * rs * gv[j][3]);
                *(u32x2*)(hr + lane * 4 + 256 * j) = o; }
        }
    }
    grid.sync();

    for (int step = 0; step < p.nsteps; ++step) {
        const int l = step / 10, ph = step - l * 10;
        int tid_s = threadIdx.x; asm volatile("" : "+v"(tid_s));
        const int lane = tid_s & 63, wid = tid_s >> 6, gw = (int)blockIdx.x * 8 + wid;
        unsigned char* wl = ws + WS_WL + (size_t)l * WL_BYTES;
        const float* bgate = p.in[5] + (size_t)l * 2 * D;
        Gemm g{S0, WIN, D, D, D, MP / BM, D / BM, 0};
        Epi E{E_PLAIN, D, S1, nullptr, nullptr, nullptr, ws};
        SkGemm sk{SE_F32, D, D, D, D / 32, D, 1 << 20, 0, 1, HS, WIN, PROJS, PROJS, bgate, M1S};
        bool is_gemm = true;
        switch (ph) {
        case 0:
            g.nN = DIN / BM; E.id = E_PROJ; E.vec = bgate;
            sk.ldc = DIN; sk.nCB = DIN / 32; sk.C = PROJS; break;
        case 2:
            g.Bt = (const bf16_t*)(wl + WL_POOL); g.ldb = 256; g.K = 256; g.nN = 4; g.a_pn_off = 256;
            E.id = E_SCALE; E.o0 = S2; E.vec = p.in[9] + (size_t)l * D;
            sk.emode = SE_SCALE; sk.A = DDS; sk.Bt = g.Bt; sk.ldb = 256; sk.K = 256; sk.cbPerGrp = 8; sk.grpK = 256; sk.C = YBS; sk.vec = E.vec; break;
        case 3:
            g.A = S1; g.Bt = (const bf16_t*)(wl + WL_WC); E.id = E_GATE; E.o0 = S3; E.x0 = (const bf16_t*)(ws + 4 * SLOT);
            sk.emode = SE_GATE; sk.A = YAS; sk.Bt = g.Bt; break;
        case 4:
            g.A = S2; g.Bt = (const bf16_t*)(wl + WL_WP); E.id = E_GATEADD; E.o0 = S0; E.x0 = S5; E.x1 = S3;
            sk.emode = SE_GATEADD; sk.A = YBS; sk.Bt = g.Bt; sk.C = MRGS; break;
        case 5:
            g.Bt = (const bf16_t*)(wl + WL_WO);
            sk.A = MRGS; sk.Bt = g.Bt; sk.K = 256; sk.nKS = 4; break;
        case 7:
            g.Bt = (const bf16_t*)(wl + WL_UP); g.nN = DFF / BM; E.id = E_RELU2; E.ldc = DFF;
            sk.emode = SE_RELU2; sk.Bt = g.Bt; sk.ldc = DFF; sk.nCB = DFF / 32; sk.C = US; break;
        case 8:
            g.A = S1; g.Bt = (const bf16_t*)(wl + WL_DOWN); g.lda = DFF; g.ldb = DFF; g.K = DFF; E.o0 = S5;
            sk.A = US; sk.lda = DFF; sk.Bt = g.Bt; sk.ldb = DFF; sk.K = D; sk.nKS = 4; break;
        default: is_gemm = false; break;
        }
        if (is_gemm) {
            skinny_gemm(lds, sk, (int)blockIdx.x, G);
            StaticOrder S; S.init(g.nM, g.nN, G, (int)blockIdx.x);
            gemm_phase(lds, g, S, E);
        } else if (ph == 1) {
            const float* cw = p.in[6] + (size_t)l * 3 * D;
            const float* cconv = p.in[2] + (size_t)l * NB_S * 2 * D;
            const float* cpool = p.in[3] + (size_t)l * NB_S * 15 * D;
            float* o_csp = p.out + O_CSP + (size_t)l * 2 * D;
            float* o_psp = p.out + O_PSP + (size_t)l * 15 * D;
            float* o_css = p.out + O_CSS + (size_t)l * NB_S * 2 * D;
            float* o_pss = p.out + O_PSS + (size_t)l * NB_S * 15 * D;
            constexpr int NSMP = MS / 2 * 4;
            constexpr int NSLOW = NSMP + 16 / 2 * 4;
            constexpr int NFAST = ((MP / 16 - 1) * 4 + 1) / 2;
            for (int it = gw; it < NSLOW + NFAST; it += NGW) {
                if (it < NSLOW) {
                    const int gi = it & 3, ch = gi * 256 + (lane & 31) * 8, w = 2 << gi;
                    const f32x4 w0a = *(const f32x4*)(cw + ch), w0b = *(const f32x4*)(cw + ch + 4);
                    const f32x4 w1a = *(const f32x4*)(cw + D + ch), w1b = *(const f32x4*)(cw + D + ch + 4);
                    const f32x4 w2a = *(const f32x4*)(cw + 2 * D + ch), w2b = *(const f32x4*)(cw + 2 * D + ch + 4);
                    const f32x4 zero4 = (f32x4){0.f, 0.f, 0.f, 0.f};
                    if (it < NSMP) {
                        const int rs = (it >> 2) * 2 + (lane >> 5), sb = rs >> 4, t = rs & 15;
                        const int cc = D + (ch >> 7) * 256 + (ch & 127);
                        const float* pr = PROJS + (size_t)rs * DIN;
                        const f32x4 b0 = *(const f32x4*)(pr + ch), b1 = *(const f32x4*)(pr + ch + 4);
                        const f32x4 z0a = *(const f32x4*)(pr + cc) * *(const f32x4*)(pr + cc + 128), z0b = *(const f32x4*)(pr + cc + 4) * *(const f32x4*)(pr + cc + 132);
                        const f32x4 p0a = *(const f32x4*)(pr + 3 * D + ch), p0b = *(const f32x4*)(pr + 3 * D + ch + 4);
                        f32x4 z1a, z1b, z2a, z2b;
                        if (t >= 1) { const float* q = pr - DIN; z1a = *(const f32x4*)(q + cc) * *(const f32x4*)(q + cc + 128); z1b = *(const f32x4*)(q + cc + 4) * *(const f32x4*)(q + cc + 132); }
                        else { const float* q = cconv + ((size_t)sb * 2 + 1) * D + ch; z1a = *(const f32x4*)q; z1b = *(const f32x4*)(q + 4); }
                        if (t >= 2) { const float* q = pr - 2 * DIN; z2a = *(const f32x4*)(q + cc) * *(const f32x4*)(q + cc + 128); z2b = *(const f32x4*)(q + cc + 4) * *(const f32x4*)(q + cc + 132); }
                        else { const float* q = cconv + ((size_t)sb * 2 + t) * D + ch; z2a = *(const f32x4*)q; z2b = *(const f32x4*)(q + 4); }
                        f32x4 sa = p0a, sb2 = p0b;
                        for (int i = 1; i < w; ++i) {
                            const float* q = (t - i >= 0) ? pr - (size_t)i * DIN + 3 * D + ch : cpool + ((size_t)sb * 15 + (15 + t - i)) * D + ch;
                            sa += *(const f32x4*)q; sb2 += *(const f32x4*)(q + 4);
                        }
                        const float ic = 1.0f / (float)w;
                        st8(YAS + (size_t)rs * D + ch, b0 * (w0a * z2a + w1a * z1a + w2a * z0a), b1 * (w0b * z2b + w1b * z1b + w2b * z0b));
                        st8(DDS + (size_t)rs * D + ch, sa * ic - p0a, sb2 * ic - p0b);
                        if (t >= SEQ_S - 2) { float* o = o_css + ((size_t)sb * 2 + (t - (SEQ_S - 2))) * D + ch; *(f32x4*)o = z0a; *(f32x4*)(o + 4) = z0b; }
                        if (t >= 1) { float* o = o_pss + ((size_t)sb * 15 + (t - 1)) * D + ch; *(f32x4*)o = p0a; *(f32x4*)(o + 4) = p0b; }
                    } else {
                        const int r = ((it - NSMP) >> 2) * 2 + (lane >> 5), t = r;
                        f32x4 b0, b1, z0a, z0b, z1a = zero4, z1b = zero4, z2a = zero4, z2b = zero4, p0a, p0b;
                        ld8(S1 + (size_t)r * D + ch, b0, b1);
                        ld8(S2 + (size_t)r * D + ch, z0a, z0b);
                        ld8(S3 + (size_t)r * D + ch, p0a, p0b);
                        if (t >= 1) ld8(S2 + (size_t)(r - 1) * D + ch, z1a, z1b);
                        if (t >= 2) ld8(S2 + (size_t)(r - 2) * D + ch, z2a, z2b);
                        f32x4 sa = p0a, sb2 = p0b;
                        for (int i = 1; i < w; ++i) if (t - i >= 0) { f32x4 qa, qb; ld8(S3 + (size_t)(r - i) * D + ch, qa, qb); sa += qa; sb2 += qb; }
                        const int cnt = t + 1 < w ? t + 1 : w;
                        const float ic = 1.0f / (float)cnt;
                        st8(S1 + (size_t)r * D + ch, b0 * (w0a * z2a + w1a * z1a + w2a * z0a), b1 * (w0b * z2b + w1b * z1b + w2b * z0b));
                        st8(S0 + (size_t)r * D + ch, sa * ic - p0a, sb2 * ic - p0b);
                    }
                } else {
                    const int hi = (it - NSLOW) * 2 + (lane >> 5);
                    if (hi < (MP / 16 - 1) * 4) {
                        const int gi = hi & 3, r0 = ((hi >> 2) + 1) * 16, ch = gi * 256 + (lane & 31) * 8, w = 2 << gi;
                        const float ic = 1.0f / (float)w;
                        const f32x4 w0a = *(const f32x4*)(cw + ch), w0b = *(const f32x4*)(cw + ch + 4);
                        const f32x4 w1a = *(const f32x4*)(cw + D + ch), w1b = *(const f32x4*)(cw + D + ch + 4);
                        const f32x4 w2a = *(const f32x4*)(cw + 2 * D + ch), w2b = *(const f32x4*)(cw + 2 * D + ch + 4);
                        f32x4 z1a, z1b, z2a, z2b;
                        ld8(S2 + (size_t)(r0 - 1) * D + ch, z1a, z1b);
                        ld8(S2 + (size_t)(r0 - 2) * D + ch, z2a, z2b);
                        f32x4 sa = (f32x4){0.f, 0.f, 0.f, 0.f}, sb2 = sa;
                        for (int i = 1; i < w; ++i) { f32x4 qa, qb; ld8(S3 + (size_t)(r0 - i) * D + ch, qa, qb); sa += qa; sb2 += qb; }
#pragma unroll 4
                        for (int k = 0; k < 16; ++k) {
                            const size_t ro = (size_t)(r0 + k) * D + ch;
                            f32x4 b0, b1, z0a, z0b, p0a, p0b, oa, ob;
                            ld8(S1 + ro, b0, b1);
                            ld8(S2 + ro, z0a, z0b);
                            ld8(S3 + ro, p0a, p0b);
                            ld8(S3 + ro - (size_t)(w - 1) * D, oa, ob);
                            sa += p0a; sb2 += p0b;
                            st8(S1 + ro, b0 * (w0a * z2a + w1a * z1a + w2a * z0a), b1 * (w0b * z2b + w1b * z1b + w2b * z0b));
                            st8(S0 + ro, sa * ic - p0a, sb2 * ic - p0b);
                            sa -= oa; sb2 -= ob;
                            z2a = z1a; z2b = z1b; z1a = z0a; z1b = z0b;
                            const int t = r0 + k;
                            if (t >= MP - 2) { float* o = o_csp + (size_t)(t - (MP - 2)) * D + ch; *(f32x4*)o = z0a; *(f32x4*)(o + 4) = z0b; }
                            if (t >= MP - 15) { float* o = o_psp + (size_t)(t - (MP - 15)) * D + ch; *(f32x4*)o = p0a; *(f32x4*)(o + 4) = p0b; }
                        }
                    }
                }
            }
            if (l + 1 < NL) {
                LAS float* scr = (LAS float*)(lds + wid * 16384);
                int off = 0;
                transpose_matrix(p.in[4] + (size_t)(l + 1) * D * DIN, D, DIN, WIN, 1, scr, gw, NGW, lane, off);
            }
        } else {
            const int half = ph == 6 ? 0 : 1;
            const bf16_t* Y = half == 0 ? S1 : S5;
            const float* gpost = (half == 0 ? p.in[13] : p.in[17]) + (size_t)l * D;
            const float* gnext = half == 0 ? p.in[16] + (size_t)l * D : p.in[12] + (size_t)(l + 1 < NL ? l + 1 : l) * D;
            const bool from_input = (l == 0 && half == 0);
            f32x4 gp[4], gn[4];
#pragma unroll
            for (int j = 0; j < 4; ++j) { gp[j] = *(const f32x4*)(gpost + lane * 4 + 256 * j); gn[j] = *(const f32x4*)(gnext + lane * 4 + 256 * j); }
            for (int r = gw; r < MTOT; r += NGW) {
                const float* xr = from_input ? (r < MP ? p.in[0] + (size_t)r * D : p.in[1] + (size_t)(r - MP) * D) : X + (size_t)r * D;
                bf16_t* hr = r < MP ? S0 + (size_t)r * D : HS + (size_t)(r - MP) * D;
                f32x4 xv[4], yv[4]; float s = 0.f;
#pragma unroll
                for (int j = 0; j < 4; ++j) {
                    xv[j] = *(const f32x4*)(xr + lane * 4 + 256 * j);
                    if (r < MP) {
                        const u32x2 wv = *(const u32x2*)(Y + (size_t)r * D + lane * 4 + 256 * j);
                        yv[j][0] = bf_lo(wv.x); yv[j][1] = bf_hi(wv.x); yv[j][2] = bf_lo(wv.y); yv[j][3] = bf_hi(wv.y);
                    } else { const float* q = PROJS + (size_t)(r - MP) * D + lane * 4 + 256 * j;
                        yv[j] = (*(const f32x4*)q + *(const f32x4*)(q + MS * D)) + (*(const f32x4*)(q + 2 * MS * D) + *(const f32x4*)(q + 3 * MS * D)); }
                    s += (yv[j][0] * yv[j][0] + yv[j][1] * yv[j][1]) + (yv[j][2] * yv[j][2] + yv[j][3] * yv[j][3]);
                }
                const float rs = rsqrtf(wave_sum(s) * (1.f / D) + EPS);
                float s2 = 0.f;
#pragma unroll
                for (int j = 0; j < 4; ++j) { xv[j] = xv[j] + yv[j] * rs * gp[j]; s2 += (xv[j][0] * xv[j][0] + xv[j][1] * xv[j][1]) + (xv[j][2] * xv[j][2] + xv[j][3] * xv[j][3]);
                    *(f32x4*)(X + (size_t)r * D + lane * 4 + 256 * j) = xv[j]; }
                const float rs2 = rsqrtf(wave_sum(s2) * (1.f / D) + EPS);
#pragma unroll
                for (int j = 0; j < 4; ++j) { u32x2 o; o.x = cvt_pk_bf16(xv[j][0] * rs2 * gn[j][0], xv[j][1] * rs2 * gn[j][1]); o.y = cvt_pk_bf16(xv[j][2] * rs2 * gn[j][2], xv[j][3] * rs2 * gn[j][3]);
                    *(u32x2*)(hr + lane * 4 + 256 * j) = o; }
            }
        }
        if (step + 1 < p.nsteps) GRID_BAR();
    }
}

extern "C" void kernel_launch(void* const* d_in, const int* in_sizes, int n_in, void* d_out, int out_size, void* d_ws, size_t ws_size, hipStream_t stream) {
    static int grid = 0;
    if (grid == 0) {
        if (n_in != 18 || ws_size < WS_END) { fprintf(stderr, "kernel_launch: unexpected n_in %d or ws_size %zu (< %zu)\n", n_in, ws_size, (size_t)WS_END); grid = -1; return; }
        int dev = 0, cus = 0, per_cu = 0;
        hipGetDevice(&dev);
        hipDeviceGetAttribute(&cus, hipDeviceAttributeMultiprocessorCount, dev);
        if (hipFuncSetAttribute((const void*)fwd_megakernel, hipFuncAttributeMaxDynamicSharedMemorySize, LDS_BYTES) != hipSuccess) { fprintf(stderr, "kernel_launch: hipFuncSetAttribute failed\n"); grid = -1; return; }
        if (hipOccupancyMaxActiveBlocksPerMultiprocessor(&per_cu, (const void*)fwd_megakernel, 512, LDS_BYTES) != hipSuccess || per_cu < 1) { fprintf(stderr, "kernel_launch: occupancy query failed (%d)\n", per_cu); grid = -1; return; }
        grid = cus * per_cu;
    }
    if (grid < 0) return;
    (void)hipMemsetAsync((unsigned char*)d_ws + WS_BAR, 0, 16384, stream);
    Params p{};
    for (int i = 0; i < 18; ++i) p.in[i] = (const float*)d_in[i];
    p.out = (float*)d_out; p.ws = (unsigned char*)d_ws; p.nsteps = NL * 10; p.pad = PROBE;
    void* args[] = {&p};
    hipError_t e = hipLaunchCooperativeKernel((const void*)fwd_megakernel, dim3(grid), dim3(512), args, LDS_BYTES, stream);
    if (e != hipSuccess) fprintf(stderr, "cooperative launch failed: %s (grid %d)\n", hipGetErrorString(e), grid);
}
```

```cpp
#include <hip/hip_runtime.h>
#include <hip/hip_cooperative_groups.h>
#include <cstdio>
namespace cg = cooperative_groups;

#ifndef SKELETON
#define SKELETON 0
#endif
#ifndef STOP_AFTER
#define STOP_AFTER 99
#endif
#ifndef PROBE
#define PROBE 0
#ifndef STAGGER_TICKS
#define STAGGER_TICKS 350
#endif
#endif
#ifndef USE_CG_ONLY
#define USE_CG_ONLY 0
#endif

#define LAS __attribute__((address_space(3)))
typedef unsigned short bf16_t;
typedef short bf16x8 __attribute__((ext_vector_type(8)));
typedef float f32x4 __attribute__((ext_vector_type(4)));
typedef unsigned u32x4 __attribute__((ext_vector_type(4)));
typedef unsigned u32x2 __attribute__((ext_vector_type(2)));

constexpr int D = 1024, DIN = 6144, DFF = 4096, NL = 2;
constexpr int MP = 16384, MS = 128, MTOT = MP + MS, MPAD = MP;
constexpr int SEQ_S = 16, NB_S = 8, PAST = 2048;
constexpr int BM = 256, BK = 64, HALF = 128, HTB = HALF * BK * 2, STAGE_BYTES = 8 * HTB, NXCD = 8, WGM = 8;
constexpr int LDS_BYTES = STAGE_BYTES + 64;
constexpr float EPS = 1e-6f;

constexpr size_t SLOT = (size_t)MPAD * 1024 * 2;
constexpr size_t WS_WIN = 6 * SLOT;
constexpr size_t WIN_BYTES = (size_t)DIN * D * 2;
constexpr size_t WL_WC = 0, WL_WP = 2097152, WL_WO = 4194304, WL_POOL = 6291456, WL_UP = 6815744, WL_DOWN = 15204352, WL_BYTES = 23592960;
constexpr size_t WS_WL = WS_WIN + WIN_BYTES;
constexpr size_t WS_BAR = WS_WL + NL * WL_BYTES;
constexpr size_t CTL_BYTES = 49152, CTL_TCNT = 16384, CTL_GCNT = 32768, CTL_SCNT = 36864;
constexpr size_t WS_SM = WS_BAR + CTL_BYTES;
constexpr size_t SM_PROJ = 0, SM_M1 = 3145728, SM_HS = 3670016, SM_YAS = 3932160, SM_DDS = 4194304, SM_YBS = 4456448, SM_MRG = 4718592, SM_US = 4980736, SM_BYTES = 6029312;
constexpr size_t WS_END = WS_SM + SM_BYTES;

constexpr size_t O_Y = 0, O_CSP = (size_t)MTOT * D, O_PSP = O_CSP + NL * 2 * D, O_CSS = O_PSP + NL * 15 * D, O_PSS = O_CSS + (size_t)NL * NB_S * 2 * D;

struct Params {
    const float* in[18];
    float* out;
    unsigned char* ws;
    int nsteps, pad;
};

__device__ __forceinline__ unsigned cvt_pk_bf16(float lo, float hi) { unsigned r; asm volatile("v_cvt_pk_bf16_f32 %0, %1, %2" : "=v"(r) : "v"(lo), "v"(hi)); return r; }
__device__ __forceinline__ float bf_lo(unsigned w) { return __uint_as_float(w << 16); }
__device__ __forceinline__ float bf_hi(unsigned w) { return __uint_as_float(w & 0xffff0000u); }
__device__ __forceinline__ void st16_wt(void* p, u32x4 w) { asm volatile("global_store_dwordx4 %0, %1, off sc1\n\ts_nop 1" :: "v"(p), "v"(w) : "memory"); }
__device__ __forceinline__ void st8_wt(void* p, u32x2 w) { asm volatile("global_store_dwordx2 %0, %1, off sc1\n\ts_nop 1" :: "v"(p), "v"(w) : "memory"); }
__device__ __forceinline__ void st8(bf16_t* p, f32x4 a, f32x4 b) {
    u32x4 w; w.x = cvt_pk_bf16(a[0], a[1]); w.y = cvt_pk_bf16(a[2], a[3]); w.z = cvt_pk_bf16(b[0], b[1]); w.w = cvt_pk_bf16(b[2], b[3]);
    st16_wt(p, w);
}
__device__ __forceinline__ void ld8(const bf16_t* p, f32x4& a, f32x4& b) {
    const u32x4 w = *(const u32x4*)p;
    a[0] = bf_lo(w.x); a[1] = bf_hi(w.x); a[2] = bf_lo(w.y); a[3] = bf_hi(w.y);
    b[0] = bf_lo(w.z); b[1] = bf_hi(w.z); b[2] = bf_lo(w.w); b[3] = bf_hi(w.w);
}
__device__ __forceinline__ float sigmoidf_(float x) { return 1.0f / (1.0f + __expf(-x)); }
__device__ __forceinline__ float wave_sum(float v) {
#pragma unroll
    for (int o = 1; o < 64; o <<= 1) v += __shfl_xor(v, o);
    return v;
}
#define LDS_WAIT() asm volatile("s_waitcnt lgkmcnt(0)" ::: "memory")

#define XB_TMO      128
#define XB_XCNT(j)  (256  + 64 * (j))
#define XB_XSUB(j)  (1280 + 64 * (j))
#define XB_XGEN(j)  (2304 + 64 * (j))
#define XB_TOP      3328
#define XB_TOPGEN   3392
#define XCD_BAR_WORDS 3456
#define XB_SPIN_CAP (1u << 18)
__device__ __forceinline__ unsigned xb_ld(unsigned* p)              { return __hip_atomic_load(p, __ATOMIC_RELAXED, __HIP_MEMORY_SCOPE_AGENT); }
__device__ __forceinline__ unsigned xb_add(unsigned* p, unsigned v) { return __hip_atomic_fetch_add(p, v, __ATOMIC_RELAXED, __HIP_MEMORY_SCOPE_AGENT); }
__device__ __forceinline__ unsigned xb_xcc_id() { return (unsigned)__builtin_amdgcn_s_getreg((3 << 11) | 20) & 0xFu; }
#define XB_SPIN(cond, bar) do { unsigned _sp = 0; while (cond) { __builtin_amdgcn_s_sleep(1); \
    if ((++_sp & 255u) == 0u) { if (xb_ld(&(bar)[XB_TMO])) break; if (_sp > XB_SPIN_CAP) { atomicAdd(&(bar)[XB_TMO], 1u); break; } } } } while (0)
struct XcdBarrier { unsigned* bar; unsigned x; volatile LAS unsigned* st; };
__device__ __forceinline__ XcdBarrier xcd_barrier_post(unsigned* bar, volatile LAS unsigned* st) {
    XcdBarrier b; b.bar = bar; b.x = xb_xcc_id(); b.st = st;
    if (threadIdx.x == 0) (void)xb_add(&bar[XB_XCNT(b.x)], 1u);
    return b;
}
__device__ __forceinline__ void xcd_barrier_complete(unsigned* bar, unsigned x, unsigned& nloc, unsigned& nx) {
    const unsigned G = gridDim.x * gridDim.y * gridDim.z;
    unsigned sum, cnt, mine, sp = 0u;
    for (;;) {
        sum = 0u; cnt = 0u; mine = 0u;
#pragma unroll
        for (unsigned j = 0; j < 16; ++j) { const unsigned c = xb_ld(&bar[XB_XCNT(j)]); sum += c; cnt += (c > 0u) ? 1u : 0u; mine = (j == x) ? c : mine; }
        if (sum == G) break;
        __builtin_amdgcn_s_sleep(1);
        if ((++sp & 255u) == 0u) { if (xb_ld(&bar[XB_TMO])) break; if (sp > XB_SPIN_CAP) { atomicAdd(&bar[XB_TMO], 1u); break; } }
    }
    nloc = mine > 0u ? mine : 1u; nx = cnt > 0u ? cnt : 1u;
}
__device__ __forceinline__ void xcd_barrier(const XcdBarrier& b) {
    asm volatile("s_waitcnt vmcnt(0)" ::: "memory");
    __syncthreads();
    if (threadIdx.x == 0) {
        unsigned* bar = b.bar;
        __builtin_amdgcn_s_waitcnt(0);
        unsigned nloc = b.st[0], nx = b.st[1];
        if (nloc == 0u) { xcd_barrier_complete(bar, b.x, nloc, nx); b.st[0] = nloc; b.st[1] = nx; }
        const unsigned old = xb_add(&bar[XB_XSUB(b.x)], 1u);
        const unsigned gen = old / nloc;
        if (old + 1u == (gen + 1u) * nloc) {
            __builtin_amdgcn_fence(__ATOMIC_RELEASE, "agent");
            asm volatile("s_waitcnt vmcnt(0)" ::: "memory");
            const unsigned og = xb_add(&bar[XB_TOP], 1u);
            const unsigned tg = og / nx;
            if (og + 1u == (tg + 1u) * nx) xb_add(&bar[XB_TOPGEN], 1u);
            else XB_SPIN(xb_ld(&bar[XB_TOPGEN]) == tg, bar);
            __builtin_amdgcn_fence(__ATOMIC_ACQUIRE, "agent");
            xb_add(&bar[XB_XGEN(b.x)], 1u);
            asm volatile("s_waitcnt vmcnt(0)" ::: "memory");
        } else {
            XB_SPIN(xb_ld(&bar[XB_XGEN(b.x)]) == gen, bar);
            __builtin_amdgcn_fence(__ATOMIC_ACQUIRE, "agent");
            asm volatile("s_waitcnt vmcnt(0)" ::: "memory");
        }
    }
    __syncthreads();
}

__device__ __forceinline__ int lds_byte(int r, int c) { const int st = (r >> 4) * 2 + (c >> 5), rr = r & 15, cc = c & 31, ob = rr * 64 + cc * 2; return st * 1024 + (ob ^ (((ob >> 9) & 1) << 5)); }
__device__ __forceinline__ void stage_rc(int b, int& R, int& C) { const int st = b / 1024, sb = b % 1024, swz = sb ^ (((sb >> 9) & 1) << 5); R = (st >> 1) * 16 + swz / 64; C = (st & 1) * 32 + (swz % 64) / 2; }
__device__ __forceinline__ int perm32(int rho) { const int n = rho >> 4, i = rho & 15; return 8 * (i >> 2) + 4 * n + (i & 3); }

struct Unit { int pm, pn; };
struct Gemm { const bf16_t* A; const bf16_t* Bt; int lda, ldb, K, nM, nN, a_pn_off, a_wrap_shift; size_t a_wrap_stride; };
struct StaticOrder {
    int nM, nN, nwg, G, c;
    __device__ void init(int nM_, int nN_, int G_, int c_) { nM = nM_; nN = nN_; nwg = nM * nN; G = G_; c = c_; }
    __device__ bool next(int i, Unit& u) const {
        const long L = (long)i * G + c; if (L >= nwg) return false;
        int wgid = (int)L; { const int q = nwg / NXCD, r = nwg % NXCD, xcd = wgid % NXCD, off = wgid / NXCD; wgid = (xcd < r ? xcd * (q + 1) : r * (q + 1) + (xcd - r) * q) + off; }
        const int nig = WGM * nN, gid = wgid / nig, fm = gid * WGM, gsz = (nM - fm) < WGM ? (nM - fm) : WGM;
        u.pm = fm + ((wgid % nig) % gsz); u.pn = (wgid % nig) / gsz; return true;
    }
};

enum { E_PROJ = 0, E_SCALE = 1, E_GATE = 2, E_GATEADD = 3, E_PLAIN = 4, E_RELU2 = 5 };
struct Epi { int id, ldc; bf16_t* o0; const bf16_t* x0; const bf16_t* x1; const float* vec; unsigned char* ws; };

__device__ __forceinline__ void epilogue(const Epi& E, const f32x4 (&acc)[2][2][4][2], const Unit& u) {
    int tl = threadIdx.x; asm volatile("" : "+v"(tl));
    const int wv = tl >> 6, ln = tl & 63, wr = wv >> 2, wc = wv & 3, fr = ln & 15, fq = ln >> 4;
    if (E.id == 99) return;
    const int row0 = u.pm * BM + wr * 64 + fr;
    const int colw = wc * 32 + 8 * fq;
    if (E.id == E_PROJ) {
        if (u.pn >= 4 && u.pn < 12) {
            const int ch = (u.pn - 4) * 128 + colw;
#pragma unroll
            for (int ai = 0; ai < 2; ++ai)
#pragma unroll
                for (int m = 0; m < 4; ++m) {
                    const size_t r = (size_t)(row0 + ai * HALF + m * 16);
                    st8((bf16_t*)(E.ws + 2 * SLOT) + r * D + ch, acc[ai][0][m][0] * acc[ai][1][m][0], acc[ai][0][m][1] * acc[ai][1][m][1]);
                }
        } else if (u.pn >= 16) {
            const int gc0 = (u.pn - 16) * BM;
            bf16_t* O = (bf16_t*)(E.ws + (gc0 < D ? 4 : 5) * SLOT);
            const int oc0 = gc0 & (D - 1);
#pragma unroll
            for (int bj = 0; bj < 2; ++bj) {
                const f32x4 b0 = *(const f32x4*)(E.vec + gc0 + bj * HALF + colw), b1 = *(const f32x4*)(E.vec + gc0 + bj * HALF + colw + 4);
#pragma unroll
                for (int ai = 0; ai < 2; ++ai)
#pragma unroll
                    for (int m = 0; m < 4; ++m) {
                        const size_t r = (size_t)(row0 + ai * HALF + m * 16);
                        f32x4 v0 = acc[ai][bj][m][0] + b0, v1 = acc[ai][bj][m][1] + b1;
#pragma unroll
                        for (int j = 0; j < 4; ++j) { v0[j] = sigmoidf_(v0[j]); v1[j] = sigmoidf_(v1[j]); }
                        st8(O + r * D + oc0 + bj * HALF + colw, v0, v1);
                    }
            }
        } else {
            bf16_t* O = (bf16_t*)(E.ws + (u.pn < 4 ? 1 : 3) * SLOT);
            const int oc0 = (u.pn & 3) * BM;
#pragma unroll
            for (int ai = 0; ai < 2; ++ai)
#pragma unroll
                for (int m = 0; m < 4; ++m) {
                    const size_t r = (size_t)(row0 + ai * HALF + m * 16);
#pragma unroll
                    for (int bj = 0; bj < 2; ++bj) st8(O + r * D + oc0 + bj * HALF + colw, acc[ai][bj][m][0], acc[ai][bj][m][1]);
                }
        }
        return;
    }
    const int col0 = u.pn * BM + colw;
    if (E.id == E_SCALE) {
#pragma unroll
        for (int bj = 0; bj < 2; ++bj) {
            const f32x4 s0 = *(const f32x4*)(E.vec + col0 + bj * HALF), s1 = *(const f32x4*)(E.vec + col0 + bj * HALF + 4);
#pragma unroll
            for (int ai = 0; ai < 2; ++ai)
#pragma unroll
                for (int m = 0; m < 4; ++m) {
                    const size_t r = (size_t)(row0 + ai * HALF + m * 16);
                    st8(E.o0 + r * E.ldc + col0 + bj * HALF, acc[ai][bj][m][0] * s0, acc[ai][bj][m][1] * s1);
                }
        }
    } else if (E.id == E_GATE) {
#pragma unroll
        for (int ai = 0; ai < 2; ++ai)
#pragma unroll
            for (int m = 0; m < 4; ++m) {
                const size_t r = (size_t)(row0 + ai * HALF + m * 16);
#pragma unroll
                for (int bj = 0; bj < 2; ++bj) {
                    f32x4 g0, g1; ld8(E.x0 + r * D + col0 + bj * HALF, g0, g1);
                    st8(E.o0 + r * E.ldc + col0 + bj * HALF, acc[ai][bj][m][0] * g0, acc[ai][bj][m][1] * g1);
                }
                if (m == 3) asm volatile("" ::: "memory");
            }
    } else if (E.id == E_GATEADD) {
#pragma unroll
        for (int ai = 0; ai < 2; ++ai)
#pragma unroll
            for (int m = 0; m < 4; ++m) {
                const size_t r = (size_t)(row0 + ai * HALF + m * 16);
#pragma unroll
                for (int bj = 0; bj < 2; ++bj) {
                    f32x4 g0, g1, a0, a1; ld8(E.x0 + r * D + col0 + bj * HALF, g0, g1); ld8(E.x1 + r * D + col0 + bj * HALF, a0, a1);
                    st8(E.o0 + r * E.ldc + col0 + bj * HALF, a0 + acc[ai][bj][m][0] * g0, a1 + acc[ai][bj][m][1] * g1);
                }
                if (m & 1) asm volatile("" ::: "memory");
            }
    } else if (E.id == E_RELU2) {
        bf16_t* O = (bf16_t*)(E.ws + (size_t)(1 + (u.pn >> 2)) * SLOT) + (u.pn & 3) * BM + colw;
#pragma unroll
        for (int ai = 0; ai < 2; ++ai)
#pragma unroll
            for (int m = 0; m < 4; ++m) {
                const size_t r = (size_t)(row0 + ai * HALF + m * 16);
#pragma unroll
                for (int bj = 0; bj < 2; ++bj) {
                    f32x4 v0 = acc[ai][bj][m][0], v1 = acc[ai][bj][m][1];
#pragma unroll
                    for (int j = 0; j < 4; ++j) { const float a = fmaxf(v0[j], 0.f), b = fmaxf(v1[j], 0.f); v0[j] = a * a; v1[j] = b * b; }
                    st8(O + r * D + bj * HALF, v0, v1);
                }
            }
    } else {
#pragma unroll
        for (int ai = 0; ai < 2; ++ai)
#pragma unroll
            for (int m = 0; m < 4; ++m) {
                const size_t r = (size_t)(row0 + ai * HALF + m * 16);
#pragma unroll
                for (int bj = 0; bj < 2; ++bj) st8(E.o0 + r * E.ldc + col0 + bj * HALF, acc[ai][bj][m][0], acc[ai][bj][m][1]);
            }
    }
}

__device__ __forceinline__ void gemm_phase(LAS unsigned char* lds, const Gemm g, const StaticOrder& S, const Epi& E) {
    const int tid = threadIdx.x, wid = __builtin_amdgcn_readfirstlane(tid >> 6), lane = tid & 63, wr = wid >> 2, wc = wid & 3, fr = lane & 15, fq = lane >> 4;
    const int nt = g.K / BK;
    unsigned voffA[2], voffB[2];
#pragma unroll
    for (int i = 0; i < 2; ++i) { int R, C; stage_rc(tid * 16 + i * 8192, R, C); const int Rb = (R & ~31) + perm32(R & 31);
        voffA[i] = (unsigned)(R * g.lda + C) * 2u; voffB[i] = (unsigned)(Rb * g.ldb + C) * 2u; }
    const size_t kstep = (size_t)(BK * 2);
    const size_t hstepA = (size_t)HALF * g.lda * 2, hstepB = (size_t)HALF * g.ldb * 2;
    const size_t tstepA = 2 * hstepA, tstepB = 2 * hstepB;
    const size_t pnoffA = (size_t)g.a_pn_off * 2;
    const int wsh = g.a_wrap_shift, wmask = (1 << wsh) - 1; const size_t wstride = g.a_wrap_stride;
#define PG8_AOFF(t) ((size_t)((t) >> wsh) * wstride + (size_t)((t) & wmask) * kstep)
    const unsigned ldsw = (unsigned)wid * 1024u;
    const int aoff = lds_byte(wr * 64 + fr, fq * 8), boff = lds_byte(wc * 32 + fr, fq * 8);
#define PG8_SA(b, h) (((b) * 2 + (h)) * HTB)
#define PG8_SB(b, h) ((4 + (b) * 2 + (h)) * HTB)
#define PG8_STAGE(bufoff, gbase, voff) do { _Pragma("unroll") for (int _i = 0; _i < 2; ++_i) \
        __builtin_amdgcn_global_load_lds((const unsigned*)((const char*)(gbase) + (voff)[_i]), (LAS unsigned*)(lds + (bufoff) + ldsw + _i * 8192), 16, 0, 0); } while (0)
#define PG8_LDA(dst, b, h) do { _Pragma("unroll") for (int m = 0; m < 4; ++m) _Pragma("unroll") for (int k = 0; k < 2; ++k) dst[m][k] = *(const LAS bf16x8*)(lds + PG8_SA(b, h) + aoff + m * 2048 + k * 1024); } while (0)
#define PG8_LDB(dst, b, h) do { _Pragma("unroll") for (int n = 0; n < 2; ++n) _Pragma("unroll") for (int k = 0; k < 2; ++k) dst[n][k] = *(const LAS bf16x8*)(lds + PG8_SB(b, h) + boff + n * 2048 + k * 1024); } while (0)
#define PG8_MMA(ai, bj, At, Bt) do { __builtin_amdgcn_s_setprio(1); _Pragma("unroll") for (int m = 0; m < 4; ++m) _Pragma("unroll") for (int n = 0; n < 2; ++n) _Pragma("unroll") for (int k = 0; k < 2; ++k) \
        acc[ai][bj][m][n] = __builtin_amdgcn_mfma_f32_16x16x32_bf16(Bt[n][k], At[m][k], acc[ai][bj][m][n], 0, 0, 0); __builtin_amdgcn_s_setprio(0); } while (0)
#define PG8_WAIT_V(n) asm volatile("s_waitcnt vmcnt(" #n ")" ::: "memory")
#define PG8_WAIT_L(n) asm volatile("s_waitcnt lgkmcnt(" #n ")" ::: "memory")
#define PG8_BAR __builtin_amdgcn_s_barrier()
#define PG8_SCHED __builtin_amdgcn_sched_barrier(0)
    Unit cur, nxt; int ui = 0;
    if (!S.next(0, cur)) return;
    f32x4 acc[2][2][4][2];
#pragma unroll
    for (int a = 0; a < 2; ++a)
#pragma unroll
        for (int b = 0; b < 2; ++b)
#pragma unroll
            for (int m = 0; m < 4; ++m)
#pragma unroll
                for (int n = 0; n < 2; ++n) acc[a][b][m][n] = (f32x4){0.f, 0.f, 0.f, 0.f};
    bf16x8 At[4][2], B0[2][2], B1[2][2];
    const char* cA = (const char*)g.A + (size_t)cur.pm * tstepA + (size_t)cur.pn * pnoffA; const char* cB = (const char*)g.Bt + (size_t)cur.pn * tstepB;
    PG8_STAGE(PG8_SB(0, 0), cB, voffB); PG8_STAGE(PG8_SA(0, 0), cA, voffA); PG8_STAGE(PG8_SB(0, 1), cB + hstepB, voffB); PG8_STAGE(PG8_SA(0, 1), cA + hstepA, voffA);
    if (wr == 1) PG8_BAR;
    PG8_WAIT_V(4); PG8_BAR;
    PG8_STAGE(PG8_SB(1, 0), cB + kstep, voffB); PG8_STAGE(PG8_SA(1, 0), cA + kstep, voffA); PG8_STAGE(PG8_SB(1, 1), cB + hstepB + kstep, voffB);
    PG8_WAIT_V(6); PG8_BAR;
    for (;;) {
        const bool has_next = S.next(ui + 1, nxt);
        const char* nA = has_next ? (const char*)g.A + (size_t)nxt.pm * tstepA + (size_t)nxt.pn * pnoffA : cA; const char* nB = has_next ? (const char*)g.Bt + (size_t)nxt.pn * tstepB : cB;
        for (int t = 0; t < nt; t += 2) {
            const bool last = (t == nt - 2);
            const char* a1 = cA + PG8_AOFF(t + 1);
            const char* a2 = last ? nA : cA + PG8_AOFF(t + 2); const char* b2 = last ? nB : cB + (size_t)(t + 2) * kstep;
            const char* a3 = last ? nA + kstep : cA + PG8_AOFF(t + 3); const char* b3 = b2 + kstep;
            PG8_LDB(B0, 0, 0); PG8_SCHED; PG8_LDA(At, 0, 0); PG8_STAGE(PG8_SA(1, 1), a1 + hstepA, voffA);
            PG8_WAIT_L(8); PG8_BAR; PG8_WAIT_L(0); PG8_MMA(0, 0, At, B0); PG8_BAR; PG8_SCHED;
            PG8_LDB(B1, 0, 1); PG8_STAGE(PG8_SB(0, 0), b2, voffB);
            PG8_BAR; PG8_WAIT_L(0); PG8_MMA(0, 1, At, B1); PG8_BAR;
            PG8_LDA(At, 0, 1); PG8_STAGE(PG8_SA(0, 0), a2, voffA);
            PG8_BAR; PG8_WAIT_L(0); PG8_MMA(1, 0, At, B0); PG8_BAR; PG8_SCHED;
            PG8_STAGE(PG8_SB(0, 1), b2 + hstepB, voffB);
            PG8_WAIT_V(6); PG8_BAR; PG8_MMA(1, 1, At, B1); PG8_BAR;
            PG8_LDB(B0, 1, 0); PG8_SCHED; PG8_LDA(At, 1, 0); PG8_STAGE(PG8_SA(0, 1), a2 + hstepA, voffA);
            PG8_WAIT_L(8); PG8_BAR; PG8_WAIT_L(0); PG8_MMA(0, 0, At, B0); PG8_BAR; PG8_SCHED;
            PG8_LDB(B1, 1, 1); PG8_STAGE(PG8_SB(1, 0), b3, voffB);
            PG8_BAR; PG8_WAIT_L(0); PG8_MMA(0, 1, At, B1); PG8_BAR;
            PG8_LDA(At, 1, 1); PG8_STAGE(PG8_SA(1, 0), a3, voffA);
            PG8_BAR; PG8_WAIT_L(0); PG8_MMA(1, 0, At, B0); PG8_BAR; PG8_SCHED;
            PG8_STAGE(PG8_SB(1, 1), b3 + hstepB, voffB);
            PG8_WAIT_V(6); PG8_BAR; PG8_MMA(1, 1, At, B1); PG8_BAR;
        }
        epilogue(E, acc, cur);
        if (!has_next) break;
#pragma unroll
        for (int a = 0; a < 2; ++a)
#pragma unroll
            for (int b = 0; b < 2; ++b)
#pragma unroll
                for (int m = 0; m < 4; ++m)
#pragma unroll
                    for (int n = 0; n < 2; ++n) acc[a][b][m][n] = (f32x4){0.f, 0.f, 0.f, 0.f};
        cur = nxt; cA = nA; cB = nB; ++ui;
    }
    PG8_WAIT_V(0);
    if (wr == 0) PG8_BAR;
    PG8_BAR;
#undef PG8_AOFF
#undef PG8_SA
#undef PG8_SB
#undef PG8_STAGE
#undef PG8_LDA
#undef PG8_LDB
#undef PG8_MMA
#undef PG8_WAIT_V
#undef PG8_WAIT_L
#undef PG8_BAR
#undef PG8_SCHED
}

__device__ __forceinline__ int win_dst_row(int n0) {
    if (n0 < D || n0 >= 3 * D) return n0;
    const int isv = n0 >= 2 * D, ch = n0 - (isv ? 2 * D : D);
    return D + (ch >> 7) * 256 + isv * 128 + (ch & 127);
}
__device__ __forceinline__ void transpose_item(const float* W, int K, int N, bf16_t* WT, int wperm, LAS float* scr, int item, int lane) {
    const int nblk = N / 32, kb = item / nblk, nb = item % nblk, k0 = 64 * kb, n0 = 32 * nb;
#pragma unroll 8
    for (int i = 0; i < 32; ++i) { const int kk = 2 * i + (lane >> 5); scr[kk * 33 + (lane & 31)] = W[(size_t)(k0 + kk) * N + n0 + (lane & 31)]; }
    LDS_WAIT(); asm volatile("" ::: "memory");
    const int c = lane & 7;
    const int drow0 = wperm ? win_dst_row(n0) : n0;
#pragma unroll
    for (int j = 0; j < 4; ++j) { const int n = (lane >> 3) + 8 * j; const LAS float* s = scr + (8 * c) * 33 + n;
        u32x4 o; o.x = cvt_pk_bf16(s[0 * 33], s[1 * 33]); o.y = cvt_pk_bf16(s[2 * 33], s[3 * 33]); o.z = cvt_pk_bf16(s[4 * 33], s[5 * 33]); o.w = cvt_pk_bf16(s[6 * 33], s[7 * 33]);
        st16_wt(WT + (size_t)(drow0 + n) * K + k0 + 8 * c, o); }
    LDS_WAIT(); asm volatile("" ::: "memory");
}
__device__ __forceinline__ void transpose_matrix(const float* W, int K, int N, bf16_t* WT, int wperm, LAS float* scr, int gw, int NGW, int lane, int& off) {
    const int nitems = (K / 64) * (N / 32);
    int start = gw - (off % NGW); if (start < 0) start += NGW;
    for (int it = start; it < nitems; it += NGW) transpose_item(W, K, N, WT, wperm, scr, it, lane);
    off += nitems;
}

enum { SE_F32 = 0, SE_SCALE = 1, SE_GATE = 2, SE_GATEADD = 3, SE_RELU2 = 4 };
struct SkGemm { int emode, lda, ldb, ldc, nCB, K, cbPerGrp, grpK, nKS; const bf16_t* A; const bf16_t* Bt; void* C; const float* projs; const float* vec; float* m1; };
__device__ __forceinline__ void skinny_gemm(LAS unsigned char* lds, const SkGemm& g, int task0, int tstride) {
    int tl = threadIdx.x; asm volatile("" : "+v"(tl));
    const int lane = tl & 63, wid = tl >> 6, fr = lane & 15, fq = lane >> 4;
    const int kw = g.K >> 3, nks = kw >> 5;
    for (int t = task0; t < g.nCB * g.nKS; t += tstride) {
        const int cb = t % g.nCB, ksl = t / g.nCB;
        const int kB = ksl * g.K + wid * kw, kA = kB + (cb / g.cbPerGrp) * g.grpK;
        f32x4 acc[8][2];
#pragma unroll
        for (int rb = 0; rb < 8; ++rb) { acc[rb][0] = (f32x4){0.f, 0.f, 0.f, 0.f}; acc[rb][1] = acc[rb][0]; }
        const bf16_t* bp = g.Bt + (size_t)(cb * 32 + fr) * g.ldb + kB + fq * 8;
        const bf16_t* ap = g.A + (size_t)fr * g.lda + kA + fq * 8;
        for (int ks = 0; ks < nks; ks += 2) {
            const bool two = ks + 1 < nks;
            bf16x8 a0[8], a1[8], b00, b01, b10, b11;
            b00 = *(const bf16x8*)(bp + ks * 32); b01 = *(const bf16x8*)(bp + (size_t)16 * g.ldb + ks * 32);
#pragma unroll
            for (int rb = 0; rb < 8; ++rb) a0[rb] = *(const bf16x8*)(ap + (size_t)rb * 16 * g.lda + ks * 32);
            if (two) {
                b10 = *(const bf16x8*)(bp + ks * 32 + 32); b11 = *(const bf16x8*)(bp + (size_t)16 * g.ldb + ks * 32 + 32);
#pragma unroll
                for (int rb = 0; rb < 8; ++rb) a1[rb] = *(const bf16x8*)(ap + (size_t)rb * 16 * g.lda + ks * 32 + 32);
            }
#pragma unroll
            for (int rb = 0; rb < 8; ++rb) {
                acc[rb][0] = __builtin_amdgcn_mfma_f32_16x16x32_bf16(b00, a0[rb], acc[rb][0], 0, 0, 0);
                acc[rb][1] = __builtin_amdgcn_mfma_f32_16x16x32_bf16(b01, a0[rb], acc[rb][1], 0, 0, 0);
            }
            if (two) {
#pragma unroll
                for (int rb = 0; rb < 8; ++rb) {
                    acc[rb][0] = __builtin_amdgcn_mfma_f32_16x16x32_bf16(b10, a1[rb], acc[rb][0], 0, 0, 0);
                    acc[rb][1] = __builtin_amdgcn_mfma_f32_16x16x32_bf16(b11, a1[rb], acc[rb][1], 0, 0, 0);
                }
            }
        }
#pragma unroll
        for (int rb = 0; rb < 8; ++rb)
#pragma unroll
            for (int c2 = 0; c2 < 2; ++c2) *(LAS f32x4*)(lds + wid * 16384 + ((rb * 2 + c2) * 64 + lane) * 16) = acc[rb][c2];
        __syncthreads();
#pragma unroll
        for (int h = 0; h < 2; ++h) {
            const int q = tl + h * 512, i = q >> 6, ls = q & 63;
            f32x4 v = *(const LAS f32x4*)(lds + q * 16);
#pragma unroll
            for (int w = 1; w < 8; ++w) v += *(const LAS f32x4*)(lds + w * 16384 + q * 16);
            const int row = (i >> 1) * 16 + (ls & 15), col = cb * 32 + (i & 1) * 16 + 4 * (ls >> 4);
            if (g.emode == SE_F32) st16_wt((float*)g.C + (size_t)ksl * 128 * g.ldc + (size_t)row * g.ldc + col, __builtin_bit_cast(u32x4, v));
            else if (g.emode == SE_GATE || g.emode == SE_GATEADD) {
                const int go = g.emode == SE_GATE ? 0 : D;
                f32x4 gt = *(const f32x4*)(g.projs + (size_t)row * DIN + 4 * D + go + col) + *(const f32x4*)(g.vec + go + col);
#pragma unroll
                for (int j = 0; j < 4; ++j) gt[j] = sigmoidf_(gt[j]);
                if (g.emode == SE_GATE) st16_wt(g.m1 + (size_t)row * D + col, __builtin_bit_cast(u32x4, gt * v));
                else { const f32x4 o = *(const f32x4*)(g.m1 + (size_t)row * D + col) + gt * v;
                    u32x2 w2; w2.x = cvt_pk_bf16(o[0], o[1]); w2.y = cvt_pk_bf16(o[2], o[3]); st8_wt((bf16_t*)g.C + (size_t)row * g.ldc + col, w2); }
            } else {
                f32x4 o;
                if (g.emode == SE_SCALE) o = v * *(const f32x4*)(g.vec + col);
                else {
#pragma unroll
                    for (int j = 0; j < 4; ++j) { const float u = fmaxf(v[j], 0.f); o[j] = u * u; }
                }
                u32x2 w2; w2.x = cvt_pk_bf16(o[0], o[1]); w2.y = cvt_pk_bf16(o[2], o[3]); st8_wt((bf16_t*)g.C + (size_t)row * g.ldc + col, w2);
            }
        }
        __syncthreads();
    }
}

#define SPIN_UNTIL(cond, tmo) do { unsigned _sp = 0; while (!(cond)) { __builtin_amdgcn_s_sleep(1); if (++_sp > (1u << 21)) { atomicAdd((tmo), 1u); break; } } } while (0)
__device__ __forceinline__ int sample_blocks(int ph) { return ph == 0 ? 192 : ph == 1 ? 256 : ph <= 4 ? 32 : 128; }
__device__ __forceinline__ void step_sync(unsigned char* ctl, int pm, int k) {
    asm volatile("s_waitcnt vmcnt(0)" ::: "memory");
    __syncthreads();
    if (threadIdx.x == 0) {
        unsigned* tcnt = (unsigned*)(ctl + CTL_TCNT); unsigned* gcnt = (unsigned*)(ctl + CTL_GCNT); unsigned* scnt = (unsigned*)(ctl + CTL_SCNT); unsigned* tmo = (unsigned*)(ctl) + XB_TMO;
        const int b = (int)blockIdx.x, ph = k % 10, nph = (k + 1) % 10;
        if (b < sample_blocks(ph)) (void)xb_add(scnt + 64 * k, 1u);
        if (k == 0) (void)xb_add(gcnt, 1u);
        if (k == 9) (void)xb_add(gcnt + 64, 1u);
        (void)xb_add(tcnt + 64 * pm, 1u);
        const unsigned target = 4u * (unsigned)(k + 1);
        SPIN_UNTIL(xb_ld(tcnt + 64 * pm) >= target, tmo);
        if (nph == 1 && pm > 0) SPIN_UNTIL(xb_ld(tcnt + 64 * (pm - 1)) >= target, tmo);
        if (nph == 2 && pm < 63) SPIN_UNTIL(xb_ld(tcnt + 64 * (pm + 1)) >= target, tmo);
        if (b < sample_blocks(nph)) SPIN_UNTIL(xb_ld(scnt + 64 * k) >= (unsigned)sample_blocks(ph), tmo);
        if (k + 1 == 9) SPIN_UNTIL(xb_ld(gcnt) >= 256u, tmo);
        if (k + 1 == 10) SPIN_UNTIL(xb_ld(gcnt + 64) >= 256u, tmo);
        __builtin_amdgcn_fence(__ATOMIC_ACQUIRE, "agent");
        asm volatile("s_waitcnt vmcnt(0)" ::: "memory");
    }
    __syncthreads();
}

__global__ void __launch_bounds__(512, 2) fwd_megakernel(Params p) {
    extern __shared__ __attribute__((aligned(16))) unsigned char shm[];
    LAS unsigned char* lds = (LAS unsigned char*)shm;
    cg::grid_group grid = cg::this_grid();
    const int tid = threadIdx.x;
    const int G = (int)gridDim.x, NGW = G * 8;
    unsigned char* ws = p.ws;
    bf16_t* S0 = (bf16_t*)(ws + 0 * SLOT); bf16_t* S1 = (bf16_t*)(ws + 1 * SLOT); bf16_t* S2 = (bf16_t*)(ws + 2 * SLOT);
    bf16_t* S3 = (bf16_t*)(ws + 3 * SLOT); bf16_t* S5 = (bf16_t*)(ws + 5 * SLOT);
    bf16_t* WIN = (bf16_t*)(ws + WS_WIN);
    unsigned char* sm = ws + WS_SM;
    float* PROJS = (float*)(sm + SM_PROJ); float* M1S = (float*)(sm + SM_M1);
    bf16_t* HS = (bf16_t*)(sm + SM_HS); bf16_t* YAS = (bf16_t*)(sm + SM_YAS); bf16_t* DDS = (bf16_t*)(sm + SM_DDS);
    bf16_t* YBS = (bf16_t*)(sm + SM_YBS); bf16_t* MRGS = (bf16_t*)(sm + SM_MRG); bf16_t* US = (bf16_t*)(sm + SM_US);
    float* X = p.out + O_Y;

    const int bc = (int)blockIdx.x, pm_t = 8 * (bc & 7) + ((bc >> 3) & 7), mem_t = bc >> 6;
    if (G != 256) return;
    {
        const int lane = tid & 63, wid = tid >> 6, gw = (int)blockIdx.x * 8 + wid;
        LAS float* scr = (LAS float*)(lds + wid * 16384);
        int off = 0;
        transpose_matrix(p.in[4], D, DIN, WIN, 1, scr, gw, NGW, lane, off);
        for (int l = 0; l < NL; ++l) {
            unsigned char* wl = ws + WS_WL + (size_t)l * WL_BYTES;
            transpose_matrix(p.in[7] + (size_t)l * D * D, D, D, (bf16_t*)(wl + WL_WC), 0, scr, gw, NGW, lane, off);
            transpose_matrix(p.in[10] + (size_t)l * D * D, D, D, (bf16_t*)(wl + WL_WP), 0, scr, gw, NGW, lane, off);
            transpose_matrix(p.in[11] + (size_t)l * D * D, D, D, (bf16_t*)(wl + WL_WO), 0, scr, gw, NGW, lane, off);
            for (int gi = 0; gi < 4; ++gi)
                transpose_matrix(p.in[8] + (size_t)l * 4 * 65536 + (size_t)gi * 65536, 256, 256, (bf16_t*)(wl + WL_POOL) + (size_t)gi * 65536, 0, scr, gw, NGW, lane, off);
            transpose_matrix(p.in[14] + (size_t)l * D * DFF, D, DFF, (bf16_t*)(wl + WL_UP), 0, scr, gw, NGW, lane, off);
            transpose_matrix(p.in[15] + (size_t)l * DFF * D, DFF, D, (bf16_t*)(wl + WL_DOWN), 0, scr, gw, NGW, lane, off);
        }
        const float* gpre = p.in[12];
        f32x4 gv[4];
#pragma unroll
        for (int j = 0; j < 4; ++j) gv[j] = *(const f32x4*)(gpre + lane * 4 + 256 * j);
        for (int r = gw; r < MTOT; r += NGW) {
            const float* xr = r < MP ? p.in[0] + (size_t)r * D : p.in[1] + (size_t)(r - MP) * D;
            bf16_t* hr = r < MP ? S0 + (size_t)r * D : HS + (size_t)(r - MP) * D;
            f32x4 v[4]; float s = 0.f;
#pragma unroll
            for (int j = 0; j < 4; ++j) { v[j] = *(const f32x4*)(xr + lane * 4 + 256 * j); s += (v[j][0] * v[j][0] + v[j][1] * v[j][1]) + (v[j][2] * v[j][2] + v[j][3] * v[j][3]); }
            const float rs = rsqrtf(wave_sum(s) * (1.f / D) + EPS);
#pragma unroll
            for (int j = 0; j < 4; ++j) { u32x2 o; o.x = cvt_pk_bf16(v[j][0] * rs * gv[j][0], v[j][1] * rs * gv[j][1]); o.y = cvt_pk_bf16(v[j][2] * rs * gv[j][2], v[j][3] * rs * gv[j][3]);
                *(u32x2*)(hr + lane * 4 + 256 * j) = o; }
        }
    }
    grid.sync();

    for (int step = 0; step < p.nsteps; ++step) {
        const int l = step / 10, ph = step - l * 10;
        int tid_s = threadIdx.x; asm volatile("" : "+v"(tid_s));
        const int lane = tid_s & 63, wid = tid_s >> 6, gw = (int)blockIdx.x * 8 + wid;
        unsigned char* wl = ws + WS_WL + (size_t)l * WL_BYTES;
        const float* bgate = p.in[5] + (size_t)l * 2 * D;
        Gemm g{S0, WIN, D, D, D, MP / BM, D / BM, 0, 30, 0};
        Epi E{E_PLAIN, D, S1, nullptr, nullptr, nullptr, ws};
        SkGemm sk{SE_F32, D, D, D, D / 32, D, 1 << 20, 0, 1, HS, WIN, PROJS, PROJS, bgate, M1S};
        bool is_gemm = true;
        switch (ph) {
        case 0:
            g.nN = DIN / BM; E.id = E_PROJ; E.vec = bgate;
            sk.ldc = DIN; sk.nCB = DIN / 32; sk.C = PROJS; break;
        case 2:
            g.Bt = (const bf16_t*)(wl + WL_POOL); g.ldb = 256; g.K = 256; g.nN = 4; g.a_pn_off = 256;
            E.id = E_SCALE; E.o0 = S2; E.vec = p.in[9] + (size_t)l * D;
            sk.emode = SE_SCALE; sk.A = DDS; sk.Bt = g.Bt; sk.ldb = 256; sk.K = 256; sk.cbPerGrp = 8; sk.grpK = 256; sk.C = YBS; sk.vec = E.vec; break;
        case 3:
            g.A = S1; g.Bt = (const bf16_t*)(wl + WL_WC); E.id = E_GATE; E.o0 = S3; E.x0 = (const bf16_t*)(ws + 4 * SLOT);
            sk.emode = SE_GATE; sk.A = YAS; sk.Bt = g.Bt; break;
        case 4:
            g.A = S2; g.Bt = (const bf16_t*)(wl + WL_WP); E.id = E_GATEADD; E.o0 = S0; E.x0 = S5; E.x1 = S3;
            sk.emode = SE_GATEADD; sk.A = YBS; sk.Bt = g.Bt; sk.C = MRGS; break;
        case 5:
            g.Bt = (const bf16_t*)(wl + WL_WO); E.o0 = S5;
            sk.A = MRGS; sk.Bt = g.Bt; sk.K = 256; sk.nKS = 4; break;
        case 7:
            g.Bt = (const bf16_t*)(wl + WL_UP); g.nN = DFF / BM; E.id = E_RELU2; E.ldc = DFF;
            sk.emode = SE_RELU2; sk.Bt = g.Bt; sk.ldc = DFF; sk.nCB = DFF / 32; sk.C = US; break;
        case 8:
            g.A = S1; g.Bt = (const bf16_t*)(wl + WL_DOWN); g.ldb = DFF; g.K = DFF; g.a_wrap_shift = 4; g.a_wrap_stride = SLOT; E.o0 = S5;
            sk.A = US; sk.lda = DFF; sk.Bt = g.Bt; sk.ldb = DFF; sk.K = D; sk.nKS = 4; break;
        default: is_gemm = false; break;
        }
        if (is_gemm) {
            skinny_gemm(lds, sk, (int)blockIdx.x, G);
            StaticOrder S; S.init(g.nM, g.nN, G, (int)blockIdx.x);
            gemm_phase(lds, g, S, E);
        } else if (ph == 1) {
            const float* cw = p.in[6] + (size_t)l * 3 * D;
            const float* cconv = p.in[2] + (size_t)l * NB_S * 2 * D;
            const float* cpool = p.in[3] + (size_t)l * NB_S * 15 * D;
            float* o_csp = p.out + O_CSP + (size_t)l * 2 * D;
            float* o_psp = p.out + O_PSP + (size_t)l * 15 * D;
            float* o_css = p.out + O_CSS + (size_t)l * NB_S * 2 * D;
            float* o_pss = p.out + O_PSS + (size_t)l * NB_S * 15 * D;
            const f32x4 zero4 = (f32x4){0.f, 0.f, 0.f, 0.f};
            {
                const int hi = wid * 2 + (lane >> 5);
                const int gi = hi & 3, r0 = pm_t * 256 + (mem_t * 4 + (hi >> 2)) * 16, ch = gi * 256 + (lane & 31) * 8, w = 2 << gi;
                const bool head = (r0 == 0);
                const float ic = 1.0f / (float)w;
                const f32x4 w0a = *(const f32x4*)(cw + ch), w0b = *(const f32x4*)(cw + ch + 4);
                const f32x4 w1a = *(const f32x4*)(cw + D + ch), w1b = *(const f32x4*)(cw + D + ch + 4);
                const f32x4 w2a = *(const f32x4*)(cw + 2 * D + ch), w2b = *(const f32x4*)(cw + 2 * D + ch + 4);
                f32x4 z1a = zero4, z1b = zero4, z2a = zero4, z2b = zero4, sa = zero4, sb2 = zero4;
                if (!head) {
                    ld8(S2 + (size_t)(r0 - 1) * D + ch, z1a, z1b);
                    ld8(S2 + (size_t)(r0 - 2) * D + ch, z2a, z2b);
                    for (int i = 1; i < w; ++i) { f32x4 qa, qb; ld8(S3 + (size_t)(r0 - i) * D + ch, qa, qb); sa += qa; sb2 += qb; }
                }
#pragma unroll 4
                for (int k = 0; k < 16; ++k) {
                    const size_t ro = (size_t)(r0 + k) * D + ch;
                    const int t = r0 + k;
                    f32x4 b0, b1, z0a, z0b, p0a, p0b, oa = zero4, ob = zero4;
                    ld8(S1 + ro, b0, b1);
                    ld8(S2 + ro, z0a, z0b);
                    ld8(S3 + ro, p0a, p0b);
                    if (!head || t - (w - 1) >= 0) ld8(S3 + ro - (size_t)(w - 1) * D, oa, ob);
                    const float ict = head ? 1.0f / (float)(t + 1 < w ? t + 1 : w) : ic;
                    sa += p0a; sb2 += p0b;
                    st8(S1 + ro, b0 * (w0a * z2a + w1a * z1a + w2a * z0a), b1 * (w0b * z2b + w1b * z1b + w2b * z0b));
                    st8(S0 + ro, sa * ict - p0a, sb2 * ict - p0b);
                    sa -= oa; sb2 -= ob;
                    z2a = z1a; z2b = z1b; z1a = z0a; z1b = z0b;
                    if (t >= MP - 2) { float* o = o_csp + (size_t)(t - (MP - 2)) * D + ch; *(f32x4*)o = z0a; *(f32x4*)(o + 4) = z0b; }
                    if (t >= MP - 15) { float* o = o_psp + (size_t)(t - (MP - 15)) * D + ch; *(f32x4*)o = p0a; *(f32x4*)(o + 4) = p0b; }
                }
            }
            if (wid == 0) {
                const int it = bc, gi = it & 3, ch = gi * 256 + (lane & 31) * 8, w = 2 << gi;
                const f32x4 w0a = *(const f32x4*)(cw + ch), w0b = *(const f32x4*)(cw + ch + 4);
                const f32x4 w1a = *(const f32x4*)(cw + D + ch), w1b = *(const f32x4*)(cw + D + ch + 4);
                const f32x4 w2a = *(const f32x4*)(cw + 2 * D + ch), w2b = *(const f32x4*)(cw + 2 * D + ch + 4);
                const int rs = (it >> 2) * 2 + (lane >> 5), sb = rs >> 4, t = rs & 15;
                const int cc = D + (ch >> 7) * 256 + (ch & 127);
                const float* pr = PROJS + (size_t)rs * DIN;
                const f32x4 b0 = *(const f32x4*)(pr + ch), b1 = *(const f32x4*)(pr + ch + 4);
                const f32x4 z0a = *(const f32x4*)(pr + cc) * *(const f32x4*)(pr + cc + 128), z0b = *(const f32x4*)(pr + cc + 4) * *(const f32x4*)(pr + cc + 132);
                const f32x4 p0a = *(const f32x4*)(pr + 3 * D + ch), p0b = *(const f32x4*)(pr + 3 * D + ch + 4);
                f32x4 z1a, z1b, z2a, z2b;
                if (t >= 1) { const float* q = pr - DIN; z1a = *(const f32x4*)(q + cc) * *(const f32x4*)(q + cc + 128); z1b = *(const f32x4*)(q + cc + 4) * *(const f32x4*)(q + cc + 132); }
                else { const float* q = cconv + ((size_t)sb * 2 + 1) * D + ch; z1a = *(const f32x4*)q; z1b = *(const f32x4*)(q + 4); }
                if (t >= 2) { const float* q = pr - 2 * DIN; z2a = *(const f32x4*)(q + cc) * *(const f32x4*)(q + cc + 128); z2b = *(const f32x4*)(q + cc + 4) * *(const f32x4*)(q + cc + 132); }
                else { const float* q = cconv + ((size_t)sb * 2 + t) * D + ch; z2a = *(const f32x4*)q; z2b = *(const f32x4*)(q + 4); }
                f32x4 sa = p0a, sb2 = p0b;
                for (int i = 1; i < w; ++i) {
                    const float* q = (t - i >= 0) ? pr - (size_t)i * DIN + 3 * D + ch : cpool + ((size_t)sb * 15 + (15 + t - i)) * D + ch;
                    sa += *(const f32x4*)q; sb2 += *(const f32x4*)(q + 4);
                }
                const float ic = 1.0f / (float)w;
                st8(YAS + (size_t)rs * D + ch, b0 * (w0a * z2a + w1a * z1a + w2a * z0a), b1 * (w0b * z2b + w1b * z1b + w2b * z0b));
                st8(DDS + (size_t)rs * D + ch, sa * ic - p0a, sb2 * ic - p0b);
                if (t >= SEQ_S - 2) { float* o = o_css + ((size_t)sb * 2 + (t - (SEQ_S - 2))) * D + ch; *(f32x4*)o = z0a; *(f32x4*)(o + 4) = z0b; }
                if (t >= 1) { float* o = o_pss + ((size_t)sb * 15 + (t - 1)) * D + ch; *(f32x4*)o = p0a; *(f32x4*)(o + 4) = p0b; }
            }
        } else {
            const int half = ph == 6 ? 0 : 1;
            const bf16_t* Y = S5;
            const float* gpost = (half == 0 ? p.in[13] : p.in[17]) + (size_t)l * D;
            const float* gnext = half == 0 ? p.in[16] + (size_t)l * D : p.in[12] + (size_t)(l + 1 < NL ? l + 1 : l) * D;
            const bool from_input = (l == 0 && half == 0);
            f32x4 gp[4], gn[4];
#pragma unroll
            for (int j = 0; j < 4; ++j) { gp[j] = *(const f32x4*)(gpost + lane * 4 + 256 * j); gn[j] = *(const f32x4*)(gnext + lane * 4 + 256 * j); }
            const int nrow = 8 + ((wid == 0 && bc < MS) ? 1 : 0);
            for (int i = 0; i < nrow; ++i) {
                const int r = i < 8 ? pm_t * 256 + mem_t * 64 + wid * 8 + i : MP + bc;
                const float* xr = from_input ? (r < MP ? p.in[0] + (size_t)r * D : p.in[1] + (size_t)(r - MP) * D) : X + (size_t)r * D;
                bf16_t* hr = r < MP ? S0 + (size_t)r * D : HS + (size_t)(r - MP) * D;
                f32x4 xv[4], yv[4]; float s = 0.f;
#pragma unroll
                for (int j = 0; j < 4; ++j) {
                    xv[j] = *(const f32x4*)(xr + lane * 4 + 256 * j);
                    if (r < MP) {
                        const u32x2 wv = *(const u32x2*)(Y + (size_t)r * D + lane * 4 + 256 * j);
                        yv[j][0] = bf_lo(wv.x); yv[j][1] = bf_hi(wv.x); yv[j][2] = bf_lo(wv.y); yv[j][3] = bf_hi(wv.y);
                    } else { const float* q = PROJS + (size_t)(r - MP) * D + lane * 4 + 256 * j;
                        yv[j] = (*(const f32x4*)q + *(const f32x4*)(q + MS * D)) + (*(const f32x4*)(q + 2 * MS * D) + *(const f32x4*)(q + 3 * MS * D)); }
                    s += (yv[j][0] * yv[j][0] + yv[j][1] * yv[j][1]) + (yv[j][2] * yv[j][2] + yv[j][3] * yv[j][3]);
                }
                const float rs = rsqrtf(wave_sum(s) * (1.f / D) + EPS);
                float s2 = 0.f;
#pragma unroll
                for (int j = 0; j < 4; ++j) { xv[j] = xv[j] + yv[j] * rs * gp[j]; s2 += (xv[j][0] * xv[j][0] + xv[j][1] * xv[j][1]) + (xv[j][2] * xv[j][2] + xv[j][3] * xv[j][3]);
                    st16_wt(X + (size_t)r * D + lane * 4 + 256 * j, __builtin_bit_cast(u32x4, xv[j])); }
                const float rs2 = rsqrtf(wave_sum(s2) * (1.f / D) + EPS);
#pragma unroll
                for (int j = 0; j < 4; ++j) { u32x2 o; o.x = cvt_pk_bf16(xv[j][0] * rs2 * gn[j][0], xv[j][1] * rs2 * gn[j][1]); o.y = cvt_pk_bf16(xv[j][2] * rs2 * gn[j][2], xv[j][3] * rs2 * gn[j][3]);
                    st8_wt(hr + lane * 4 + 256 * j, o); }
            }
            if (half == 1 && l + 1 < NL) {
                LAS float* scr = (LAS float*)(lds + wid * 16384);
                int off = 0;
                transpose_matrix(p.in[4] + (size_t)(l + 1) * D * DIN, D, DIN, WIN, 1, scr, gw, NGW, lane, off);
            }
        }
        if (step + 1 < p.nsteps) step_sync(ws + WS_BAR, pm_t, step);
    }
}

extern "C" void kernel_launch(void* const* d_in, const int* in_sizes, int n_in, void* d_out, int out_size, void* d_ws, size_t ws_size, hipStream_t stream) {
    static int grid = 0;
    if (grid == 0) {
        if (n_in != 18 || ws_size < WS_END) { fprintf(stderr, "kernel_launch: unexpected n_in %d or ws_size %zu (< %zu)\n", n_in, ws_size, (size_t)WS_END); grid = -1; return; }
        int dev = 0, cus = 0, per_cu = 0;
        hipGetDevice(&dev);
        hipDeviceGetAttribute(&cus, hipDeviceAttributeMultiprocessorCount, dev);
        if (hipFuncSetAttribute((const void*)fwd_megakernel, hipFuncAttributeMaxDynamicSharedMemorySize, LDS_BYTES) != hipSuccess) { fprintf(stderr, "kernel_launch: hipFuncSetAttribute failed\n"); grid = -1; return; }
        if (hipOccupancyMaxActiveBlocksPerMultiprocessor(&per_cu, (const void*)fwd_megakernel, 512, LDS_BYTES) != hipSuccess || per_cu < 1) { fprintf(stderr, "kernel_launch: occupancy query failed (%d)\n", per_cu); grid = -1; return; }
        grid = cus * per_cu;
    }
    if (grid < 0) return;
    (void)hipMemsetAsync((unsigned char*)d_ws + WS_BAR, 0, CTL_BYTES, stream);
    Params p{};
    for (int i = 0; i < 18; ++i) p.in[i] = (const float*)d_in[i];
    p.out = (float*)d_out; p.ws = (unsigned char*)d_ws; p.nsteps = NL * 10; p.pad = PROBE;
    void* args[] = {&p};
    hipError_t e = hipLaunchCooperativeKernel((const void*)fwd_megakernel, dim3(grid), dim3(512), args, LDS_BYTES, stream);
    if (e != hipSuccess) fprintf(stderr, "cooperative launch failed: %s (grid %d)\n", hipGetErrorString(e), grid);
}
```

```cpp
#include <hip/hip_runtime.h>
#include <hip/hip_cooperative_groups.h>
#include <cstdio>
namespace cg = cooperative_groups;

#ifndef SKELETON
#define SKELETON 0
#endif
#ifndef STOP_AFTER
#define STOP_AFTER 99
#endif
#ifndef PROBE
#define PROBE 0
#ifndef STAGGER_TICKS
#define STAGGER_TICKS 350
#endif
#endif
#ifndef SKEW_TICKS
#define SKEW_TICKS 0
#endif
#ifndef USE_CG_ONLY
#define USE_CG_ONLY 0
#endif

#define LAS __attribute__((address_space(3)))
typedef unsigned short bf16_t;
typedef short bf16x8 __attribute__((ext_vector_type(8)));
typedef float f32x4 __attribute__((ext_vector_type(4)));
typedef unsigned u32x4 __attribute__((ext_vector_type(4)));
typedef unsigned u32x2 __attribute__((ext_vector_type(2)));

constexpr int D = 1024, DIN = 6144, DFF = 4096, NL = 2;
constexpr int MP = 16384, MS = 128, MTOT = MP + MS, MPAD = MP;
constexpr int SEQ_S = 16, NB_S = 8, PAST = 2048;
constexpr int BM = 256, BK = 64, HALF = 128, HTB = HALF * BK * 2, STAGE_BYTES = 8 * HTB, NXCD = 8, WGM = 8;
constexpr int LDS_BYTES = STAGE_BYTES + 64;
constexpr float EPS = 1e-6f;

constexpr size_t SLOT = (size_t)MPAD * 1024 * 2;
constexpr size_t WS_WIN = 6 * SLOT;
constexpr size_t WIN_BYTES = (size_t)DIN * D * 2;
constexpr size_t WL_WC = 0, WL_WP = 2097152, WL_WO = 4194304, WL_POOL = 6291456, WL_UP = 6815744, WL_DOWN = 15204352, WL_BYTES = 23592960;
constexpr size_t WS_WL = WS_WIN + WIN_BYTES;
constexpr size_t WS_BAR = WS_WL + NL * WL_BYTES;
constexpr size_t CTL_BYTES = 49152, CTL_TCNT = 16384, CTL_GCNT = 32768, CTL_SCNT = 36864, CTL_XCNT = 45056;
constexpr size_t WS_SM = WS_BAR + CTL_BYTES;
constexpr size_t SM_PROJ = 0, SM_M1 = 3145728, SM_HS = 3670016, SM_YAS = 3932160, SM_DDS = 4194304, SM_YBS = 4456448, SM_MRG = 4718592, SM_US = 4980736, SM_BYTES = 6029312;
constexpr size_t WS_END = WS_SM + SM_BYTES;

constexpr size_t O_Y = 0, O_CSP = (size_t)MTOT * D, O_PSP = O_CSP + NL * 2 * D, O_CSS = O_PSP + NL * 15 * D, O_PSS = O_CSS + (size_t)NL * NB_S * 2 * D;

struct Params {
    const float* in[18];
    float* out;
    unsigned char* ws;
    int nsteps, pad;
};

__device__ __forceinline__ unsigned cvt_pk_bf16(float lo, float hi) { unsigned r; asm volatile("v_cvt_pk_bf16_f32 %0, %1, %2" : "=v"(r) : "v"(lo), "v"(hi)); return r; }
__device__ __forceinline__ float bf_lo(unsigned w) { return __uint_as_float(w << 16); }
__device__ __forceinline__ float bf_hi(unsigned w) { return __uint_as_float(w & 0xffff0000u); }
__device__ __forceinline__ void st16_wt(void* p, u32x4 w) { asm volatile("global_store_dwordx4 %0, %1, off sc1\n\ts_nop 1" :: "v"(p), "v"(w) : "memory"); }
__device__ __forceinline__ void st8_wt(void* p, u32x2 w) { asm volatile("global_store_dwordx2 %0, %1, off sc1\n\ts_nop 1" :: "v"(p), "v"(w) : "memory"); }
__device__ __forceinline__ void st8(bf16_t* p, f32x4 a, f32x4 b) {
    u32x4 w; w.x = cvt_pk_bf16(a[0], a[1]); w.y = cvt_pk_bf16(a[2], a[3]); w.z = cvt_pk_bf16(b[0], b[1]); w.w = cvt_pk_bf16(b[2], b[3]);
    st16_wt(p, w);
}
__device__ __forceinline__ void ld8(const bf16_t* p, f32x4& a, f32x4& b) {
    const u32x4 w = *(const u32x4*)p;
    a[0] = bf_lo(w.x); a[1] = bf_hi(w.x); a[2] = bf_lo(w.y); a[3] = bf_hi(w.y);
    b[0] = bf_lo(w.z); b[1] = bf_hi(w.z); b[2] = bf_lo(w.w); b[3] = bf_hi(w.w);
}
__device__ __forceinline__ void up8(u32x4 w, f32x4& a, f32x4& b) {
    a[0] = bf_lo(w.x); a[1] = bf_hi(w.x); a[2] = bf_lo(w.y); a[3] = bf_hi(w.y);
    b[0] = bf_lo(w.z); b[1] = bf_hi(w.z); b[2] = bf_lo(w.w); b[3] = bf_hi(w.w);
}
__device__ __forceinline__ float sigmoidf_(float x) { return __builtin_amdgcn_rcpf(1.0f + __expf(-x)); }
__device__ __forceinline__ float wave_sum(float v) {
#pragma unroll
    for (int o = 1; o < 64; o <<= 1) v += __shfl_xor(v, o);
    return v;
}
#define LDS_WAIT() asm volatile("s_waitcnt lgkmcnt(0)" ::: "memory")

#define XB_TMO      128
#define XB_XCNT(j)  (256  + 64 * (j))
#define XB_XSUB(j)  (1280 + 64 * (j))
#define XB_XGEN(j)  (2304 + 64 * (j))
#define XB_TOP      3328
#define XB_TOPGEN   3392
#define XCD_BAR_WORDS 3456
#define XB_SPIN_CAP (1u << 18)
__device__ __forceinline__ unsigned xb_ld(unsigned* p)              { return __hip_atomic_load(p, __ATOMIC_RELAXED, __HIP_MEMORY_SCOPE_AGENT); }
__device__ __forceinline__ unsigned xb_add(unsigned* p, unsigned v) { return __hip_atomic_fetch_add(p, v, __ATOMIC_RELAXED, __HIP_MEMORY_SCOPE_AGENT); }
__device__ __forceinline__ unsigned xb_xcc_id() { return (unsigned)__builtin_amdgcn_s_getreg((3 << 11) | 20) & 0xFu; }
#define XB_SPIN(cond, bar) do { unsigned _sp = 0; while (cond) { __builtin_amdgcn_s_sleep(1); \
    if ((++_sp & 255u) == 0u) { if (xb_ld(&(bar)[XB_TMO])) break; if (_sp > XB_SPIN_CAP) { atomicAdd(&(bar)[XB_TMO], 1u); break; } } } } while (0)
struct XcdBarrier { unsigned* bar; unsigned x; volatile LAS unsigned* st; };
__device__ __forceinline__ XcdBarrier xcd_barrier_post(unsigned* bar, volatile LAS unsigned* st) {
    XcdBarrier b; b.bar = bar; b.x = xb_xcc_id(); b.st = st;
    if (threadIdx.x == 0) (void)xb_add(&bar[XB_XCNT(b.x)], 1u);
    return b;
}
__device__ __forceinline__ void xcd_barrier_complete(unsigned* bar, unsigned x, unsigned& nloc, unsigned& nx) {
    const unsigned G = gridDim.x * gridDim.y * gridDim.z;
    unsigned sum, cnt, mine, sp = 0u;
    for (;;) {
        sum = 0u; cnt = 0u; mine = 0u;
#pragma unroll
        for (unsigned j = 0; j < 16; ++j) { const unsigned c = xb_ld(&bar[XB_XCNT(j)]); sum += c; cnt += (c > 0u) ? 1u : 0u; mine = (j == x) ? c : mine; }
        if (sum == G) break;
        __builtin_amdgcn_s_sleep(1);
        if ((++sp & 255u) == 0u) { if (xb_ld(&bar[XB_TMO])) break; if (sp > XB_SPIN_CAP) { atomicAdd(&bar[XB_TMO], 1u); break; } }
    }
    nloc = mine > 0u ? mine : 1u; nx = cnt > 0u ? cnt : 1u;
}
__device__ __forceinline__ void xcd_barrier(const XcdBarrier& b) {
    asm volatile("s_waitcnt vmcnt(0)" ::: "memory");
    __syncthreads();
    if (threadIdx.x == 0) {
        unsigned* bar = b.bar;
        __builtin_amdgcn_s_waitcnt(0);
        unsigned nloc = b.st[0], nx = b.st[1];
        if (nloc == 0u) { xcd_barrier_complete(bar, b.x, nloc, nx); b.st[0] = nloc; b.st[1] = nx; }
        const unsigned old = xb_add(&bar[XB_XSUB(b.x)], 1u);
        const unsigned gen = old / nloc;
        if (old + 1u == (gen + 1u) * nloc) {
            __builtin_amdgcn_fence(__ATOMIC_RELEASE, "agent");
            asm volatile("s_waitcnt vmcnt(0)" ::: "memory");
            const unsigned og = xb_add(&bar[XB_TOP], 1u);
            const unsigned tg = og / nx;
            if (og + 1u == (tg + 1u) * nx) xb_add(&bar[XB_TOPGEN], 1u);
            else XB_SPIN(xb_ld(&bar[XB_TOPGEN]) == tg, bar);
            __builtin_amdgcn_fence(__ATOMIC_ACQUIRE, "agent");
            xb_add(&bar[XB_XGEN(b.x)], 1u);
            asm volatile("s_waitcnt vmcnt(0)" ::: "memory");
        } else {
            XB_SPIN(xb_ld(&bar[XB_XGEN(b.x)]) == gen, bar);
            __builtin_amdgcn_fence(__ATOMIC_ACQUIRE, "agent");
            asm volatile("s_waitcnt vmcnt(0)" ::: "memory");
        }
    }
    __syncthreads();
}

__device__ __forceinline__ int lds_byte(int r, int c) { const int st = (r >> 4) * 2 + (c >> 5), rr = r & 15, cc = c & 31, ob = rr * 64 + cc * 2; return st * 1024 + (ob ^ (((ob >> 9) & 1) << 5)); }
__device__ __forceinline__ void stage_rc(int b, int& R, int& C) { const int st = b / 1024, sb = b % 1024, swz = sb ^ (((sb >> 9) & 1) << 5); R = (st >> 1) * 16 + swz / 64; C = (st & 1) * 32 + (swz % 64) / 2; }
__device__ __forceinline__ int perm32(int rho) { const int n = rho >> 4, i = rho & 15; return 8 * (i >> 2) + 4 * n + (i & 3); }

struct Unit { int pm, pn; };
struct Gemm { const bf16_t* A; const bf16_t* Bt; int lda, ldb, K, nM, nN, a_pn_off, a_wrap_shift; size_t a_wrap_stride; };
struct StaticOrder {
    int nM, nN, nwg, G, c;
    __device__ void init(int nM_, int nN_, int G_, int c_) { nM = nM_; nN = nN_; nwg = nM * nN; G = G_; c = c_; }
    __device__ bool next(int i, Unit& u) const {
        const long L = (long)i * G + c; if (L >= nwg) return false;
        int wgid = (int)L; { const int q = nwg / NXCD, r = nwg % NXCD, xcd = wgid % NXCD, off = wgid / NXCD; wgid = (xcd < r ? xcd * (q + 1) : r * (q + 1) + (xcd - r) * q) + off; }
        const int nig = WGM * nN, gid = wgid / nig, fm = gid * WGM, gsz = (nM - fm) < WGM ? (nM - fm) : WGM;
        u.pm = fm + ((wgid % nig) % gsz); u.pn = (wgid % nig) / gsz; return true;
    }
};

enum { E_PROJ = 0, E_SCALE = 1, E_GATE = 2, E_GATEADD = 3, E_PLAIN = 4, E_RELU2 = 5 };
struct Epi { int id, ldc; bf16_t* o0; const bf16_t* x0; const bf16_t* x1; const float* vec; unsigned char* ws; };

__device__ __forceinline__ void epilogue(const Epi& E, const f32x4 (&acc)[2][2][4][2], const Unit& u) {
    int tl = threadIdx.x; asm volatile("" : "+v"(tl));
    const int wv = tl >> 6, ln = tl & 63, wr = wv >> 2, wc = wv & 3, fr = ln & 15, fq = ln >> 4;
    if (E.id == 99) return;
    const int row0 = u.pm * BM + wr * 64 + fr;
    const int colw = wc * 32 + 8 * fq;
    if (E.id == E_PROJ) {
        if (u.pn >= 4 && u.pn < 12) {
            const int ch = (u.pn - 4) * 128 + colw;
#pragma unroll
            for (int ai = 0; ai < 2; ++ai)
#pragma unroll
                for (int m = 0; m < 4; ++m) {
                    const size_t r = (size_t)(row0 + ai * HALF + m * 16);
                    st8((bf16_t*)(E.ws + 2 * SLOT) + r * D + ch, acc[ai][0][m][0] * acc[ai][1][m][0], acc[ai][0][m][1] * acc[ai][1][m][1]);
                }
        } else if (u.pn >= 16) {
            const int gc0 = (u.pn - 16) * BM;
            bf16_t* O = (bf16_t*)(E.ws + (gc0 < D ? 4 : 5) * SLOT);
            const int oc0 = gc0 & (D - 1);
#pragma unroll
            for (int bj = 0; bj < 2; ++bj) {
                const f32x4 b0 = *(const f32x4*)(E.vec + gc0 + bj * HALF + colw), b1 = *(const f32x4*)(E.vec + gc0 + bj * HALF + colw + 4);
#pragma unroll
                for (int ai = 0; ai < 2; ++ai)
#pragma unroll
                    for (int m = 0; m < 4; ++m) {
                        const size_t r = (size_t)(row0 + ai * HALF + m * 16);
                        f32x4 v0 = acc[ai][bj][m][0] + b0, v1 = acc[ai][bj][m][1] + b1;
#pragma unroll
                        for (int j = 0; j < 4; ++j) { v0[j] = sigmoidf_(v0[j]); v1[j] = sigmoidf_(v1[j]); }
                        st8(O + r * D + oc0 + bj * HALF + colw, v0, v1);
                    }
            }
        } else {
            bf16_t* O = (bf16_t*)(E.ws + (u.pn < 4 ? 1 : 3) * SLOT);
            const int oc0 = (u.pn & 3) * BM;
#pragma unroll
            for (int ai = 0; ai < 2; ++ai)
#pragma unroll
                for (int m = 0; m < 4; ++m) {
                    const size_t r = (size_t)(row0 + ai * HALF + m * 16);
#pragma unroll
                    for (int bj = 0; bj < 2; ++bj) st8(O + r * D + oc0 + bj * HALF + colw, acc[ai][bj][m][0], acc[ai][bj][m][1]);
                }
        }
        return;
    }
    const int col0 = u.pn * BM + colw;
    if (E.id == E_SCALE) {
#pragma unroll
        for (int bj = 0; bj < 2; ++bj) {
            const f32x4 s0 = *(const f32x4*)(E.vec + col0 + bj * HALF), s1 = *(const f32x4*)(E.vec + col0 + bj * HALF + 4);
#pragma unroll
            for (int ai = 0; ai < 2; ++ai)
#pragma unroll
                for (int m = 0; m < 4; ++m) {
                    const size_t r = (size_t)(row0 + ai * HALF + m * 16);
                    st8(E.o0 + r * E.ldc + col0 + bj * HALF, acc[ai][bj][m][0] * s0, acc[ai][bj][m][1] * s1);
                }
        }
    } else if (E.id == E_GATE) {
#pragma unroll
        for (int ai = 0; ai < 2; ++ai) {
            u32x4 gr[4][2];
#pragma unroll
            for (int m = 0; m < 4; ++m)
#pragma unroll
                for (int bj = 0; bj < 2; ++bj) gr[m][bj] = __builtin_nontemporal_load((const u32x4*)(E.x0 + (size_t)(row0 + ai * HALF + m * 16) * D + col0 + bj * HALF));
#pragma unroll
            for (int m = 0; m < 4; ++m) {
                const size_t r = (size_t)(row0 + ai * HALF + m * 16);
#pragma unroll
                for (int bj = 0; bj < 2; ++bj) {
                    f32x4 g0, g1; up8(gr[m][bj], g0, g1);
                    st8(E.o0 + r * E.ldc + col0 + bj * HALF, acc[ai][bj][m][0] * g0, acc[ai][bj][m][1] * g1);
                }
            }
        }
    } else if (E.id == E_GATEADD) {
#pragma unroll
        for (int ai = 0; ai < 2; ++ai) {
            u32x4 gr[4][2], ar[4][2];
#pragma unroll
            for (int m = 0; m < 4; ++m)
#pragma unroll
                for (int bj = 0; bj < 2; ++bj) {
                    const size_t o = (size_t)(row0 + ai * HALF + m * 16) * D + col0 + bj * HALF;
                    gr[m][bj] = __builtin_nontemporal_load((const u32x4*)(E.x0 + o)); ar[m][bj] = __builtin_nontemporal_load((const u32x4*)(E.x1 + o));
                }
#pragma unroll
            for (int m = 0; m < 4; ++m) {
                const size_t r = (size_t)(row0 + ai * HALF + m * 16);
#pragma unroll
                for (int bj = 0; bj < 2; ++bj) {
                    f32x4 g0, g1, a0, a1; up8(gr[m][bj], g0, g1); up8(ar[m][bj], a0, a1);
                    st8(E.o0 + r * E.ldc + col0 + bj * HALF, a0 + acc[ai][bj][m][0] * g0, a1 + acc[ai][bj][m][1] * g1);
                }
            }
        }
    } else if (E.id == E_RELU2) {
        bf16_t* O = (bf16_t*)(E.ws + (size_t)(1 + (u.pn >> 2)) * SLOT) + (u.pn & 3) * BM + colw;
#pragma unroll
        for (int ai = 0; ai < 2; ++ai)
#pragma unroll
            for (int m = 0; m < 4; ++m) {
                const size_t r = (size_t)(row0 + ai * HALF + m * 16);
#pragma unroll
                for (int bj = 0; bj < 2; ++bj) {
                    f32x4 v0 = acc[ai][bj][m][0], v1 = acc[ai][bj][m][1];
#pragma unroll
                    for (int j = 0; j < 4; ++j) { const float a = fmaxf(v0[j], 0.f), b = fmaxf(v1[j], 0.f); v0[j] = a * a; v1[j] = b * b; }
                    st8(O + r * D + bj * HALF, v0, v1);
                }
            }
    } else {
#pragma unroll
        for (int ai = 0; ai < 2; ++ai)
#pragma unroll
            for (int m = 0; m < 4; ++m) {
                const size_t r = (size_t)(row0 + ai * HALF + m * 16);
#pragma unroll
                for (int bj = 0; bj < 2; ++bj) st8(E.o0 + r * E.ldc + col0 + bj * HALF, acc[ai][bj][m][0], acc[ai][bj][m][1]);
            }
    }
}

__device__ __forceinline__ void gemm_phase(LAS unsigned char* lds, const Gemm g, const StaticOrder& S, const Epi& E) {
    const int tid = threadIdx.x, wid = __builtin_amdgcn_readfirstlane(tid >> 6), lane = tid & 63, wr = wid >> 2, wc = wid & 3, fr = lane & 15, fq = lane >> 4;
    const int nt = g.K / BK;
    unsigned voffA[2], voffB[2];
#pragma unroll
    for (int i = 0; i < 2; ++i) { int R, C; stage_rc(tid * 16 + i * 8192, R, C); const int Rb = (R & ~31) + perm32(R & 31);
        voffA[i] = (unsigned)(R * g.lda + C) * 2u; voffB[i] = (unsigned)(Rb * g.ldb + C) * 2u; }
    const size_t kstep = (size_t)(BK * 2);
    const size_t hstepA = (size_t)HALF * g.lda * 2, hstepB = (size_t)HALF * g.ldb * 2;
    const size_t tstepA = 2 * hstepA, tstepB = 2 * hstepB;
    const size_t pnoffA = (size_t)g.a_pn_off * 2;
    const int wsh = g.a_wrap_shift, wmask = (1 << wsh) - 1; const size_t wstride = g.a_wrap_stride;
#define PG8_AOFF(t) ((size_t)((t) >> wsh) * wstride + (size_t)((t) & wmask) * kstep)
    const unsigned ldsw = (unsigned)wid * 1024u;
    const int aoff = lds_byte(wr * 64 + fr, fq * 8), boff = lds_byte(wc * 32 + fr, fq * 8);
#define PG8_SA(b, h) (((b) * 2 + (h)) * HTB)
#define PG8_SB(b, h) ((4 + (b) * 2 + (h)) * HTB)
#define PG8_STAGE(bufoff, gbase, voff) do { _Pragma("unroll") for (int _i = 0; _i < 2; ++_i) \
        __builtin_amdgcn_global_load_lds((const unsigned*)((const char*)(gbase) + (voff)[_i]), (LAS unsigned*)(lds + (bufoff) + ldsw + _i * 8192), 16, 0, 0); } while (0)
#define PG8_LDA(dst, b, h) do { _Pragma("unroll") for (int m = 0; m < 4; ++m) _Pragma("unroll") for (int k = 0; k < 2; ++k) dst[m][k] = *(const LAS bf16x8*)(lds + PG8_SA(b, h) + aoff + m * 2048 + k * 1024); } while (0)
#define PG8_LDB(dst, b, h) do { _Pragma("unroll") for (int n = 0; n < 2; ++n) _Pragma("unroll") for (int k = 0; k < 2; ++k) dst[n][k] = *(const LAS bf16x8*)(lds + PG8_SB(b, h) + boff + n * 2048 + k * 1024); } while (0)
#define PG8_MMA(ai, bj, At, Bt) do { __builtin_amdgcn_s_setprio(1); _Pragma("unroll") for (int m = 0; m < 4; ++m) _Pragma("unroll") for (int n = 0; n < 2; ++n) _Pragma("unroll") for (int k = 0; k < 2; ++k) \
        acc[ai][bj][m][n] = __builtin_amdgcn_mfma_f32_16x16x32_bf16(Bt[n][k], At[m][k], acc[ai][bj][m][n], 0, 0, 0); __builtin_amdgcn_s_setprio(0); } while (0)
#define PG8_WAIT_V(n) asm volatile("s_waitcnt vmcnt(" #n ")" ::: "memory")
#define PG8_WAIT_L(n) asm volatile("s_waitcnt lgkmcnt(" #n ")" ::: "memory")
#define PG8_BAR __builtin_amdgcn_s_barrier()
#define PG8_SCHED __builtin_amdgcn_sched_barrier(0)
    Unit cur, nxt; int ui = 0;
    if (!S.next(0, cur)) return;
    f32x4 acc[2][2][4][2];
#pragma unroll
    for (int a = 0; a < 2; ++a)
#pragma unroll
        for (int b = 0; b < 2; ++b)
#pragma unroll
            for (int m = 0; m < 4; ++m)
#pragma unroll
                for (int n = 0; n < 2; ++n) acc[a][b][m][n] = (f32x4){0.f, 0.f, 0.f, 0.f};
    bf16x8 At[4][2], B0[2][2], B1[2][2];
    const char* cA = (const char*)g.A + (size_t)cur.pm * tstepA + (size_t)cur.pn * pnoffA; const char* cB = (const char*)g.Bt + (size_t)cur.pn * tstepB;
    PG8_STAGE(PG8_SB(0, 0), cB, voffB); PG8_STAGE(PG8_SA(0, 0), cA, voffA); PG8_STAGE(PG8_SB(0, 1), cB + hstepB, voffB); PG8_STAGE(PG8_SA(0, 1), cA + hstepA, voffA);
    if (wr == 1) PG8_BAR;
    PG8_WAIT_V(4); PG8_BAR;
    PG8_STAGE(PG8_SB(1, 0), cB + kstep, voffB); PG8_STAGE(PG8_SA(1, 0), cA + kstep, voffA); PG8_STAGE(PG8_SB(1, 1), cB + hstepB + kstep, voffB);
    PG8_WAIT_V(6); PG8_BAR;
    for (;;) {
        const bool has_next = S.next(ui + 1, nxt);
        const char* nA = has_next ? (const char*)g.A + (size_t)nxt.pm * tstepA + (size_t)nxt.pn * pnoffA : cA; const char* nB = has_next ? (const char*)g.Bt + (size_t)nxt.pn * tstepB : cB;
        for (int t = 0; t < nt; t += 2) {
            const bool last = (t == nt - 2);
            const char* a1 = cA + PG8_AOFF(t + 1);
            const char* a2 = last ? nA : cA + PG8_AOFF(t + 2); const char* b2 = last ? nB : cB + (size_t)(t + 2) * kstep;
            const char* a3 = last ? nA + kstep : cA + PG8_AOFF(t + 3); const char* b3 = b2 + kstep;
            PG8_LDB(B0, 0, 0); PG8_SCHED; PG8_LDA(At, 0, 0); PG8_STAGE(PG8_SA(1, 1), a1 + hstepA, voffA);
            PG8_WAIT_L(8); PG8_BAR; PG8_WAIT_L(0); PG8_MMA(0, 0, At, B0); PG8_BAR; PG8_SCHED;
            PG8_LDB(B1, 0, 1); PG8_STAGE(PG8_SB(0, 0), b2, voffB);
            PG8_BAR; PG8_WAIT_L(0); PG8_MMA(0, 1, At, B1); PG8_BAR;
            PG8_LDA(At, 0, 1); PG8_STAGE(PG8_SA(0, 0), a2, voffA);
            PG8_BAR; PG8_WAIT_L(0); PG8_MMA(1, 0, At, B0); PG8_BAR; PG8_SCHED;
            PG8_STAGE(PG8_SB(0, 1), b2 + hstepB, voffB);
            PG8_WAIT_V(6); PG8_BAR; PG8_MMA(1, 1, At, B1); PG8_BAR;
            PG8_LDB(B0, 1, 0); PG8_SCHED; PG8_LDA(At, 1, 0); PG8_STAGE(PG8_SA(0, 1), a2 + hstepA, voffA);
            PG8_WAIT_L(8); PG8_BAR; PG8_WAIT_L(0); PG8_MMA(0, 0, At, B0); PG8_BAR; PG8_SCHED;
            PG8_LDB(B1, 1, 1); PG8_STAGE(PG8_SB(1, 0), b3, voffB);
            PG8_BAR; PG8_WAIT_L(0); PG8_MMA(0, 1, At, B1); PG8_BAR;
            PG8_LDA(At, 1, 1); PG8_STAGE(PG8_SA(1, 0), a3, voffA);
            PG8_BAR; PG8_WAIT_L(0); PG8_MMA(1, 0, At, B0); PG8_BAR; PG8_SCHED;
            PG8_STAGE(PG8_SB(1, 1), b3 + hstepB, voffB);
            PG8_WAIT_V(6); PG8_BAR; PG8_MMA(1, 1, At, B1); PG8_BAR;
        }
        epilogue(E, acc, cur);
        if (!has_next) break;
#pragma unroll
        for (int a = 0; a < 2; ++a)
#pragma unroll
            for (int b = 0; b < 2; ++b)
#pragma unroll
                for (int m = 0; m < 4; ++m)
#pragma unroll
                    for (int n = 0; n < 2; ++n) acc[a][b][m][n] = (f32x4){0.f, 0.f, 0.f, 0.f};
        cur = nxt; cA = nA; cB = nB; ++ui;
    }
    PG8_WAIT_V(0);
    if (wr == 0) PG8_BAR;
    PG8_BAR;
#undef PG8_AOFF
#undef PG8_SA
#undef PG8_SB
#undef PG8_STAGE
#undef PG8_LDA
#undef PG8_LDB
#undef PG8_MMA
#undef PG8_WAIT_V
#undef PG8_WAIT_L
#undef PG8_BAR
#undef PG8_SCHED
}

__device__ __forceinline__ int win_dst_row(int n0) {
    if (n0 < D || n0 >= 3 * D) return n0;
    const int isv = n0 >= 2 * D, ch = n0 - (isv ? 2 * D : D);
    return D + (ch >> 7) * 256 + isv * 128 + (ch & 127);
}
struct TrItem { const float* W; bf16_t* WT; int K, N, wperm, item; };
__device__ __forceinline__ void tr_load(const TrItem& t, float (&wv)[32], int lane) {
    const int nblk = t.N / 32, kb = t.item / nblk, nb = t.item % nblk, k0 = 64 * kb, n0 = 32 * nb;
#pragma unroll
    for (int i = 0; i < 32; ++i) wv[i] = __builtin_nontemporal_load(t.W + (size_t)(k0 + 2 * i + (lane >> 5)) * t.N + n0 + (lane & 31));
}
template <bool WT_STORE> __device__ __forceinline__ void tr_finish(const TrItem& t, const float (&wv)[32], LAS float* scr, int lane) {
    const int nblk = t.N / 32, kb = t.item / nblk, nb = t.item % nblk, k0 = 64 * kb, n0 = 32 * nb;
#pragma unroll
    for (int i = 0; i < 32; ++i) scr[(2 * i + (lane >> 5)) * 33 + (lane & 31)] = wv[i];
    LDS_WAIT(); asm volatile("" ::: "memory");
    const int c = lane & 7;
    const int drow0 = t.wperm ? win_dst_row(n0) : n0;
#pragma unroll
    for (int j = 0; j < 4; ++j) { const int n = (lane >> 3) + 8 * j; const LAS float* s = scr + (8 * c) * 33 + n;
        u32x4 o; o.x = cvt_pk_bf16(s[0 * 33], s[1 * 33]); o.y = cvt_pk_bf16(s[2 * 33], s[3 * 33]); o.z = cvt_pk_bf16(s[4 * 33], s[5 * 33]); o.w = cvt_pk_bf16(s[6 * 33], s[7 * 33]);
        if (WT_STORE) st16_wt(t.WT + (size_t)(drow0 + n) * t.K + k0 + 8 * c, o); else *(u32x4*)(t.WT + (size_t)(drow0 + n) * t.K + k0 + 8 * c) = o; }
    LDS_WAIT(); asm volatile("" ::: "memory");
}
template <bool WT_STORE> __device__ __forceinline__ void transpose_item(const float* W, int K, int N, bf16_t* WT, int wperm, LAS float* scr, int item, int lane) {
    const TrItem t{W, WT, K, N, wperm, item}; float wv[32]; tr_load(t, wv, lane); tr_finish<WT_STORE>(t, wv, scr, lane);
}
constexpr int TR_L = 3 * 512 + 128 + 2 * 2048, TR_TOTAL = 3072 + NL * TR_L, TR_P0 = 3072 + TR_L;
__device__ __forceinline__ TrItem tr_decode(const Params& p, unsigned char* ws, int idx) {
    if (idx < 3072) return TrItem{p.in[4], (bf16_t*)(ws + WS_WIN), D, DIN, 1, idx};
    idx -= 3072; const int l = idx / TR_L; int r = idx - l * TR_L;
    unsigned char* wl = ws + WS_WL + (size_t)l * WL_BYTES;
    if (r < 512) return TrItem{p.in[7] + (size_t)l * D * D, (bf16_t*)(wl + WL_WC), D, D, 0, r}; r -= 512;
    if (r < 512) return TrItem{p.in[10] + (size_t)l * D * D, (bf16_t*)(wl + WL_WP), D, D, 0, r}; r -= 512;
    if (r < 512) return TrItem{p.in[11] + (size_t)l * D * D, (bf16_t*)(wl + WL_WO), D, D, 0, r}; r -= 512;
    if (r < 128) { const int gi = r >> 5; return TrItem{p.in[8] + (size_t)l * 4 * 65536 + (size_t)gi * 65536, (bf16_t*)(wl + WL_POOL) + (size_t)gi * 65536, 256, 256, 0, r & 31}; } r -= 128;
    if (r < 2048) return TrItem{p.in[14] + (size_t)l * D * DFF, (bf16_t*)(wl + WL_UP), D, DFF, 0, r}; r -= 2048;
    return TrItem{p.in[15] + (size_t)l * DFF * D, (bf16_t*)(wl + WL_DOWN), DFF, D, 0, r};
}
template <bool WT_STORE> __device__ __forceinline__ void transpose_matrix(const float* W, int K, int N, bf16_t* WT, int wperm, LAS float* scr, int gw, int NGW, int lane, int& off) {
    const int nitems = (K / 64) * (N / 32);
    int start = gw - (off % NGW); if (start < 0) start += NGW;
    for (int it = start; it < nitems; it += NGW) transpose_item<WT_STORE>(W, K, N, WT, wperm, scr, it, lane);
    off += nitems;
}

enum { SE_F32 = 0, SE_SCALE = 1, SE_GATE = 2, SE_GATEADD = 3, SE_RELU2 = 4 };
struct SkGemm { int emode, lda, ldb, ldc, nCB, K, cbPerGrp, grpK, nKS; const bf16_t* A; const bf16_t* Bt; void* C; const float* projs; const float* vec; float* m1; };
__device__ __forceinline__ void skinny_gemm(LAS unsigned char* lds, const SkGemm& g, int task0, int tstride) {
    int tl = threadIdx.x; asm volatile("" : "+v"(tl));
    const int lane = tl & 63, wid = tl >> 6, fr = lane & 15, fq = lane >> 4;
    const int kw = g.K >> 3, nks = kw >> 5;
    for (int t = task0; t < g.nCB * g.nKS; t += tstride) {
        const int cb = t % g.nCB, ksl = t / g.nCB;
        const int kB = ksl * g.K + wid * kw, kA = kB + (cb / g.cbPerGrp) * g.grpK;
        f32x4 acc[8][2];
#pragma unroll
        for (int rb = 0; rb < 8; ++rb) { acc[rb][0] = (f32x4){0.f, 0.f, 0.f, 0.f}; acc[rb][1] = acc[rb][0]; }
        const bf16_t* bp = g.Bt + (size_t)(cb * 32 + fr) * g.ldb + kB + fq * 8;
        const bf16_t* ap = g.A + (size_t)fr * g.lda + kA + fq * 8;
        for (int ks = 0; ks < nks; ks += 2) {
            const bool two = ks + 1 < nks;
            bf16x8 a0[8], a1[8], b00, b01, b10, b11;
            b00 = *(const bf16x8*)(bp + ks * 32); b01 = *(const bf16x8*)(bp + (size_t)16 * g.ldb + ks * 32);
#pragma unroll
            for (int rb = 0; rb < 8; ++rb) a0[rb] = *(const bf16x8*)(ap + (size_t)rb * 16 * g.lda + ks * 32);
            if (two) {
                b10 = *(const bf16x8*)(bp + ks * 32 + 32); b11 = *(const bf16x8*)(bp + (size_t)16 * g.ldb + ks * 32 + 32);
#pragma unroll
                for (int rb = 0; rb < 8; ++rb) a1[rb] = *(const bf16x8*)(ap + (size_t)rb * 16 * g.lda + ks * 32 + 32);
            }
#pragma unroll
            for (int rb = 0; rb < 8; ++rb) {
                acc[rb][0] = __builtin_amdgcn_mfma_f32_16x16x32_bf16(b00, a0[rb], acc[rb][0], 0, 0, 0);
                acc[rb][1] = __builtin_amdgcn_mfma_f32_16x16x32_bf16(b01, a0[rb], acc[rb][1], 0, 0, 0);
            }
            if (two) {
#pragma unroll
                for (int rb = 0; rb < 8; ++rb) {
                    acc[rb][0] = __builtin_amdgcn_mfma_f32_16x16x32_bf16(b10, a1[rb], acc[rb][0], 0, 0, 0);
                    acc[rb][1] = __builtin_amdgcn_mfma_f32_16x16x32_bf16(b11, a1[rb], acc[rb][1], 0, 0, 0);
                }
            }
        }
#pragma unroll
        for (int rb = 0; rb < 8; ++rb)
#pragma unroll
            for (int c2 = 0; c2 < 2; ++c2) *(LAS f32x4*)(lds + wid * 16384 + ((rb * 2 + c2) * 64 + lane) * 16) = acc[rb][c2];
        __syncthreads();
#pragma unroll
        for (int h = 0; h < 2; ++h) {
            const int q = tl + h * 512, i = q >> 6, ls = q & 63;
            f32x4 v = *(const LAS f32x4*)(lds + q * 16);
#pragma unroll
            for (int w = 1; w < 8; ++w) v += *(const LAS f32x4*)(lds + w * 16384 + q * 16);
            const int row = (i >> 1) * 16 + (ls & 15), col = cb * 32 + (i & 1) * 16 + 4 * (ls >> 4);
            if (g.emode == SE_F32) st16_wt((float*)g.C + (size_t)ksl * 128 * g.ldc + (size_t)row * g.ldc + col, __builtin_bit_cast(u32x4, v));
            else if (g.emode == SE_GATE || g.emode == SE_GATEADD) {
                const int go = g.emode == SE_GATE ? 0 : D;
                f32x4 gt = *(const f32x4*)(g.projs + (size_t)row * DIN + 4 * D + go + col) + *(const f32x4*)(g.vec + go + col);
#pragma unroll
                for (int j = 0; j < 4; ++j) gt[j] = sigmoidf_(gt[j]);
                if (g.emode == SE_GATE) st16_wt(g.m1 + (size_t)row * D + col, __builtin_bit_cast(u32x4, gt * v));
                else { const f32x4 o = *(const f32x4*)(g.m1 + (size_t)row * D + col) + gt * v;
                    u32x2 w2; w2.x = cvt_pk_bf16(o[0], o[1]); w2.y = cvt_pk_bf16(o[2], o[3]); st8_wt((bf16_t*)g.C + (size_t)row * g.ldc + col, w2); }
            } else {
                f32x4 o;
                if (g.emode == SE_SCALE) o = v * *(const f32x4*)(g.vec + col);
                else {
#pragma unroll
                    for (int j = 0; j < 4; ++j) { const float u = fmaxf(v[j], 0.f); o[j] = u * u; }
                }
                u32x2 w2; w2.x = cvt_pk_bf16(o[0], o[1]); w2.y = cvt_pk_bf16(o[2], o[3]); st8_wt((bf16_t*)g.C + (size_t)row * g.ldc + col, w2);
            }
        }
        __syncthreads();
    }
}

__device__ __forceinline__ void norm_row_finish(f32x4 (&xv)[4], const f32x4 (&yv)[4], const f32x4 (&gp)[4], const f32x4 (&gn)[4], float* xo, bf16_t* xob, bf16_t* ho, int lane) {
    float s = 0.f;
#pragma unroll
    for (int j = 0; j < 4; ++j) s += (yv[j][0] * yv[j][0] + yv[j][1] * yv[j][1]) + (yv[j][2] * yv[j][2] + yv[j][3] * yv[j][3]);
    const float rs = rsqrtf(wave_sum(s) * (1.f / D) + EPS);
    float s2 = 0.f;
#pragma unroll
    for (int j = 0; j < 4; ++j) { xv[j] = xv[j] + yv[j] * rs * gp[j]; s2 += (xv[j][0] * xv[j][0] + xv[j][1] * xv[j][1]) + (xv[j][2] * xv[j][2] + xv[j][3] * xv[j][3]);
        if (xo) st16_wt(xo + lane * 4 + 256 * j, __builtin_bit_cast(u32x4, xv[j]));
        else { u32x2 o; o.x = cvt_pk_bf16(xv[j][0], xv[j][1]); o.y = cvt_pk_bf16(xv[j][2], xv[j][3]); st8_wt(xob + lane * 4 + 256 * j, o); } }
    if (ho) {
        const float rs2 = rsqrtf(wave_sum(s2) * (1.f / D) + EPS);
#pragma unroll
        for (int j = 0; j < 4; ++j) { u32x2 o; o.x = cvt_pk_bf16(xv[j][0] * rs2 * gn[j][0], xv[j][1] * rs2 * gn[j][1]); o.y = cvt_pk_bf16(xv[j][2] * rs2 * gn[j][2], xv[j][3] * rs2 * gn[j][3]);
            st8_wt(ho + lane * 4 + 256 * j, o); }
    }
}

#define SPIN_UNTIL(cond, tmo) do { unsigned _sp = 0; while (!(cond)) { __builtin_amdgcn_s_sleep(1); if (++_sp > (1u << 21)) { atomicAdd((tmo), 1u); break; } } } while (0)
__device__ __forceinline__ int sample_blocks(int ph) { return ph == 0 ? 192 : ph == 1 ? 256 : ph == 2 ? 64 : ph == 3 ? 0 : ph == 4 ? 32 : 128; }
__device__ __forceinline__ void step_sync(unsigned char* ctl, int b, int pm, int k, int ls, int nls) {
    asm volatile("s_waitcnt vmcnt(0)" ::: "memory");
    __syncthreads();
    if (threadIdx.x == 0) {
        unsigned* tcnt = (unsigned*)(ctl + CTL_TCNT); unsigned* gcnt = (unsigned*)(ctl + CTL_GCNT); unsigned* scnt = (unsigned*)(ctl + CTL_SCNT); unsigned* tmo = (unsigned*)(ctl) + XB_TMO;
        const int ph = ls % 10, nph = nls % 10;
        if (b < sample_blocks(ph)) (void)xb_add(scnt + 64 * k, 1u);
        if (ls == 0) (void)xb_add(gcnt, 1u);
        if (ls == 9) (void)xb_add(gcnt + 64, 1u);
        if (ls == 4) (void)xb_add(gcnt + 128, 1u);
        const unsigned target = 4u * (unsigned)(k + 1);
        const unsigned ticket = xb_add(tcnt + 64 * pm, 1u);
        if (ticket + 1u < target) SPIN_UNTIL(xb_ld(tcnt + 64 * pm) >= target, tmo);
        if (nph == 1 && pm > 0) SPIN_UNTIL(xb_ld(tcnt + 64 * (pm - 1)) >= target, tmo);
        if (nph == 2 && pm < 63) SPIN_UNTIL(xb_ld(tcnt + 64 * (pm + 1)) >= target, tmo);
        if (b < sample_blocks(nph)) { const int kk = nph == 4 ? k - 1 : k, pp = nph == 4 ? 2 : ph;
            SPIN_UNTIL(xb_ld(scnt + 64 * kk) >= (unsigned)sample_blocks(pp), tmo); }
        if (nls == 2 * 10 - 1 && pm < 32) {
            SPIN_UNTIL(xb_ld(tcnt + 64 * (2 * pm)) >= 68u, tmo); SPIN_UNTIL(xb_ld(tcnt + 64 * (2 * pm + 1)) >= 68u, tmo); }
        if (nls == 9) SPIN_UNTIL(xb_ld(gcnt) >= 256u, tmo);
        if (nls == 10) SPIN_UNTIL(xb_ld(gcnt + 64) >= 256u, tmo);
        if (nls == 12) SPIN_UNTIL(xb_ld(gcnt + 128) >= 256u, tmo);
        __builtin_amdgcn_fence(__ATOMIC_ACQUIRE, "agent");
        asm volatile("s_waitcnt vmcnt(0)" ::: "memory");
    }
    __syncthreads();
}

__global__ void __launch_bounds__(512, 2) fwd_megakernel(Params p) {
    extern __shared__ __attribute__((aligned(16))) unsigned char shm[];
    LAS unsigned char* lds = (LAS unsigned char*)shm;
    cg::grid_group grid = cg::this_grid();
    const int tid = threadIdx.x;
    const int G = (int)gridDim.x, NGW = G * 8;
    unsigned char* ws = p.ws;
    bf16_t* S0 = (bf16_t*)(ws + 0 * SLOT); bf16_t* S1 = (bf16_t*)(ws + 1 * SLOT); bf16_t* S2 = (bf16_t*)(ws + 2 * SLOT);
    bf16_t* S3 = (bf16_t*)(ws + 3 * SLOT); bf16_t* S5 = (bf16_t*)(ws + 5 * SLOT);
    bf16_t* WIN = (bf16_t*)(ws + WS_WIN);
    unsigned char* sm = ws + WS_SM;
    float* PROJS = (float*)(sm + SM_PROJ); float* M1S = (float*)(sm + SM_M1);
    bf16_t* HS = (bf16_t*)(sm + SM_HS); bf16_t* YAS = (bf16_t*)(sm + SM_YAS); bf16_t* DDS = (bf16_t*)(sm + SM_DDS);
    bf16_t* YBS = (bf16_t*)(sm + SM_YBS); bf16_t* MRGS = (bf16_t*)(sm + SM_MRG); bf16_t* US = (bf16_t*)(sm + SM_US);
    float* X = p.out + O_Y;

    volatile LAS unsigned* cns = (volatile LAS unsigned*)(lds + STAGE_BYTES);
    if (tid == 0) { const unsigned x = xb_xcc_id() & 7u; cns[0] = x; ((unsigned*)(ws + WS_BAR + CTL_XCNT))[blockIdx.x] = x; }
    for (int i = (int)blockIdx.x * 512 + tid; i < (int)(CTL_XCNT / 16); i += G * 512) *(u32x4*)(ws + WS_BAR + (size_t)i * 16) = (u32x4){0u, 0u, 0u, 0u};
    if (G != 256) return;
    {
        const int lane = tid & 63, wid = tid >> 6, gw = (int)blockIdx.x * 8 + wid;
        LAS float* scr = (LAS float*)(lds + wid * 16384);
        {
            int idx = gw; bool have = idx < TR_P0; TrItem cur{}; float wv[32];
            if (have) { cur = tr_decode(p, ws, idx); tr_load(cur, wv, lane); }
            while (have) {
                const int nidx = idx + NGW; const bool hn = nidx < TR_P0; TrItem nxt{}; float wn[32];
                if (hn) { nxt = tr_decode(p, ws, nidx); tr_load(nxt, wn, lane); }
                tr_finish<false>(cur, wv, scr, lane);
                if (hn) {
#pragma unroll
                    for (int i = 0; i < 32; ++i) wv[i] = wn[i];
                }
                cur = nxt; idx = nidx; have = hn;
            }
        }
        const float* gpre = p.in[12];
        f32x4 gv[4];
#pragma unroll
        for (int j = 0; j < 4; ++j) gv[j] = *(const f32x4*)(gpre + lane * 4 + 256 * j);
        for (int r0 = gw * 4; r0 < MTOT; r0 += NGW * 4) {
            f32x4 v[4][4];
#pragma unroll
            for (int q = 0; q < 4; ++q) { const int r = r0 + q; const float* xr = r < MP ? p.in[0] + (size_t)r * D : p.in[1] + (size_t)(r - MP) * D;
#pragma unroll
                for (int j = 0; j < 4; ++j) v[q][j] = __builtin_nontemporal_load((const f32x4*)(xr + lane * 4 + 256 * j)); }
#pragma unroll
            for (int q = 0; q < 4; ++q) {
                const int r = r0 + q; bf16_t* hr = r < MP ? S0 + (size_t)r * D : HS + (size_t)(r - MP) * D;
                float s = 0.f;
#pragma unroll
                for (int j = 0; j < 4; ++j) s += (v[q][j][0] * v[q][j][0] + v[q][j][1] * v[q][j][1]) + (v[q][j][2] * v[q][j][2] + v[q][j][3] * v[q][j][3]);
                const float rs = rsqrtf(wave_sum(s) * (1.f / D) + EPS);
#pragma unroll
                for (int j = 0; j < 4; ++j) { u32x2 o; o.x = cvt_pk_bf16(v[q][j][0] * rs * gv[j][0], v[q][j][1] * rs * gv[j][1]); o.y = cvt_pk_bf16(v[q][j][2] * rs * gv[j][2], v[q][j][3] * rs * gv[j][3]);
                    *(u32x2*)(hr + lane * 4 + 256 * j) = o; }
            }
        }
    }
    grid.sync();
    int bc = (int)blockIdx.x;
    {
        const unsigned* tab = (const unsigned*)(ws + WS_BAR + CTL_XCNT);
        const unsigned myx = cns[0];
        volatile LAS unsigned* red = (volatile LAS unsigned*)(lds + STAGE_BYTES + 16);
        if (tid < 9) red[tid] = 0u;
        __syncthreads();
        if (tid < 256) {
            const unsigned x = tab[tid];
            const unsigned long long lower = __ballot(x == myx && tid < (int)blockIdx.x);
            if ((tid & 63) == 0) atomicAdd((unsigned*)&red[0], (unsigned)__popcll(lower));
#pragma unroll
            for (unsigned xx = 0; xx < 8; ++xx) { const unsigned long long m = __ballot(x == xx); if ((tid & 63) == 0) atomicAdd((unsigned*)&red[1 + xx], (unsigned)__popcll(m)); }
        }
        __syncthreads();
        bool ok = true;
        for (int xx = 0; xx < 8; ++xx) ok = ok && (red[1 + xx] == 32u);
        if (ok) bc = (int)myx + 8 * (int)red[0];
        bc = __builtin_amdgcn_readfirstlane(bc);
    }
    const int pm_t = 8 * (bc & 7) + ((bc >> 3) & 7), mem_t = bc >> 6;

    if (SKEW_TICKS > 0 && (bc & 4)) {
        const unsigned long long t0 = __builtin_amdgcn_s_memrealtime();
        while (__builtin_amdgcn_s_memrealtime() - t0 < (unsigned long long)SKEW_TICKS) __builtin_amdgcn_s_sleep(8);
    }
    for (int step = 0; step < p.nsteps; ++step) {
        const int step2 = (p.pad && step > p.pad) ? step - 1 : step;
        const int l = step2 / 10, ph = step2 - l * 10;
        int tid_s = threadIdx.x; asm volatile("" : "+v"(tid_s));
        const int lane = tid_s & 63, wid = tid_s >> 6, gw = bc * 8 + wid;
        unsigned char* wl = ws + WS_WL + (size_t)l * WL_BYTES;
        const float* bgate = p.in[5] + (size_t)l * 2 * D;
        Gemm g{S0, WIN, D, D, D, MP / BM, D / BM, 0, 30, 0};
        Epi E{E_PLAIN, D, S1, nullptr, nullptr, nullptr, ws};
        SkGemm sk{SE_F32, D, D, D, D / 32, D, 1 << 20, 0, 1, HS, WIN, PROJS, PROJS, bgate, M1S};
        bool is_gemm = true;
        switch (ph) {
        case 0:
            g.nN = DIN / BM; E.id = E_PROJ; E.vec = bgate;
            sk.ldc = DIN; sk.nCB = DIN / 32; sk.C = PROJS; break;
        case 2:
            g.Bt = (const bf16_t*)(wl + WL_POOL); g.ldb = 256; g.K = 256; g.nN = 4; g.a_pn_off = 256;
            E.id = E_SCALE; E.o0 = S2; E.vec = p.in[9] + (size_t)l * D;
            if (bc < 32) { sk.emode = SE_SCALE; sk.A = DDS; sk.Bt = g.Bt; sk.ldb = 256; sk.K = 256; sk.cbPerGrp = 8; sk.grpK = 256; sk.C = YBS; sk.vec = E.vec; }
            else { sk.emode = SE_GATE; sk.A = YAS; sk.Bt = (const bf16_t*)(wl + WL_WC); }
            break;
        case 3:
            g.A = S1; g.Bt = (const bf16_t*)(wl + WL_WC); E.id = E_GATE; E.o0 = S3; E.x0 = (const bf16_t*)(ws + 4 * SLOT);
            sk.nCB = 0; break;
        case 4:
            g.A = S2; g.Bt = (const bf16_t*)(wl + WL_WP); E.id = E_GATEADD; E.o0 = S0; E.x0 = S5; E.x1 = S3;
            sk.emode = SE_GATEADD; sk.A = YBS; sk.Bt = g.Bt; sk.C = MRGS; break;
        case 5:
            g.Bt = (const bf16_t*)(wl + WL_WO); E.o0 = S5;
            sk.A = MRGS; sk.Bt = g.Bt; sk.K = 256; sk.nKS = 4; break;
        case 7:
            g.Bt = (const bf16_t*)(wl + WL_UP); g.nN = DFF / BM; E.id = E_RELU2; E.ldc = DFF;
            sk.emode = SE_RELU2; sk.Bt = g.Bt; sk.ldc = DFF; sk.nCB = DFF / 32; sk.C = US; break;
        case 8:
            g.A = S1; g.Bt = (const bf16_t*)(wl + WL_DOWN); g.ldb = DFF; g.K = DFF; g.a_wrap_shift = 4; g.a_wrap_stride = SLOT; E.o0 = S0;
            sk.A = US; sk.lda = DFF; sk.Bt = g.Bt; sk.ldb = DFF; sk.K = D; sk.nKS = 4; break;
        default: is_gemm = false; break;
        }
        if (is_gemm) {
            skinny_gemm(lds, sk, (ph == 2 && bc >= 32) ? bc - 32 : bc, G);
            StaticOrder S; S.init(g.nM, g.nN, G, bc);
            gemm_phase(lds, g, S, E);
            if (l == 0 && (ph == 0 || ph == 2 || ph == 4)) {
                const int nts = ph == 0 ? 192 : ph == 2 ? 64 : 32, boff = ph == 0 ? 0 : ph == 2 ? 64 : 256;
                if (bc >= nts) {
                    LAS float* scr = (LAS float*)(lds + wid * 16384);
#pragma unroll 1
                    for (int j = 0; j < 2; ++j) {
                        const int it = (boff + bc - nts) * 16 + wid * 2 + j;
                        if (it < TR_L) { const TrItem t = tr_decode(p, ws, TR_P0 + it); float wv[32]; tr_load(t, wv, lane); tr_finish<true>(t, wv, scr, lane); }
                    }
                }
            }
        } else if (ph == 1) {
            const float* cw = p.in[6] + (size_t)l * 3 * D;
            const float* cconv = p.in[2] + (size_t)l * NB_S * 2 * D;
            const float* cpool = p.in[3] + (size_t)l * NB_S * 15 * D;
            float* o_csp = p.out + O_CSP + (size_t)l * 2 * D;
            float* o_psp = p.out + O_PSP + (size_t)l * 15 * D;
            float* o_css = p.out + O_CSS + (size_t)l * NB_S * 2 * D;
            float* o_pss = p.out + O_PSS + (size_t)l * NB_S * 15 * D;
            const f32x4 zero4 = (f32x4){0.f, 0.f, 0.f, 0.f};
            {
                const int hi = wid * 2 + (lane >> 5);
                const int gi = hi & 3, r0 = pm_t * 256 + (mem_t * 4 + (hi >> 2)) * 16, ch = gi * 256 + (lane & 31) * 8, w = 2 << gi;
                const bool head = (r0 == 0);
                const float ic = 1.0f / (float)w;
                const f32x4 w0a = *(const f32x4*)(cw + ch), w0b = *(const f32x4*)(cw + ch + 4);
                const f32x4 w1a = *(const f32x4*)(cw + D + ch), w1b = *(const f32x4*)(cw + D + ch + 4);
                const f32x4 w2a = *(const f32x4*)(cw + 2 * D + ch), w2b = *(const f32x4*)(cw + 2 * D + ch + 4);
                f32x4 z1a = zero4, z1b = zero4, z2a = zero4, z2b = zero4, sa = zero4, sb2 = zero4;
                if (!head) {
                    ld8(S2 + (size_t)(r0 - 1) * D + ch, z1a, z1b);
                    ld8(S2 + (size_t)(r0 - 2) * D + ch, z2a, z2b);
#pragma unroll
                    for (int i0 = 1; i0 < 16; i0 += 8) {
                        u32x4 hr[8];
#pragma unroll
                        for (int i = 0; i < 8; ++i) if (i0 + i < 16) hr[i] = *(const u32x4*)(S3 + (size_t)(r0 - (i0 + i)) * D + ch);
#pragma unroll
                        for (int i = 0; i < 8; ++i) if (i0 + i < 16) { f32x4 qa, qb; up8(hr[i], qa, qb); const float mk = (i0 + i < w) ? 1.f : 0.f; sa += qa * mk; sb2 += qb * mk; }
                    }
                }
                u32x4 nB[2], nZ[2], nP[2], nO[2];
                const u32x4 zr = (u32x4){0u, 0u, 0u, 0u};
#pragma unroll
                for (int q = 0; q < 2; ++q) { const size_t ro = (size_t)(r0 + q) * D + ch;
                    nB[q] = __builtin_nontemporal_load((const u32x4*)(S1 + ro)); nZ[q] = __builtin_nontemporal_load((const u32x4*)(S2 + ro)); nP[q] = *(const u32x4*)(S3 + ro);
                    nO[q] = (!head || r0 + q - (w - 1) >= 0) ? *(const u32x4*)(S3 + ro - (size_t)(w - 1) * D) : zr; }
                for (int gq = 0; gq < 8; ++gq) {
                    u32x4 cB[2], cZ[2], cP[2], cO[2];
#pragma unroll
                    for (int q = 0; q < 2; ++q) { cB[q] = nB[q]; cZ[q] = nZ[q]; cP[q] = nP[q]; cO[q] = nO[q]; }
                    if (gq < 7) {
#pragma unroll
                        for (int q = 0; q < 2; ++q) { const size_t ro = (size_t)(r0 + gq * 2 + 2 + q) * D + ch;
                            nB[q] = __builtin_nontemporal_load((const u32x4*)(S1 + ro)); nZ[q] = __builtin_nontemporal_load((const u32x4*)(S2 + ro)); nP[q] = *(const u32x4*)(S3 + ro);
                            nO[q] = (!head || r0 + gq * 2 + 2 + q - (w - 1) >= 0) ? *(const u32x4*)(S3 + ro - (size_t)(w - 1) * D) : zr; }
                    }
#pragma unroll
                    for (int q = 0; q < 2; ++q) {
                        const int t = r0 + gq * 2 + q;
                        const size_t ro = (size_t)t * D + ch;
                        f32x4 b0, b1, z0a, z0b, p0a, p0b, oa, ob;
                        up8(cB[q], b0, b1); up8(cZ[q], z0a, z0b); up8(cP[q], p0a, p0b); up8(cO[q], oa, ob);
                        const float ict = head ? 1.0f / (float)(t + 1 < w ? t + 1 : w) : ic;
                        sa += p0a; sb2 += p0b;
                        st8(S1 + ro, b0 * (w0a * z2a + w1a * z1a + w2a * z0a), b1 * (w0b * z2b + w1b * z1b + w2b * z0b));
                        st8(S0 + ro, sa * ict - p0a, sb2 * ict - p0b);
                        sa -= oa; sb2 -= ob;
                        z2a = z1a; z2b = z1b; z1a = z0a; z1b = z0b;
                        if (t >= MP - 2) { float* o = o_csp + (size_t)(t - (MP - 2)) * D + ch; *(f32x4*)o = z0a; *(f32x4*)(o + 4) = z0b; }
                        if (t >= MP - 15) { float* o = o_psp + (size_t)(t - (MP - 15)) * D + ch; *(f32x4*)o = p0a; *(f32x4*)(o + 4) = p0b; }
                    }
                }
            }
            if (wid == 0) {
                const int it = bc, gi = it & 3, ch = gi * 256 + (lane & 31) * 8, w = 2 << gi;
                const f32x4 w0a = *(const f32x4*)(cw + ch), w0b = *(const f32x4*)(cw + ch + 4);
                const f32x4 w1a = *(const f32x4*)(cw + D + ch), w1b = *(const f32x4*)(cw + D + ch + 4);
                const f32x4 w2a = *(const f32x4*)(cw + 2 * D + ch), w2b = *(const f32x4*)(cw + 2 * D + ch + 4);
                const int rs = (it >> 2) * 2 + (lane >> 5), sb = rs >> 4, t = rs & 15;
                const int cc = D + (ch >> 7) * 256 + (ch & 127);
                const float* pr = PROJS + (size_t)rs * DIN;
                const f32x4 b0 = *(const f32x4*)(pr + ch), b1 = *(const f32x4*)(pr + ch + 4);
                const f32x4 z0a = *(const f32x4*)(pr + cc) * *(const f32x4*)(pr + cc + 128), z0b = *(const f32x4*)(pr + cc + 4) * *(const f32x4*)(pr + cc + 132);
                const f32x4 p0a = *(const f32x4*)(pr + 3 * D + ch), p0b = *(const f32x4*)(pr + 3 * D + ch + 4);
                f32x4 z1a, z1b, z2a, z2b;
                if (t >= 1) { const float* q = pr - DIN; z1a = *(const f32x4*)(q + cc) * *(const f32x4*)(q + cc + 128); z1b = *(const f32x4*)(q + cc + 4) * *(const f32x4*)(q + cc + 132); }
                else { const float* q = cconv + ((size_t)sb * 2 + 1) * D + ch; z1a = *(const f32x4*)q; z1b = *(const f32x4*)(q + 4); }
                if (t >= 2) { const float* q = pr - 2 * DIN; z2a = *(const f32x4*)(q + cc) * *(const f32x4*)(q + cc + 128); z2b = *(const f32x4*)(q + cc + 4) * *(const f32x4*)(q + cc + 132); }
                else { const float* q = cconv + ((size_t)sb * 2 + t) * D + ch; z2a = *(const f32x4*)q; z2b = *(const f32x4*)(q + 4); }
                f32x4 sa = p0a, sb2 = p0b;
                {
#pragma unroll
                    for (int i0 = 1; i0 < 16; i0 += 5) {
                        f32x4 ha[5], hb[5];
#pragma unroll
                        for (int i = 0; i < 5; ++i) {
                            const int ii = i0 + i;
                            const float* q = (t - ii >= 0) ? pr - (size_t)ii * DIN + 3 * D + ch : cpool + ((size_t)sb * 15 + (15 + t - ii)) * D + ch;
                            ha[i] = *(const f32x4*)q; hb[i] = *(const f32x4*)(q + 4);
                        }
#pragma unroll
                        for (int i = 0; i < 5; ++i) { const float mk = (i0 + i < w) ? 1.f : 0.f; sa += ha[i] * mk; sb2 += hb[i] * mk; }
                    }
                }
                const float ic = 1.0f / (float)w;
                st8(YAS + (size_t)rs * D + ch, b0 * (w0a * z2a + w1a * z1a + w2a * z0a), b1 * (w0b * z2b + w1b * z1b + w2b * z0b));
                st8(DDS + (size_t)rs * D + ch, sa * ic - p0a, sb2 * ic - p0b);
                if (t >= SEQ_S - 2) { float* o = o_css + ((size_t)sb * 2 + (t - (SEQ_S - 2))) * D + ch; *(f32x4*)o = z0a; *(f32x4*)(o + 4) = z0b; }
                if (t >= 1) { float* o = o_pss + ((size_t)sb * 15 + (t - 1)) * D + ch; *(f32x4*)o = p0a; *(f32x4*)(o + 4) = p0b; }
            }
        } else {
            const int half = ph == 6 ? 0 : 1;
            const bf16_t* Y = half == 0 ? S5 : S0;
            const float* gpost = (half == 0 ? p.in[13] : p.in[17]) + (size_t)l * D;
            const float* gnext = half == 0 ? p.in[16] + (size_t)l * D : p.in[12] + (size_t)(l + 1 < NL ? l + 1 : l) * D;
            const bool from_input = (l == 0 && half == 0);
            const bool last = (l + 1 == NL && half == 1);
            bf16_t* XB = (bf16_t*)p.out;
            const bf16_t* xsrc = (l + 1 == NL && half == 1) ? S5 : XB;
            bf16_t* xdst = (l + 1 == NL && half == 0) ? S5 : XB;
            f32x4 gp[4], gn[4];
#pragma unroll
            for (int j = 0; j < 4; ++j) { gp[j] = *(const f32x4*)(gpost + lane * 4 + 256 * j); gn[j] = *(const f32x4*)(gnext + lane * 4 + 256 * j); }
            const int rbase = pm_t * 256 + mem_t * 64 + wid * 8;
            if (from_input) {
                for (int i0 = 0; i0 < 8; i0 += 2) {
                    f32x4 xn[2][4]; u32x2 yn[2][4];
#pragma unroll
                    for (int q = 0; q < 2; ++q)
#pragma unroll
                        for (int j = 0; j < 4; ++j) { const size_t o = (size_t)(rbase + i0 + q) * D + lane * 4 + 256 * j; xn[q][j] = __builtin_nontemporal_load((const f32x4*)(p.in[0] + o)); yn[q][j] = __builtin_nontemporal_load((const u32x2*)(Y + o)); }
#pragma unroll
                    for (int q = 0; q < 2; ++q) {
                        const int r = rbase + i0 + q;
                        f32x4 xv[4], yv[4];
#pragma unroll
                        for (int j = 0; j < 4; ++j) { xv[j] = xn[q][j]; yv[j][0] = bf_lo(yn[q][j].x); yv[j][1] = bf_hi(yn[q][j].x); yv[j][2] = bf_lo(yn[q][j].y); yv[j][3] = bf_hi(yn[q][j].y); }
                        norm_row_finish(xv, yv, gp, gn, nullptr, xdst + (size_t)r * D, S0 + (size_t)r * D, lane);
                    }
                }
            } else {
                for (int i0 = 0; i0 < 8; i0 += 4) {
                    u32x2 xnb[4][4], yn[4][4];
#pragma unroll
                    for (int q = 0; q < 4; ++q)
#pragma unroll
                        for (int j = 0; j < 4; ++j) { const size_t o = (size_t)(rbase + i0 + q) * D + lane * 4 + 256 * j; xnb[q][j] = __builtin_nontemporal_load((const u32x2*)(xsrc + o)); yn[q][j] = __builtin_nontemporal_load((const u32x2*)(Y + o)); }
#pragma unroll
                    for (int q = 0; q < 4; ++q) {
                        const int r = rbase + i0 + q;
                        f32x4 xv[4], yv[4];
#pragma unroll
                        for (int j = 0; j < 4; ++j) {
                            xv[j][0] = bf_lo(xnb[q][j].x); xv[j][1] = bf_hi(xnb[q][j].x); xv[j][2] = bf_lo(xnb[q][j].y); xv[j][3] = bf_hi(xnb[q][j].y);
                            yv[j][0] = bf_lo(yn[q][j].x); yv[j][1] = bf_hi(yn[q][j].x); yv[j][2] = bf_lo(yn[q][j].y); yv[j][3] = bf_hi(yn[q][j].y);
                        }
                        norm_row_finish(xv, yv, gp, gn, last ? X + (size_t)r * D : nullptr, xdst + (size_t)r * D, last ? nullptr : S0 + (size_t)r * D, lane);
                    }
                }
            }
            if (wid == 0 && bc < MS) {
                const int rs_ = bc;
                const float* xr = from_input ? p.in[1] + (size_t)rs_ * D : X + (size_t)(MP + rs_) * D;
                f32x4 xv[4], yv[4];
#pragma unroll
                for (int j = 0; j < 4; ++j) {
                    xv[j] = *(const f32x4*)(xr + lane * 4 + 256 * j);
                    const float* q = PROJS + (size_t)rs_ * D + lane * 4 + 256 * j;
                    yv[j] = (*(const f32x4*)q + *(const f32x4*)(q + MS * D)) + (*(const f32x4*)(q + 2 * MS * D) + *(const f32x4*)(q + 3 * MS * D));
                }
                norm_row_finish(xv, yv, gp, gn, X + (size_t)(MP + rs_) * D, nullptr, last ? nullptr : HS + (size_t)rs_ * D, lane);
            }
            if (half == 1 && l + 1 < NL) {
                LAS float* scr = (LAS float*)(lds + wid * 16384);
                int off = 0;
                transpose_matrix<true>(p.in[4] + (size_t)(l + 1) * D * DIN, D, DIN, WIN, 1, scr, gw, NGW, lane, off);
            }
        }
        if (step + 1 < p.nsteps) step_sync(ws + WS_BAR, bc, pm_t, step, step2, (p.pad && step + 1 > p.pad) ? step : step + 1);
    }
}

extern "C" void kernel_launch(void* const* d_in, const int* in_sizes, int n_in, void* d_out, int out_size, void* d_ws, size_t ws_size, hipStream_t stream) {
    static int grid = 0;
    if (grid == 0) {
        if (n_in != 18 || ws_size < WS_END) { fprintf(stderr, "kernel_launch: unexpected n_in %d or ws_size %zu (< %zu)\n", n_in, ws_size, (size_t)WS_END); grid = -1; return; }
        int dev = 0, cus = 0, per_cu = 0;
        hipGetDevice(&dev);
        hipDeviceGetAttribute(&cus, hipDeviceAttributeMultiprocessorCount, dev);
        if (hipFuncSetAttribute((const void*)fwd_megakernel, hipFuncAttributeMaxDynamicSharedMemorySize, LDS_BYTES) != hipSuccess) { fprintf(stderr, "kernel_launch: hipFuncSetAttribute failed\n"); grid = -1; return; }
        if (hipOccupancyMaxActiveBlocksPerMultiprocessor(&per_cu, (const void*)fwd_megakernel, 512, LDS_BYTES) != hipSuccess || per_cu < 1) { fprintf(stderr, "kernel_launch: occupancy query failed (%d)\n", per_cu); grid = -1; return; }
        grid = cus * per_cu;
    }
    if (grid < 0) return;
    Params p{};
    for (int i = 0; i < 18; ++i) p.in[i] = (const float*)d_in[i];
    p.out = (float*)d_out; p.ws = (unsigned char*)d_ws; p.nsteps = NL * 10 + (PROBE ? 1 : 0); p.pad = PROBE;
    void* args[] = {&p};
    hipError_t e = hipLaunchCooperativeKernel((const void*)fwd_megakernel, dim3(grid), dim3(512), args, LDS_BYTES, stream);
    if (e != hipSuccess) fprintf(stderr, "cooperative launch failed: %s (grid %d)\n", hipGetErrorString(e), grid);
}
```

```cpp
#include <hip/hip_runtime.h>
#include <hip/hip_cooperative_groups.h>
#include <cstdio>
namespace cg = cooperative_groups;

#ifndef SKELETON
#define SKELETON 0
#endif
#ifndef STOP_AFTER
#define STOP_AFTER 99
#endif
#ifndef PROBE
#define PROBE 0
#ifndef STAGGER_TICKS
#define STAGGER_TICKS 350
#endif
#endif
#ifndef SKEW_TICKS
#define SKEW_TICKS 0
#endif
#ifndef USE_CG_ONLY
#define USE_CG_ONLY 0
#endif

#define LAS __attribute__((address_space(3)))
typedef unsigned short bf16_t;
typedef short bf16x8 __attribute__((ext_vector_type(8)));
typedef float f32x4 __attribute__((ext_vector_type(4)));
typedef unsigned u32x4 __attribute__((ext_vector_type(4)));
typedef unsigned u32x2 __attribute__((ext_vector_type(2)));

constexpr int D = 1024, DIN = 6144, DFF = 4096, NL = 2;
constexpr int MP = 16384, MS = 128, MTOT = MP + MS, MPAD = MP;
constexpr int SEQ_S = 16, NB_S = 8, PAST = 2048;
constexpr int BM = 256, BK = 64, HALF = 128, HTB = HALF * BK * 2, STAGE_BYTES = 8 * HTB, NXCD = 8, WGM = 8;
constexpr int LDS_BYTES = STAGE_BYTES + 64;
constexpr float EPS = 1e-6f;

constexpr size_t SLOT = (size_t)MPAD * 1024 * 2;
constexpr size_t WS_WIN = 6 * SLOT;
constexpr size_t WIN_BYTES = (size_t)DIN * D * 2;
constexpr size_t WL_WC = 0, WL_WP = 2097152, WL_WO = 4194304, WL_POOL = 6291456, WL_UP = 6815744, WL_DOWN = 15204352, WL_BYTES = 23592960;
constexpr size_t WS_WL = WS_WIN + WIN_BYTES;
constexpr size_t WS_BAR = WS_WL + NL * WL_BYTES;
constexpr size_t CTL_BYTES = 49152, CTL_TCNT = 16384, CTL_GCNT = 32768, CTL_SCNT = 36864, CTL_XCNT = 45056;
constexpr size_t WS_SM = WS_BAR + CTL_BYTES;
constexpr size_t SM_PROJ = 0, SM_M1 = 3145728, SM_HS = 3670016, SM_YAS = 3932160, SM_DDS = 4194304, SM_YBS = 4456448, SM_MRG = 4718592, SM_US = 4980736, SM_BYTES = 6029312;
constexpr size_t WS_END = WS_SM + SM_BYTES;

constexpr size_t O_Y = 0, O_CSP = (size_t)MTOT * D, O_PSP = O_CSP + NL * 2 * D, O_CSS = O_PSP + NL * 15 * D, O_PSS = O_CSS + (size_t)NL * NB_S * 2 * D;

struct Params {
    const float* in[18];
    float* out;
    unsigned char* ws;
    int nsteps, pad;
};

__device__ __forceinline__ unsigned cvt_pk_bf16(float lo, float hi) { unsigned r; asm volatile("v_cvt_pk_bf16_f32 %0, %1, %2" : "=v"(r) : "v"(lo), "v"(hi)); return r; }
__device__ __forceinline__ float bf_lo(unsigned w) { return __uint_as_float(w << 16); }
__device__ __forceinline__ float bf_hi(unsigned w) { return __uint_as_float(w & 0xffff0000u); }
__device__ __forceinline__ void st16_wt(void* p, u32x4 w) { asm volatile("global_store_dwordx4 %0, %1, off sc1\n\ts_nop 1" :: "v"(p), "v"(w) : "memory"); }
__device__ __forceinline__ void st8_wt(void* p, u32x2 w) { asm volatile("global_store_dwordx2 %0, %1, off sc1\n\ts_nop 1" :: "v"(p), "v"(w) : "memory"); }
__device__ __forceinline__ void st8(bf16_t* p, f32x4 a, f32x4 b) {
    u32x4 w; w.x = cvt_pk_bf16(a[0], a[1]); w.y = cvt_pk_bf16(a[2], a[3]); w.z = cvt_pk_bf16(b[0], b[1]); w.w = cvt_pk_bf16(b[2], b[3]);
    st16_wt(p, w);
}
__device__ __forceinline__ void ld8(const bf16_t* p, f32x4& a, f32x4& b) {
    const u32x4 w = *(const u32x4*)p;
    a[0] = bf_lo(w.x); a[1] = bf_hi(w.x); a[2] = bf_lo(w.y); a[3] = bf_hi(w.y);
    b[0] = bf_lo(w.z); b[1] = bf_hi(w.z); b[2] = bf_lo(w.w); b[3] = bf_hi(w.w);
}
__device__ __forceinline__ void up8(u32x4 w, f32x4& a, f32x4& b) {
    a[0] = bf_lo(w.x); a[1] = bf_hi(w.x); a[2] = bf_lo(w.y); a[3] = bf_hi(w.y);
    b[0] = bf_lo(w.z); b[1] = bf_hi(w.z); b[2] = bf_lo(w.w); b[3] = bf_hi(w.w);
}
__device__ __forceinline__ float sigmoidf_(float x) { return __builtin_amdgcn_rcpf(1.0f + __expf(-x)); }
__device__ __forceinline__ float wave_sum(float v) {
#pragma unroll
    for (int o = 1; o < 64; o <<= 1) v += __shfl_xor(v, o);
    return v;
}
#define LDS_WAIT() asm volatile("s_waitcnt lgkmcnt(0)" ::: "memory")

#define XB_TMO      128
#define XB_XCNT(j)  (256  + 64 * (j))
#define XB_XSUB(j)  (1280 + 64 * (j))
#define XB_XGEN(j)  (2304 + 64 * (j))
#define XB_TOP      3328
#define XB_TOPGEN   3392
#define XCD_BAR_WORDS 3456
#define XB_SPIN_CAP (1u << 18)
__device__ __forceinline__ unsigned xb_ld(unsigned* p)              { return __hip_atomic_load(p, __ATOMIC_RELAXED, __HIP_MEMORY_SCOPE_AGENT); }
__device__ __forceinline__ unsigned xb_add(unsigned* p, unsigned v) { return __hip_atomic_fetch_add(p, v, __ATOMIC_RELAXED, __HIP_MEMORY_SCOPE_AGENT); }
__device__ __forceinline__ unsigned xb_xcc_id() { return (unsigned)__builtin_amdgcn_s_getreg((3 << 11) | 20) & 0xFu; }
#define XB_SPIN(cond, bar) do { unsigned _sp = 0; while (cond) { __builtin_amdgcn_s_sleep(1); \
    if ((++_sp & 255u) == 0u) { if (xb_ld(&(bar)[XB_TMO])) break; if (_sp > XB_SPIN_CAP) { atomicAdd(&(bar)[XB_TMO], 1u); break; } } } } while (0)
struct XcdBarrier { unsigned* bar; unsigned x; volatile LAS unsigned* st; };
__device__ __forceinline__ XcdBarrier xcd_barrier_post(unsigned* bar, volatile LAS unsigned* st) {
    XcdBarrier b; b.bar = bar; b.x = xb_xcc_id(); b.st = st;
    if (threadIdx.x == 0) (void)xb_add(&bar[XB_XCNT(b.x)], 1u);
    return b;
}
__device__ __forceinline__ void xcd_barrier_complete(unsigned* bar, unsigned x, unsigned& nloc, unsigned& nx) {
    const unsigned G = gridDim.x * gridDim.y * gridDim.z;
    unsigned sum, cnt, mine, sp = 0u;
    for (;;) {
        sum = 0u; cnt = 0u; mine = 0u;
#pragma unroll
        for (unsigned j = 0; j < 16; ++j) { const unsigned c = xb_ld(&bar[XB_XCNT(j)]); sum += c; cnt += (c > 0u) ? 1u : 0u; mine = (j == x) ? c : mine; }
        if (sum == G) break;
        __builtin_amdgcn_s_sleep(1);
        if ((++sp & 255u) == 0u) { if (xb_ld(&bar[XB_TMO])) break; if (sp > XB_SPIN_CAP) { atomicAdd(&bar[XB_TMO], 1u); break; } }
    }
    nloc = mine > 0u ? mine : 1u; nx = cnt > 0u ? cnt : 1u;
}
__device__ __forceinline__ void xcd_barrier(const XcdBarrier& b) {
    asm volatile("s_waitcnt vmcnt(0)" ::: "memory");
    __syncthreads();
    if (threadIdx.x == 0) {
        unsigned* bar = b.bar;
        __builtin_amdgcn_s_waitcnt(0);
        unsigned nloc = b.st[0], nx = b.st[1];
        if (nloc == 0u) { xcd_barrier_complete(bar, b.x, nloc, nx); b.st[0] = nloc; b.st[1] = nx; }
        const unsigned old = xb_add(&bar[XB_XSUB(b.x)], 1u);
        const unsigned gen = old / nloc;
        if (old + 1u == (gen + 1u) * nloc) {
            __builtin_amdgcn_fence(__ATOMIC_RELEASE, "agent");
            asm volatile("s_waitcnt vmcnt(0)" ::: "memory");
            const unsigned og = xb_add(&bar[XB_TOP], 1u);
            const unsigned tg = og / nx;
            if (og + 1u == (tg + 1u) * nx) xb_add(&bar[XB_TOPGEN], 1u);
            else XB_SPIN(xb_ld(&bar[XB_TOPGEN]) == tg, bar);
            __builtin_amdgcn_fence(__ATOMIC_ACQUIRE, "agent");
            xb_add(&bar[XB_XGEN(b.x)], 1u);
            asm volatile("s_waitcnt vmcnt(0)" ::: "memory");
        } else {
            XB_SPIN(xb_ld(&bar[XB_XGEN(b.x)]) == gen, bar);
            __builtin_amdgcn_fence(__ATOMIC_ACQUIRE, "agent");
            asm volatile("s_waitcnt vmcnt(0)" ::: "memory");
        }
    }
    __syncthreads();
}

__device__ __forceinline__ int lds_byte(int r, int c) { const int st = (r >> 4) * 2 + (c >> 5), rr = r & 15, cc = c & 31, ob = rr * 64 + cc * 2; return st * 1024 + (ob ^ (((ob >> 9) & 1) << 5)); }
__device__ __forceinline__ void stage_rc(int b, int& R, int& C) { const int st = b / 1024, sb = b % 1024, swz = sb ^ (((sb >> 9) & 1) << 5); R = (st >> 1) * 16 + swz / 64; C = (st & 1) * 32 + (swz % 64) / 2; }
__device__ __forceinline__ int perm32(int rho) { const int n = rho >> 4, i = rho & 15; return 8 * (i >> 2) + 4 * n + (i & 3); }

struct Unit { int pm, pn; };
struct Gemm { const bf16_t* A; const bf16_t* Bt; int lda, ldb, K, nM, nN, a_pn_off, a_wrap_shift; size_t a_wrap_stride; };
struct StaticOrder {
    int nM, nN, nwg, G, c;
    __device__ void init(int nM_, int nN_, int G_, int c_) { nM = nM_; nN = nN_; nwg = nM * nN; G = G_; c = c_; }
    __device__ bool next(int i, Unit& u) const {
        const long L = (long)i * G + c; if (L >= nwg) return false;
        int wgid = (int)L; { const int q = nwg / NXCD, r = nwg % NXCD, xcd = wgid % NXCD, off = wgid / NXCD; wgid = (xcd < r ? xcd * (q + 1) : r * (q + 1) + (xcd - r) * q) + off; }
        const int nig = WGM * nN, gid = wgid / nig, fm = gid * WGM, gsz = (nM - fm) < WGM ? (nM - fm) : WGM;
        u.pm = fm + ((wgid % nig) % gsz); u.pn = (wgid % nig) / gsz; return true;
    }
};

enum { E_PROJ = 0, E_SCALE = 1, E_GATE = 2, E_GATEADD = 3, E_PLAIN = 4, E_RELU2 = 5 };
struct Epi { int id, ldc; bf16_t* o0; const bf16_t* x0; const bf16_t* x1; const float* vec; unsigned char* ws; };

__device__ __forceinline__ void epilogue(const Epi& E, const f32x4 (&acc)[2][2][4][2], const Unit& u) {
    int tl = threadIdx.x; asm volatile("" : "+v"(tl));
    const int wv = tl >> 6, ln = tl & 63, wr = wv >> 2, wc = wv & 3, fr = ln & 15, fq = ln >> 4;
    if (E.id == 99) return;
    const int row0 = u.pm * BM + wr * 64 + fr;
    const int colw = wc * 32 + 8 * fq;
    if (E.id == E_PROJ) {
        if (u.pn >= 4 && u.pn < 12) {
            const int ch = (u.pn - 4) * 128 + colw;
#pragma unroll
            for (int ai = 0; ai < 2; ++ai)
#pragma unroll
                for (int m = 0; m < 4; ++m) {
                    const size_t r = (size_t)(row0 + ai * HALF + m * 16);
                    st8((bf16_t*)(E.ws + 2 * SLOT) + r * D + ch, acc[ai][0][m][0] * acc[ai][1][m][0], acc[ai][0][m][1] * acc[ai][1][m][1]);
                }
        } else if (u.pn >= 16) {
            const int gc0 = (u.pn - 16) * BM;
            bf16_t* O = (bf16_t*)(E.ws + (gc0 < D ? 4 : 5) * SLOT);
            const int oc0 = gc0 & (D - 1);
#pragma unroll
            for (int bj = 0; bj < 2; ++bj) {
                const f32x4 b0 = *(const f32x4*)(E.vec + gc0 + bj * HALF + colw), b1 = *(const f32x4*)(E.vec + gc0 + bj * HALF + colw + 4);
#pragma unroll
                for (int ai = 0; ai < 2; ++ai)
#pragma unroll
                    for (int m = 0; m < 4; ++m) {
                        const size_t r = (size_t)(row0 + ai * HALF + m * 16);
                        f32x4 v0 = acc[ai][bj][m][0] + b0, v1 = acc[ai][bj][m][1] + b1;
#pragma unroll
                        for (int j = 0; j < 4; ++j) { v0[j] = sigmoidf_(v0[j]); v1[j] = sigmoidf_(v1[j]); }
                        st8(O + r * D + oc0 + bj * HALF + colw, v0, v1);
                    }
            }
        } else {
            bf16_t* O = (bf16_t*)(E.ws + (u.pn < 4 ? 1 : 3) * SLOT);
            const int oc0 = (u.pn & 3) * BM;
#pragma unroll
            for (int ai = 0; ai < 2; ++ai)
#pragma unroll
                for (int m = 0; m < 4; ++m) {
                    const size_t r = (size_t)(row0 + ai * HALF + m * 16);
#pragma unroll
                    for (int bj = 0; bj < 2; ++bj) st8(O + r * D + oc0 + bj * HALF + colw, acc[ai][bj][m][0], acc[ai][bj][m][1]);
                }
        }
        return;
    }
    const int col0 = u.pn * BM + colw;
    if (E.id == E_SCALE) {
#pragma unroll
        for (int bj = 0; bj < 2; ++bj) {
            const f32x4 s0 = *(const f32x4*)(E.vec + col0 + bj * HALF), s1 = *(const f32x4*)(E.vec + col0 + bj * HALF + 4);
#pragma unroll
            for (int ai = 0; ai < 2; ++ai)
#pragma unroll
                for (int m = 0; m < 4; ++m) {
                    const size_t r = (size_t)(row0 + ai * HALF + m * 16);
                    st8(E.o0 + r * E.ldc + col0 + bj * HALF, acc[ai][bj][m][0] * s0, acc[ai][bj][m][1] * s1);
                }
        }
    } else if (E.id == E_GATE) {
#pragma unroll
        for (int ai = 0; ai < 2; ++ai) {
            u32x4 gr[4][2];
#pragma unroll
            for (int m = 0; m < 4; ++m)
#pragma unroll
                for (int bj = 0; bj < 2; ++bj) gr[m][bj] = __builtin_nontemporal_load((const u32x4*)(E.x0 + (size_t)(row0 + ai * HALF + m * 16) * D + col0 + bj * HALF));
#pragma unroll
            for (int m = 0; m < 4; ++m) {
                const size_t r = (size_t)(row0 + ai * HALF + m * 16);
#pragma unroll
                for (int bj = 0; bj < 2; ++bj) {
                    f32x4 g0, g1; up8(gr[m][bj], g0, g1);
                    st8(E.o0 + r * E.ldc + col0 + bj * HALF, acc[ai][bj][m][0] * g0, acc[ai][bj][m][1] * g1);
                }
            }
        }
    } else if (E.id == E_GATEADD) {
#pragma unroll
        for (int ai = 0; ai < 2; ++ai) {
            u32x4 gr[4][2], ar[4][2];
#pragma unroll
            for (int m = 0; m < 4; ++m)
#pragma unroll
                for (int bj = 0; bj < 2; ++bj) {
                    const size_t o = (size_t)(row0 + ai * HALF + m * 16) * D + col0 + bj * HALF;
                    gr[m][bj] = __builtin_nontemporal_load((const u32x4*)(E.x0 + o)); ar[m][bj] = __builtin_nontemporal_load((const u32x4*)(E.x1 + o));
                }
#pragma unroll
            for (int m = 0; m < 4; ++m) {
                const size_t r = (size_t)(row0 + ai * HALF + m * 16);
#pragma unroll
                for (int bj = 0; bj < 2; ++bj) {
                    f32x4 g0, g1, a0, a1; up8(gr[m][bj], g0, g1); up8(ar[m][bj], a0, a1);
                    st8(E.o0 + r * E.ldc + col0 + bj * HALF, a0 + acc[ai][bj][m][0] * g0, a1 + acc[ai][bj][m][1] * g1);
                }
            }
        }
    } else if (E.id == E_RELU2) {
        bf16_t* O = (bf16_t*)(E.ws + (size_t)(1 + (u.pn >> 2)) * SLOT) + (u.pn & 3) * BM + colw;
#pragma unroll
        for (int ai = 0; ai < 2; ++ai)
#pragma unroll
            for (int m = 0; m < 4; ++m) {
                const size_t r = (size_t)(row0 + ai * HALF + m * 16);
#pragma unroll
                for (int bj = 0; bj < 2; ++bj) {
                    f32x4 v0 = acc[ai][bj][m][0], v1 = acc[ai][bj][m][1];
#pragma unroll
                    for (int j = 0; j < 4; ++j) { const float a = fmaxf(v0[j], 0.f), b = fmaxf(v1[j], 0.f); v0[j] = a * a; v1[j] = b * b; }
                    st8(O + r * D + bj * HALF, v0, v1);
                }
            }
    } else {
#pragma unroll
        for (int ai = 0; ai < 2; ++ai)
#pragma unroll
            for (int m = 0; m < 4; ++m) {
                const size_t r = (size_t)(row0 + ai * HALF + m * 16);
#pragma unroll
                for (int bj = 0; bj < 2; ++bj) st8(E.o0 + r * E.ldc + col0 + bj * HALF, acc[ai][bj][m][0], acc[ai][bj][m][1]);
            }
    }
}

__device__ __forceinline__ void gemm_phase(LAS unsigned char* lds, const Gemm g, const StaticOrder& S, const Epi& E) {
    const int tid = threadIdx.x, wid = __builtin_amdgcn_readfirstlane(tid >> 6), lane = tid & 63, wr = wid >> 2, wc = wid & 3, fr = lane & 15, fq = lane >> 4;
    const int nt = g.K / BK;
    unsigned voffA[2], voffB[2];
#pragma unroll
    for (int i = 0; i < 2; ++i) { int R, C; stage_rc(tid * 16 + i * 8192, R, C); const int Rb = (R & ~31) + perm32(R & 31);
        voffA[i] = (unsigned)(R * g.lda + C) * 2u; voffB[i] = (unsigned)(Rb * g.ldb + C) * 2u; }
    const size_t kstep = (size_t)(BK * 2);
    const size_t hstepA = (size_t)HALF * g.lda * 2, hstepB = (size_t)HALF * g.ldb * 2;
    const size_t tstepA = 2 * hstepA, tstepB = 2 * hstepB;
    const size_t pnoffA = (size_t)g.a_pn_off * 2;
    const int wsh = g.a_wrap_shift, wmask = (1 << wsh) - 1; const size_t wstride = g.a_wrap_stride;
#define PG8_AOFF(t) ((size_t)((t) >> wsh) * wstride + (size_t)((t) & wmask) * kstep)
    const unsigned ldsw = (unsigned)wid * 1024u;
    const int aoff = lds_byte(wr * 64 + fr, fq * 8), boff = lds_byte(wc * 32 + fr, fq * 8);
#define PG8_SA(b, h) (((b) * 2 + (h)) * HTB)
#define PG8_SB(b, h) ((4 + (b) * 2 + (h)) * HTB)
#define PG8_STAGE(bufoff, gbase, voff) do { _Pragma("unroll") for (int _i = 0; _i < 2; ++_i) \
        __builtin_amdgcn_global_load_lds((const unsigned*)((const char*)(gbase) + (voff)[_i]), (LAS unsigned*)(lds + (bufoff) + ldsw + _i * 8192), 16, 0, 0); } while (0)
#define PG8_LDA(dst, b, h) do { _Pragma("unroll") for (int m = 0; m < 4; ++m) _Pragma("unroll") for (int k = 0; k < 2; ++k) dst[m][k] = *(const LAS bf16x8*)(lds + PG8_SA(b, h) + aoff + m * 2048 + k * 1024); } while (0)
#define PG8_LDB(dst, b, h) do { _Pragma("unroll") for (int n = 0; n < 2; ++n) _Pragma("unroll") for (int k = 0; k < 2; ++k) dst[n][k] = *(const LAS bf16x8*)(lds + PG8_SB(b, h) + boff + n * 2048 + k * 1024); } while (0)
#define PG8_MMA(ai, bj, At, Bt) do { __builtin_amdgcn_s_setprio(1); _Pragma("unroll") for (int m = 0; m < 4; ++m) _Pragma("unroll") for (int n = 0; n < 2; ++n) _Pragma("unroll") for (int k = 0; k < 2; ++k) \
        acc[ai][bj][m][n] = __builtin_amdgcn_mfma_f32_16x16x32_bf16(Bt[n][k], At[m][k], acc[ai][bj][m][n], 0, 0, 0); __builtin_amdgcn_s_setprio(0); } while (0)
#define PG8_WAIT_V(n) asm volatile("s_waitcnt vmcnt(" #n ")" ::: "memory")
#define PG8_WAIT_L(n) asm volatile("s_waitcnt lgkmcnt(" #n ")" ::: "memory")
#define PG8_BAR __builtin_amdgcn_s_barrier()
#define PG8_SCHED __builtin_amdgcn_sched_barrier(0)
    Unit cur, nxt; int ui = 0;
    if (!S.next(0, cur)) return;
    f32x4 acc[2][2][4][2];
#pragma unroll
    for (int a = 0; a < 2; ++a)
#pragma unroll
        for (int b = 0; b < 2; ++b)
#pragma unroll
            for (int m = 0; m < 4; ++m)
#pragma unroll
                for (int n = 0; n < 2; ++n) acc[a][b][m][n] = (f32x4){0.f, 0.f, 0.f, 0.f};
    bf16x8 At[4][2], B0[2][2], B1[2][2];
    const char* cA = (const char*)g.A + (size_t)cur.pm * tstepA + (size_t)cur.pn * pnoffA; const char* cB = (const char*)g.Bt + (size_t)cur.pn * tstepB;
    PG8_STAGE(PG8_SB(0, 0), cB, voffB); PG8_STAGE(PG8_SA(0, 0), cA, voffA); PG8_STAGE(PG8_SB(0, 1), cB + hstepB, voffB); PG8_STAGE(PG8_SA(0, 1), cA + hstepA, voffA);
    if (wr == 1) PG8_BAR;
    PG8_WAIT_V(4); PG8_BAR;
    PG8_STAGE(PG8_SB(1, 0), cB + kstep, voffB); PG8_STAGE(PG8_SA(1, 0), cA + kstep, voffA); PG8_STAGE(PG8_SB(1, 1), cB + hstepB + kstep, voffB);
    PG8_WAIT_V(6); PG8_BAR;
    for (;;) {
        const bool has_next = S.next(ui + 1, nxt);
        const char* nA = has_next ? (const char*)g.A + (size_t)nxt.pm * tstepA + (size_t)nxt.pn * pnoffA : cA; const char* nB = has_next ? (const char*)g.Bt + (size_t)nxt.pn * tstepB : cB;
        for (int t = 0; t < nt; t += 2) {
            const bool last = (t == nt - 2);
            const char* a1 = cA + PG8_AOFF(t + 1);
            const char* a2 = last ? nA : cA + PG8_AOFF(t + 2); const char* b2 = last ? nB : cB + (size_t)(t + 2) * kstep;
            const char* a3 = last ? nA + kstep : cA + PG8_AOFF(t + 3); const char* b3 = b2 + kstep;
            PG8_LDB(B0, 0, 0); PG8_SCHED; PG8_LDA(At, 0, 0); PG8_STAGE(PG8_SA(1, 1), a1 + hstepA, voffA);
            PG8_WAIT_L(8); PG8_BAR; PG8_WAIT_L(0); PG8_MMA(0, 0, At, B0); PG8_BAR; PG8_SCHED;
            PG8_LDB(B1, 0, 1); PG8_STAGE(PG8_SB(0, 0), b2, voffB);
            PG8_BAR; PG8_WAIT_L(0); PG8_MMA(0, 1, At, B1); PG8_BAR;
            PG8_LDA(At, 0, 1); PG8_STAGE(PG8_SA(0, 0), a2, voffA);
            PG8_BAR; PG8_WAIT_L(0); PG8_MMA(1, 0, At, B0); PG8_BAR; PG8_SCHED;
            PG8_STAGE(PG8_SB(0, 1), b2 + hstepB, voffB);
            PG8_WAIT_V(6); PG8_BAR; PG8_MMA(1, 1, At, B1); PG8_BAR;
            PG8_LDB(B0, 1, 0); PG8_SCHED; PG8_LDA(At, 1, 0); PG8_STAGE(PG8_SA(0, 1), a2 + hstepA, voffA);
            PG8_WAIT_L(8); PG8_BAR; PG8_WAIT_L(0); PG8_MMA(0, 0, At, B0); PG8_BAR; PG8_SCHED;
            PG8_LDB(B1, 1, 1); PG8_STAGE(PG8_SB(1, 0), b3, voffB);
            PG8_BAR; PG8_WAIT_L(0); PG8_MMA(0, 1, At, B1); PG8_BAR;
            PG8_LDA(At, 1, 1); PG8_STAGE(PG8_SA(1, 0), a3, voffA);
            PG8_BAR; PG8_WAIT_L(0); PG8_MMA(1, 0, At, B0); PG8_BAR; PG8_SCHED;
            PG8_STAGE(PG8_SB(1, 1), b3 + hstepB, voffB);
            PG8_WAIT_V(6); PG8_BAR; PG8_MMA(1, 1, At, B1); PG8_BAR;
        }
        epilogue(E, acc, cur);
        if (!has_next) break;
#pragma unroll
        for (int a = 0; a < 2; ++a)
#pragma unroll
            for (int b = 0; b < 2; ++b)
#pragma unroll
                for (int m = 0; m < 4; ++m)
#pragma unroll
                    for (int n = 0; n < 2; ++n) acc[a][b][m][n] = (f32x4){0.f, 0.f, 0.f, 0.f};
        cur = nxt; cA = nA; cB = nB; ++ui;
    }
    PG8_WAIT_V(0);
    if (wr == 0) PG8_BAR;
    PG8_BAR;
#undef PG8_AOFF
#undef PG8_SA
#undef PG8_SB
#undef PG8_STAGE
#undef PG8_LDA
#undef PG8_LDB
#undef PG8_MMA
#undef PG8_WAIT_V
#undef PG8_WAIT_L
#undef PG8_BAR
#undef PG8_SCHED
}

__device__ __forceinline__ int win_dst_row(int n0) {
    if (n0 < D || n0 >= 3 * D) return n0;
    const int isv = n0 >= 2 * D, ch = n0 - (isv ? 2 * D : D);
    return D + (ch >> 7) * 256 + isv * 128 + (ch & 127);
}
struct TrItem { const float* W; bf16_t* WT; int K, N, wperm, item; };
__device__ __forceinline__ void tr_load(const TrItem& t, float (&wv)[32], int lane) {
    const int nblk = t.N / 32, kb = t.item / nblk, nb = t.item % nblk, k0 = 64 * kb, n0 = 32 * nb;
#pragma unroll
    for (int i = 0; i < 32; ++i) wv[i] = __builtin_nontemporal_load(t.W + (size_t)(k0 + 2 * i + (lane >> 5)) * t.N + n0 + (lane & 31));
}
template <bool WT_STORE> __device__ __forceinline__ void tr_finish(const TrItem& t, const float (&wv)[32], LAS float* scr, int lane) {
    const int nblk = t.N / 32, kb = t.item / nblk, nb = t.item % nblk, k0 = 64 * kb, n0 = 32 * nb;
#pragma unroll
    for (int i = 0; i < 32; ++i) scr[(2 * i + (lane >> 5)) * 33 + (lane & 31)] = wv[i];
    LDS_WAIT(); asm volatile("" ::: "memory");
    const int c = lane & 7;
    const int drow0 = t.wperm ? win_dst_row(n0) : n0;
#pragma unroll
    for (int j = 0; j < 4; ++j) { const int n = (lane >> 3) + 8 * j; const LAS float* s = scr + (8 * c) * 33 + n;
        u32x4 o; o.x = cvt_pk_bf16(s[0 * 33], s[1 * 33]); o.y = cvt_pk_bf16(s[2 * 33], s[3 * 33]); o.z = cvt_pk_bf16(s[4 * 33], s[5 * 33]); o.w = cvt_pk_bf16(s[6 * 33], s[7 * 33]);
        if (WT_STORE) st16_wt(t.WT + (size_t)(drow0 + n) * t.K + k0 + 8 * c, o); else *(u32x4*)(t.WT + (size_t)(drow0 + n) * t.K + k0 + 8 * c) = o; }
    LDS_WAIT(); asm volatile("" ::: "memory");
}
template <bool WT_STORE> __device__ __forceinline__ void transpose_item(const float* W, int K, int N, bf16_t* WT, int wperm, LAS float* scr, int item, int lane) {
    const TrItem t{W, WT, K, N, wperm, item}; float wv[32]; tr_load(t, wv, lane); tr_finish<WT_STORE>(t, wv, scr, lane);
}
constexpr int TR_L = 3 * 512 + 128 + 2 * 2048, TR_TOTAL = 3072 + NL * TR_L, TR_P0 = 3072 + TR_L;
__device__ __forceinline__ TrItem tr_decode(const Params& p, unsigned char* ws, int idx) {
    if (idx < 3072) return TrItem{p.in[4], (bf16_t*)(ws + WS_WIN), D, DIN, 1, idx};
    idx -= 3072; const int l = idx / TR_L; int r = idx - l * TR_L;
    unsigned char* wl = ws + WS_WL + (size_t)l * WL_BYTES;
    if (r < 512) return TrItem{p.in[7] + (size_t)l * D * D, (bf16_t*)(wl + WL_WC), D, D, 0, r}; r -= 512;
    if (r < 512) return TrItem{p.in[10] + (size_t)l * D * D, (bf16_t*)(wl + WL_WP), D, D, 0, r}; r -= 512;
    if (r < 512) return TrItem{p.in[11] + (size_t)l * D * D, (bf16_t*)(wl + WL_WO), D, D, 0, r}; r -= 512;
    if (r < 128) { const int gi = r >> 5; return TrItem{p.in[8] + (size_t)l * 4 * 65536 + (size_t)gi * 65536, (bf16_t*)(wl + WL_POOL) + (size_t)gi * 65536, 256, 256, 0, r & 31}; } r -= 128;
    if (r < 2048) return TrItem{p.in[14] + (size_t)l * D * DFF, (bf16_t*)(wl + WL_UP), D, DFF, 0, r}; r -= 2048;
    return TrItem{p.in[15] + (size_t)l * DFF * D, (bf16_t*)(wl + WL_DOWN), DFF, D, 0, r};
}
template <bool WT_STORE> __device__ __forceinline__ void transpose_matrix(const float* W, int K, int N, bf16_t* WT, int wperm, LAS float* scr, int gw, int NGW, int lane, int& off) {
    const int nitems = (K / 64) * (N / 32);
    int start = gw - (off % NGW); if (start < 0) start += NGW;
    for (int it = start; it < nitems; it += NGW) transpose_item<WT_STORE>(W, K, N, WT, wperm, scr, it, lane);
    off += nitems;
}

enum { SE_F32 = 0, SE_SCALE = 1, SE_GATE = 2, SE_GATEADD = 3, SE_RELU2 = 4 };
struct SkGemm { int emode, lda, ldb, ldc, nCB, K, cbPerGrp, grpK, nKS; const bf16_t* A; const bf16_t* Bt; void* C; const float* projs; const float* vec; float* m1; };
__device__ __forceinline__ void skinny_gemm(LAS unsigned char* lds, const SkGemm& g, int task0, int tstride) {
    int tl = threadIdx.x; asm volatile("" : "+v"(tl));
    const int lane = tl & 63, wid = tl >> 6, fr = lane & 15, fq = lane >> 4;
    const int kw = g.K >> 3, nks = kw >> 5;
    for (int t = task0; t < g.nCB * g.nKS; t += tstride) {
        const int cb = t % g.nCB, ksl = t / g.nCB;
        const int kB = ksl * g.K + wid * kw, kA = kB + (cb / g.cbPerGrp) * g.grpK;
        f32x4 acc[8][2];
#pragma unroll
        for (int rb = 0; rb < 8; ++rb) { acc[rb][0] = (f32x4){0.f, 0.f, 0.f, 0.f}; acc[rb][1] = acc[rb][0]; }
        const bf16_t* bp = g.Bt + (size_t)(cb * 32 + fr) * g.ldb + kB + fq * 8;
        const bf16_t* ap = g.A + (size_t)fr * g.lda + kA + fq * 8;
        for (int ks = 0; ks < nks; ks += 2) {
            const bool two = ks + 1 < nks;
            bf16x8 a0[8], a1[8], b00, b01, b10, b11;
            b00 = *(const bf16x8*)(bp + ks * 32); b01 = *(const bf16x8*)(bp + (size_t)16 * g.ldb + ks * 32);
#pragma unroll
            for (int rb = 0; rb < 8; ++rb) a0[rb] = *(const bf16x8*)(ap + (size_t)rb * 16 * g.lda + ks * 32);
            if (two) {
                b10 = *(const bf16x8*)(bp + ks * 32 + 32); b11 = *(const bf16x8*)(bp + (size_t)16 * g.ldb + ks * 32 + 32);
#pragma unroll
                for (int rb = 0; rb < 8; ++rb) a1[rb] = *(const bf16x8*)(ap + (size_t)rb * 16 * g.lda + ks * 32 + 32);
            }
#pragma unroll
            for (int rb = 0; rb < 8; ++rb) {
                acc[rb][0] = __builtin_amdgcn_mfma_f32_16x16x32_bf16(b00, a0[rb], acc[rb][0], 0, 0, 0);
                acc[rb][1] = __builtin_amdgcn_mfma_f32_16x16x32_bf16(b01, a0[rb], acc[rb][1], 0, 0, 0);
            }
            if (two) {
#pragma unroll
                for (int rb = 0; rb < 8; ++rb) {
                    acc[rb][0] = __builtin_amdgcn_mfma_f32_16x16x32_bf16(b10, a1[rb], acc[rb][0], 0, 0, 0);
                    acc[rb][1] = __builtin_amdgcn_mfma_f32_16x16x32_bf16(b11, a1[rb], acc[rb][1], 0, 0, 0);
                }
            }
        }
#pragma unroll
        for (int rb = 0; rb < 8; ++rb)
#pragma unroll
            for (int c2 = 0; c2 < 2; ++c2) *(LAS f32x4*)(lds + wid * 16384 + ((rb * 2 + c2) * 64 + lane) * 16) = acc[rb][c2];
        __syncthreads();
#pragma unroll
        for (int h = 0; h < 2; ++h) {
            const int q = tl + h * 512, i = q >> 6, ls = q & 63;
            f32x4 v = *(const LAS f32x4*)(lds + q * 16);
#pragma unroll
            for (int w = 1; w < 8; ++w) v += *(const LAS f32x4*)(lds + w * 16384 + q * 16);
            const int row = (i >> 1) * 16 + (ls & 15), col = cb * 32 + (i & 1) * 16 + 4 * (ls >> 4);
            if (g.emode == SE_F32) st16_wt((float*)g.C + (size_t)ksl * 128 * g.ldc + (size_t)row * g.ldc + col, __builtin_bit_cast(u32x4, v));
            else if (g.emode == SE_GATE || g.emode == SE_GATEADD) {
                const int go = g.emode == SE_GATE ? 0 : D;
                f32x4 gt = *(const f32x4*)(g.projs + (size_t)row * DIN + 4 * D + go + col) + *(const f32x4*)(g.vec + go + col);
#pragma unroll
                for (int j = 0; j < 4; ++j) gt[j] = sigmoidf_(gt[j]);
                if (g.emode == SE_GATE) st16_wt(g.m1 + (size_t)row * D + col, __builtin_bit_cast(u32x4, gt * v));
                else { const f32x4 o = *(const f32x4*)(g.m1 + (size_t)row * D + col) + gt * v;
                    u32x2 w2; w2.x = cvt_pk_bf16(o[0], o[1]); w2.y = cvt_pk_bf16(o[2], o[3]); st8_wt((bf16_t*)g.C + (size_t)row * g.ldc + col, w2); }
            } else {
                f32x4 o;
                if (g.emode == SE_SCALE) o = v * *(const f32x4*)(g.vec + col);
                else {
#pragma unroll
                    for (int j = 0; j < 4; ++j) { const float u = fmaxf(v[j], 0.f); o[j] = u * u; }
                }
                u32x2 w2; w2.x = cvt_pk_bf16(o[0], o[1]); w2.y = cvt_pk_bf16(o[2], o[3]); st8_wt((bf16_t*)g.C + (size_t)row * g.ldc + col, w2);
            }
        }
        __syncthreads();
    }
}

__device__ __forceinline__ void norm_row_finish(f32x4 (&xv)[4], const f32x4 (&yv)[4], const f32x4 (&gp)[4], const f32x4 (&gn)[4], float* xo, bf16_t* xob, bf16_t* ho, int lane) {
    float s = 0.f;
#pragma unroll
    for (int j = 0; j < 4; ++j) s += (yv[j][0] * yv[j][0] + yv[j][1] * yv[j][1]) + (yv[j][2] * yv[j][2] + yv[j][3] * yv[j][3]);
    const float rs = rsqrtf(wave_sum(s) * (1.f / D) + EPS);
    float s2 = 0.f;
#pragma unroll
    for (int j = 0; j < 4; ++j) { xv[j] = xv[j] + yv[j] * rs * gp[j]; s2 += (xv[j][0] * xv[j][0] + xv[j][1] * xv[j][1]) + (xv[j][2] * xv[j][2] + xv[j][3] * xv[j][3]);
        if (xo) st16_wt(xo + lane * 4 + 256 * j, __builtin_bit_cast(u32x4, xv[j]));
        else { u32x2 o; o.x = cvt_pk_bf16(xv[j][0], xv[j][1]); o.y = cvt_pk_bf16(xv[j][2], xv[j][3]); st8_wt(xob + lane * 4 + 256 * j, o); } }
    if (ho) {
        const float rs2 = rsqrtf(wave_sum(s2) * (1.f / D) + EPS);
#pragma unroll
        for (int j = 0; j < 4; ++j) { u32x2 o; o.x = cvt_pk_bf16(xv[j][0] * rs2 * gn[j][0], xv[j][1] * rs2 * gn[j][1]); o.y = cvt_pk_bf16(xv[j][2] * rs2 * gn[j][2], xv[j][3] * rs2 * gn[j][3]);
            st8_wt(ho + lane * 4 + 256 * j, o); }
    }
}

#define SPIN_UNTIL(cond, tmo) do { unsigned _sp = 0; while (!(cond)) { __builtin_amdgcn_s_sleep(1); if (++_sp > (1u << 21)) { atomicAdd((tmo), 1u); break; } } } while (0)
__device__ __forceinline__ int sample_blocks(int ph) { return ph == 0 ? 192 : ph == 1 ? 256 : ph == 2 ? 64 : ph == 3 ? 0 : ph == 4 ? 32 : 128; }
__device__ __forceinline__ void step_sync(unsigned char* ctl, int b, int pm, int k, int ls, int nls) {
    asm volatile("s_waitcnt vmcnt(0)" ::: "memory");
    __syncthreads();
    if (threadIdx.x == 0) {
        unsigned* tcnt = (unsigned*)(ctl + CTL_TCNT); unsigned* gcnt = (unsigned*)(ctl + CTL_GCNT); unsigned* scnt = (unsigned*)(ctl + CTL_SCNT); unsigned* tmo = (unsigned*)(ctl) + XB_TMO;
        const int ph = ls % 10, nph = nls % 10;
        if (b < sample_blocks(ph)) (void)xb_add(scnt + 64 * k, 1u);
        if (ls == 0) (void)xb_add(gcnt, 1u);
        if (ls == 9) (void)xb_add(gcnt + 64, 1u);
        if (ls == 4) (void)xb_add(gcnt + 128, 1u);
        (void)xb_add(tcnt + 64 * pm, 1u);
        const unsigned target = 4u * (unsigned)(k + 1);
        SPIN_UNTIL(xb_ld(tcnt + 64 * pm) >= target, tmo);
        if (nph == 1 && pm > 0) SPIN_UNTIL(xb_ld(tcnt + 64 * (pm - 1)) >= target, tmo);
        if (nph == 2 && pm < 63) SPIN_UNTIL(xb_ld(tcnt + 64 * (pm + 1)) >= target, tmo);
        if (b < sample_blocks(nph)) { const int kk = nph == 4 ? k - 1 : k, pp = nph == 4 ? 2 : ph;
            SPIN_UNTIL(xb_ld(scnt + 64 * kk) >= (unsigned)sample_blocks(pp), tmo); }
        if (nls == 2 * 10 - 1 && pm < 32) {
            SPIN_UNTIL(xb_ld(tcnt + 64 * (2 * pm)) >= 68u, tmo); SPIN_UNTIL(xb_ld(tcnt + 64 * (2 * pm + 1)) >= 68u, tmo); }
        if (nls == 9) SPIN_UNTIL(xb_ld(gcnt) >= 256u, tmo);
        if (nls == 10) SPIN_UNTIL(xb_ld(gcnt + 64) >= 256u, tmo);
        if (nls == 12) SPIN_UNTIL(xb_ld(gcnt + 128) >= 256u, tmo);
        __builtin_amdgcn_fence(__ATOMIC_ACQUIRE, "agent");
        asm volatile("s_waitcnt vmcnt(0)" ::: "memory");
    }
    __syncthreads();
}

__global__ void __launch_bounds__(512, 2) fwd_megakernel(Params p) {
    extern __shared__ __attribute__((aligned(16))) unsigned char shm[];
    LAS unsigned char* lds = (LAS unsigned char*)shm;
    const int tid = threadIdx.x;
    const int G = (int)gridDim.x, NGW = G * 8;
    unsigned char* ws = p.ws;
    bf16_t* S0 = (bf16_t*)(ws + 0 * SLOT); bf16_t* S1 = (bf16_t*)(ws + 1 * SLOT); bf16_t* S2 = (bf16_t*)(ws + 2 * SLOT);
    bf16_t* S3 = (bf16_t*)(ws + 3 * SLOT); bf16_t* S5 = (bf16_t*)(ws + 5 * SLOT);
    bf16_t* WIN = (bf16_t*)(ws + WS_WIN);
    unsigned char* sm = ws + WS_SM;
    float* PROJS = (float*)(sm + SM_PROJ); float* M1S = (float*)(sm + SM_M1);
    bf16_t* HS = (bf16_t*)(sm + SM_HS); bf16_t* YAS = (bf16_t*)(sm + SM_YAS); bf16_t* DDS = (bf16_t*)(sm + SM_DDS);
    bf16_t* YBS = (bf16_t*)(sm + SM_YBS); bf16_t* MRGS = (bf16_t*)(sm + SM_MRG); bf16_t* US = (bf16_t*)(sm + SM_US);
    float* X = p.out + O_Y;

    volatile LAS unsigned* cns = (volatile LAS unsigned*)(lds + STAGE_BYTES);
    if (tid == 0) { const unsigned x = xb_xcc_id() & 7u; cns[0] = x; ((unsigned*)(ws + WS_BAR + CTL_XCNT))[blockIdx.x] = x; }
    volatile LAS unsigned* xbst = (volatile LAS unsigned*)(lds + STAGE_BYTES + 56);
    if (tid == 0) { xbst[0] = 0u; xbst[1] = 0u; }
    __syncthreads();
    XcdBarrier xb = xcd_barrier_post((unsigned*)(ws + WS_BAR), xbst);
    if (G != 256) return;
    {
        const int lane = tid & 63, wid = tid >> 6, gw = (int)blockIdx.x * 8 + wid;
        LAS float* scr = (LAS float*)(lds + wid * 16384);
        {
            int idx = gw; bool have = idx < TR_P0; TrItem cur{}; float wv[32];
            if (have) { cur = tr_decode(p, ws, idx); tr_load(cur, wv, lane); }
            while (have) {
                const int nidx = idx + NGW; const bool hn = nidx < TR_P0; TrItem nxt{}; float wn[32];
                if (hn) { nxt = tr_decode(p, ws, nidx); tr_load(nxt, wn, lane); }
                tr_finish<false>(cur, wv, scr, lane);
                if (hn) {
#pragma unroll
                    for (int i = 0; i < 32; ++i) wv[i] = wn[i];
                }
                cur = nxt; idx = nidx; have = hn;
            }
        }
        const float* gpre = p.in[12];
        f32x4 gv[4];
#pragma unroll
        for (int j = 0; j < 4; ++j) gv[j] = *(const f32x4*)(gpre + lane * 4 + 256 * j);
        for (int r0 = gw * 4; r0 < MTOT; r0 += NGW * 4) {
            f32x4 v[4][4];
#pragma unroll
            for (int q = 0; q < 4; ++q) { const int r = r0 + q; const float* xr = r < MP ? p.in[0] + (size_t)r * D : p.in[1] + (size_t)(r - MP) * D;
#pragma unroll
                for (int j = 0; j < 4; ++j) v[q][j] = __builtin_nontemporal_load((const f32x4*)(xr + lane * 4 + 256 * j)); }
#pragma unroll
            for (int q = 0; q < 4; ++q) {
                const int r = r0 + q; bf16_t* hr = r < MP ? S0 + (size_t)r * D : HS + (size_t)(r - MP) * D;
                float s = 0.f;
#pragma unroll
                for (int j = 0; j < 4; ++j) s += (v[q][j][0] * v[q][j][0] + v[q][j][1] * v[q][j][1]) + (v[q][j][2] * v[q][j][2] + v[q][j][3] * v[q][j][3]);
                const float rs = rsqrtf(wave_sum(s) * (1.f / D) + EPS);
#pragma unroll
                for (int j = 0; j < 4; ++j) { u32x2 o; o.x = cvt_pk_bf16(v[q][j][0] * rs * gv[j][0], v[q][j][1] * rs * gv[j][1]); o.y = cvt_pk_bf16(v[q][j][2] * rs * gv[j][2], v[q][j][3] * rs * gv[j][3]);
                    *(u32x2*)(hr + lane * 4 + 256 * j) = o; }
            }
        }
    }
    xcd_barrier(xb);
    int bc = (int)blockIdx.x;
    {
        const unsigned* tab = (const unsigned*)(ws + WS_BAR + CTL_XCNT);
        const unsigned myx = cns[0];
        volatile LAS unsigned* red = (volatile LAS unsigned*)(lds + STAGE_BYTES + 16);
        if (tid < 9) red[tid] = 0u;
        __syncthreads();
        if (tid < 256) {
            const unsigned x = tab[tid];
            const unsigned long long lower = __ballot(x == myx && tid < (int)blockIdx.x);
            if ((tid & 63) == 0) atomicAdd((unsigned*)&red[0], (unsigned)__popcll(lower));
#pragma unroll
            for (unsigned xx = 0; xx < 8; ++xx) { const unsigned long long m = __ballot(x == xx); if ((tid & 63) == 0) atomicAdd((unsigned*)&red[1 + xx], (unsigned)__popcll(m)); }
        }
        __syncthreads();
        bool ok = true;
        for (int xx = 0; xx < 8; ++xx) ok = ok && (red[1 + xx] == 32u);
        if (ok) bc = (int)myx + 8 * (int)red[0];
        bc = __builtin_amdgcn_readfirstlane(bc);
    }
    const int pm_t = 8 * (bc & 7) + ((bc >> 3) & 7), mem_t = bc >> 6;

    if (SKEW_TICKS > 0 && (bc & 4)) {
        const unsigned long long t0 = __builtin_amdgcn_s_memrealtime();
        while (__builtin_amdgcn_s_memrealtime() - t0 < (unsigned long long)SKEW_TICKS) __builtin_amdgcn_s_sleep(8);
    }
    for (int step = 0; step < p.nsteps; ++step) {
        const int step2 = (p.pad && step > p.pad) ? step - 1 : step;
        const int l = step2 / 10, ph = step2 - l * 10;
        int tid_s = threadIdx.x; asm volatile("" : "+v"(tid_s));
        const int lane = tid_s & 63, wid = tid_s >> 6, gw = bc * 8 + wid;
        unsigned char* wl = ws + WS_WL + (size_t)l * WL_BYTES;
        const float* bgate = p.in[5] + (size_t)l * 2 * D;
        Gemm g{S0, WIN, D, D, D, MP / BM, D / BM, 0, 30, 0};
        Epi E{E_PLAIN, D, S1, nullptr, nullptr, nullptr, ws};
        SkGemm sk{SE_F32, D, D, D, D / 32, D, 1 << 20, 0, 1, HS, WIN, PROJS, PROJS, bgate, M1S};
        bool is_gemm = true;
        switch (ph) {
        case 0:
            g.nN = DIN / BM; E.id = E_PROJ; E.vec = bgate;
            sk.ldc = DIN; sk.nCB = DIN / 32; sk.C = PROJS; break;
        case 2:
            g.Bt = (const bf16_t*)(wl + WL_POOL); g.ldb = 256; g.K = 256; g.nN = 4; g.a_pn_off = 256;
            E.id = E_SCALE; E.o0 = S2; E.vec = p.in[9] + (size_t)l * D;
            if (bc < 32) { sk.emode = SE_SCALE; sk.A = DDS; sk.Bt = g.Bt; sk.ldb = 256; sk.K = 256; sk.cbPerGrp = 8; sk.grpK = 256; sk.C = YBS; sk.vec = E.vec; }
            else { sk.emode = SE_GATE; sk.A = YAS; sk.Bt = (const bf16_t*)(wl + WL_WC); }
            break;
        case 3:
            g.A = S1; g.Bt = (const bf16_t*)(wl + WL_WC); E.id = E_GATE; E.o0 = S3; E.x0 = (const bf16_t*)(ws + 4 * SLOT);
            sk.nCB = 0; break;
        case 4:
            g.A = S2; g.Bt = (const bf16_t*)(wl + WL_WP); E.id = E_GATEADD; E.o0 = S0; E.x0 = S5; E.x1 = S3;
            sk.emode = SE_GATEADD; sk.A = YBS; sk.Bt = g.Bt; sk.C = MRGS; break;
        case 5:
            g.Bt = (const bf16_t*)(wl + WL_WO); E.o0 = S5;
            sk.A = MRGS; sk.Bt = g.Bt; sk.K = 256; sk.nKS = 4; break;
        case 7:
            g.Bt = (const bf16_t*)(wl + WL_UP); g.nN = DFF / BM; E.id = E_RELU2; E.ldc = DFF;
            sk.emode = SE_RELU2; sk.Bt = g.Bt; sk.ldc = DFF; sk.nCB = DFF / 32; sk.C = US; break;
        case 8:
            g.A = S1; g.Bt = (const bf16_t*)(wl + WL_DOWN); g.ldb = DFF; g.K = DFF; g.a_wrap_shift = 4; g.a_wrap_stride = SLOT; E.o0 = S0;
            sk.A = US; sk.lda = DFF; sk.Bt = g.Bt; sk.ldb = DFF; sk.K = D; sk.nKS = 4; break;
        default: is_gemm = false; break;
        }
        if (is_gemm) {
            skinny_gemm(lds, sk, (ph == 2 && bc >= 32) ? bc - 32 : bc, G);
            StaticOrder S; S.init(g.nM, g.nN, G, bc);
            gemm_phase(lds, g, S, E);
            if (l == 0 && (ph == 0 || ph == 2 || ph == 4)) {
                const int nts = ph == 0 ? 192 : ph == 2 ? 64 : 32, boff = ph == 0 ? 0 : ph == 2 ? 64 : 256;
                if (bc >= nts) {
                    LAS float* scr = (LAS float*)(lds + wid * 16384);
#pragma unroll 1
                    for (int j = 0; j < 2; ++j) {
                        const int it = (boff + bc - nts) * 16 + wid * 2 + j;
                        if (it < TR_L) { const TrItem t = tr_decode(p, ws, TR_P0 + it); float wv[32]; tr_load(t, wv, lane); tr_finish<true>(t, wv, scr, lane); }
                    }
                }
            }
        } else if (ph == 1) {
            const float* cw = p.in[6] + (size_t)l * 3 * D;
            const float* cconv = p.in[2] + (size_t)l * NB_S * 2 * D;
            const float* cpool = p.in[3] + (size_t)l * NB_S * 15 * D;
            float* o_csp = p.out + O_CSP + (size_t)l * 2 * D;
            float* o_psp = p.out + O_PSP + (size_t)l * 15 * D;
            float* o_css = p.out + O_CSS + (size_t)l * NB_S * 2 * D;
            float* o_pss = p.out + O_PSS + (size_t)l * NB_S * 15 * D;
            const f32x4 zero4 = (f32x4){0.f, 0.f, 0.f, 0.f};
            {
                const int hi = wid * 2 + (lane >> 5);
                const int gi = hi & 3, r0 = pm_t * 256 + (mem_t * 4 + (hi >> 2)) * 16, ch = gi * 256 + (lane & 31) * 8, w = 2 << gi;
                const bool head = (r0 == 0);
                const float ic = 1.0f / (float)w;
                const f32x4 w0a = *(const f32x4*)(cw + ch), w0b = *(const f32x4*)(cw + ch + 4);
                const f32x4 w1a = *(const f32x4*)(cw + D + ch), w1b = *(const f32x4*)(cw + D + ch + 4);
                const f32x4 w2a = *(const f32x4*)(cw + 2 * D + ch), w2b = *(const f32x4*)(cw + 2 * D + ch + 4);
                f32x4 z1a = zero4, z1b = zero4, z2a = zero4, z2b = zero4, sa = zero4, sb2 = zero4;
                if (!head) {
                    ld8(S2 + (size_t)(r0 - 1) * D + ch, z1a, z1b);
                    ld8(S2 + (size_t)(r0 - 2) * D + ch, z2a, z2b);
#pragma unroll
                    for (int i0 = 1; i0 < 16; i0 += 8) {
                        u32x4 hr[8];
#pragma unroll
                        for (int i = 0; i < 8; ++i) if (i0 + i < 16) hr[i] = *(const u32x4*)(S3 + (size_t)(r0 - (i0 + i)) * D + ch);
#pragma unroll
                        for (int i = 0; i < 8; ++i) if (i0 + i < 16) { f32x4 qa, qb; up8(hr[i], qa, qb); const float mk = (i0 + i < w) ? 1.f : 0.f; sa += qa * mk; sb2 += qb * mk; }
                    }
                }
                u32x4 nB[2], nZ[2], nP[2], nO[2];
                const u32x4 zr = (u32x4){0u, 0u, 0u, 0u};
#pragma unroll
                for (int q = 0; q < 2; ++q) { const size_t ro = (size_t)(r0 + q) * D + ch;
                    nB[q] = __builtin_nontemporal_load((const u32x4*)(S1 + ro)); nZ[q] = __builtin_nontemporal_load((const u32x4*)(S2 + ro)); nP[q] = *(const u32x4*)(S3 + ro);
                    nO[q] = (!head || r0 + q - (w - 1) >= 0) ? *(const u32x4*)(S3 + ro - (size_t)(w - 1) * D) : zr; }
                for (int gq = 0; gq < 8; ++gq) {
                    u32x4 cB[2], cZ[2], cP[2], cO[2];
#pragma unroll
                    for (int q = 0; q < 2; ++q) { cB[q] = nB[q]; cZ[q] = nZ[q]; cP[q] = nP[q]; cO[q] = nO[q]; }
                    if (gq < 7) {
#pragma unroll
                        for (int q = 0; q < 2; ++q) { const size_t ro = (size_t)(r0 + gq * 2 + 2 + q) * D + ch;
                            nB[q] = __builtin_nontemporal_load((const u32x4*)(S1 + ro)); nZ[q] = __builtin_nontemporal_load((const u32x4*)(S2 + ro)); nP[q] = *(const u32x4*)(S3 + ro);
                            nO[q] = (!head || r0 + gq * 2 + 2 + q - (w - 1) >= 0) ? *(const u32x4*)(S3 + ro - (size_t)(w - 1) * D) : zr; }
                    }
#pragma unroll
                    for (int q = 0; q < 2; ++q) {
                        const int t = r0 + gq * 2 + q;
                        const size_t ro = (size_t)t * D + ch;
                        f32x4 b0, b1, z0a, z0b, p0a, p0b, oa, ob;
                        up8(cB[q], b0, b1); up8(cZ[q], z0a, z0b); up8(cP[q], p0a, p0b); up8(cO[q], oa, ob);
                        const float ict = head ? 1.0f / (float)(t + 1 < w ? t + 1 : w) : ic;
                        sa += p0a; sb2 += p0b;
                        st8(S1 + ro, b0 * (w0a * z2a + w1a * z1a + w2a * z0a), b1 * (w0b * z2b + w1b * z1b + w2b * z0b));
                        st8(S0 + ro, sa * ict - p0a, sb2 * ict - p0b);
                        sa -= oa; sb2 -= ob;
                        z2a = z1a; z2b = z1b; z1a = z0a; z1b = z0b;
                        if (t >= MP - 2) { float* o = o_csp + (size_t)(t - (MP - 2)) * D + ch; *(f32x4*)o = z0a; *(f32x4*)(o + 4) = z0b; }
                        if (t >= MP - 15) { float* o = o_psp + (size_t)(t - (MP - 15)) * D + ch; *(f32x4*)o = p0a; *(f32x4*)(o + 4) = p0b; }
                    }
                }
            }
            if (wid == 0) {
                const int it = bc, gi = it & 3, ch = gi * 256 + (lane & 31) * 8, w = 2 << gi;
                const f32x4 w0a = *(const f32x4*)(cw + ch), w0b = *(const f32x4*)(cw + ch + 4);
                const f32x4 w1a = *(const f32x4*)(cw + D + ch), w1b = *(const f32x4*)(cw + D + ch + 4);
                const f32x4 w2a = *(const f32x4*)(cw + 2 * D + ch), w2b = *(const f32x4*)(cw + 2 * D + ch + 4);
                const int rs = (it >> 2) * 2 + (lane >> 5), sb = rs >> 4, t = rs & 15;
                const int cc = D + (ch >> 7) * 256 + (ch & 127);
                const float* pr = PROJS + (size_t)rs * DIN;
                const f32x4 b0 = *(const f32x4*)(pr + ch), b1 = *(const f32x4*)(pr + ch + 4);
                const f32x4 z0a = *(const f32x4*)(pr + cc) * *(const f32x4*)(pr + cc + 128), z0b = *(const f32x4*)(pr + cc + 4) * *(const f32x4*)(pr + cc + 132);
                const f32x4 p0a = *(const f32x4*)(pr + 3 * D + ch), p0b = *(const f32x4*)(pr + 3 * D + ch + 4);
                f32x4 z1a, z1b, z2a, z2b;
                if (t >= 1) { const float* q = pr - DIN; z1a = *(const f32x4*)(q + cc) * *(const f32x4*)(q + cc + 128); z1b = *(const f32x4*)(q + cc + 4) * *(const f32x4*)(q + cc + 132); }
                else { const float* q = cconv + ((size_t)sb * 2 + 1) * D + ch; z1a = *(const f32x4*)q; z1b = *(const f32x4*)(q + 4); }
                if (t >= 2) { const float* q = pr - 2 * DIN; z2a = *(const f32x4*)(q + cc) * *(const f32x4*)(q + cc + 128); z2b = *(const f32x4*)(q + cc + 4) * *(const f32x4*)(q + cc + 132); }
                else { const float* q = cconv + ((size_t)sb * 2 + t) * D + ch; z2a = *(const f32x4*)q; z2b = *(const f32x4*)(q + 4); }
                f32x4 sa = p0a, sb2 = p0b;
                {
#pragma unroll
                    for (int i0 = 1; i0 < 16; i0 += 5) {
                        f32x4 ha[5], hb[5];
#pragma unroll
                        for (int i = 0; i < 5; ++i) {
                            const int ii = i0 + i;
                            const float* q = (t - ii >= 0) ? pr - (size_t)ii * DIN + 3 * D + ch : cpool + ((size_t)sb * 15 + (15 + t - ii)) * D + ch;
                            ha[i] = *(const f32x4*)q; hb[i] = *(const f32x4*)(q + 4);
                        }
#pragma unroll
                        for (int i = 0; i < 5; ++i) { const float mk = (i0 + i < w) ? 1.f : 0.f; sa += ha[i] * mk; sb2 += hb[i] * mk; }
                    }
                }
                const float ic = 1.0f / (float)w;
                st8(YAS + (size_t)rs * D + ch, b0 * (w0a * z2a + w1a * z1a + w2a * z0a), b1 * (w0b * z2b + w1b * z1b + w2b * z0b));
                st8(DDS + (size_t)rs * D + ch, sa * ic - p0a, sb2 * ic - p0b);
                if (t >= SEQ_S - 2) { float* o = o_css + ((size_t)sb * 2 + (t - (SEQ_S - 2))) * D + ch; *(f32x4*)o = z0a; *(f32x4*)(o + 4) = z0b; }
                if (t >= 1) { float* o = o_pss + ((size_t)sb * 15 + (t - 1)) * D + ch; *(f32x4*)o = p0a; *(f32x4*)(o + 4) = p0b; }
            }
        } else {
            const int half = ph == 6 ? 0 : 1;
            const bf16_t* Y = half == 0 ? S5 : S0;
            const float* gpost = (half == 0 ? p.in[13] : p.in[17]) + (size_t)l * D;
            const float* gnext = half == 0 ? p.in[16] + (size_t)l * D : p.in[12] + (size_t)(l + 1 < NL ? l + 1 : l) * D;
            const bool from_input = (l == 0 && half == 0);
            const bool last = (l + 1 == NL && half == 1);
            bf16_t* XB = (bf16_t*)p.out;
            const bf16_t* xsrc = (l + 1 == NL && half == 1) ? S5 : XB;
            bf16_t* xdst = (l + 1 == NL && half == 0) ? S5 : XB;
            f32x4 gp[4], gn[4];
#pragma unroll
            for (int j = 0; j < 4; ++j) { gp[j] = *(const f32x4*)(gpost + lane * 4 + 256 * j); gn[j] = *(const f32x4*)(gnext + lane * 4 + 256 * j); }
            const int rbase = pm_t * 256 + mem_t * 64 + wid * 8;
            if (from_input) {
                for (int i0 = 0; i0 < 8; i0 += 2) {
                    f32x4 xn[2][4]; u32x2 yn[2][4];
#pragma unroll
                    for (int q = 0; q < 2; ++q)
#pragma unroll
                        for (int j = 0; j < 4; ++j) { const size_t o = (size_t)(rbase + i0 + q) * D + lane * 4 + 256 * j; xn[q][j] = __builtin_nontemporal_load((const f32x4*)(p.in[0] + o)); yn[q][j] = __builtin_nontemporal_load((const u32x2*)(Y + o)); }
#pragma unroll
                    for (int q = 0; q < 2; ++q) {
                        const int r = rbase + i0 + q;
                        f32x4 xv[4], yv[4];
#pragma unroll
                        for (int j = 0; j < 4; ++j) { xv[j] = xn[q][j]; yv[j][0] = bf_lo(yn[q][j].x); yv[j][1] = bf_hi(yn[q][j].x); yv[j][2] = bf_lo(yn[q][j].y); yv[j][3] = bf_hi(yn[q][j].y); }
                        norm_row_finish(xv, yv, gp, gn, nullptr, xdst + (size_t)r * D, S0 + (size_t)r * D, lane);
                    }
                }
            } else {
                for (int i0 = 0; i0 < 8; i0 += 4) {
                    u32x2 xnb[4][4], yn[4][4];
#pragma unroll
                    for (int q = 0; q < 4; ++q)
#pragma unroll
                        for (int j = 0; j < 4; ++j) { const size_t o = (size_t)(rbase + i0 + q) * D + lane * 4 + 256 * j; xnb[q][j] = __builtin_nontemporal_load((const u32x2*)(xsrc + o)); yn[q][j] = __builtin_nontemporal_load((const u32x2*)(Y + o)); }
#pragma unroll
                    for (int q = 0; q < 4; ++q) {
                        const int r = rbase + i0 + q;
                        f32x4 xv[4], yv[4];
#pragma unroll
                        for (int j = 0; j < 4; ++j) {
                            xv[j][0] = bf_lo(xnb[q][j].x); xv[j][1] = bf_hi(xnb[q][j].x); xv[j][2] = bf_lo(xnb[q][j].y); xv[j][3] = bf_hi(xnb[q][j].y);
                            yv[j][0] = bf_lo(yn[q][j].x); yv[j][1] = bf_hi(yn[q][j].x); yv[j][2] = bf_lo(yn[q][j].y); yv[j][3] = bf_hi(yn[q][j].y);
                        }
                        norm_row_finish(xv, yv, gp, gn, last ? X + (size_t)r * D : nullptr, xdst + (size_t)r * D, last ? nullptr : S0 + (size_t)r * D, lane);
                    }
                }
            }
            if (wid == 0 && bc < MS) {
                const int rs_ = bc;
                const float* xr = from_input ? p.in[1] + (size_t)rs_ * D : X + (size_t)(MP + rs_) * D;
                f32x4 xv[4], yv[4];
#pragma unroll
                for (int j = 0; j < 4; ++j) {
                    xv[j] = *(const f32x4*)(xr + lane * 4 + 256 * j);
                    const float* q = PROJS + (size_t)rs_ * D + lane * 4 + 256 * j;
                    yv[j] = (*(const f32x4*)q + *(const f32x4*)(q + MS * D)) + (*(const f32x4*)(q + 2 * MS * D) + *(const f32x4*)(q + 3 * MS * D));
                }
                norm_row_finish(xv, yv, gp, gn, X + (size_t)(MP + rs_) * D, nullptr, last ? nullptr : HS + (size_t)rs_ * D, lane);
            }
            if (half == 1 && l + 1 < NL) {
                LAS float* scr = (LAS float*)(lds + wid * 16384);
                int off = 0;
                transpose_matrix<true>(p.in[4] + (size_t)(l + 1) * D * DIN, D, DIN, WIN, 1, scr, gw, NGW, lane, off);
            }
        }
        if (step + 1 < p.nsteps) step_sync(ws + WS_BAR, bc, pm_t, step, step2, (p.pad && step + 1 > p.pad) ? step : step + 1);
    }
}

extern "C" void kernel_launch(void* const* d_in, const int* in_sizes, int n_in, void* d_out, int out_size, void* d_ws, size_t ws_size, hipStream_t stream) {
    static int grid = 0;
    if (grid == 0) {
        if (n_in != 18 || ws_size < WS_END) { fprintf(stderr, "kernel_launch: unexpected n_in %d or ws_size %zu (< %zu)\n", n_in, ws_size, (size_t)WS_END); grid = -1; return; }
        int dev = 0, cus = 0, per_cu = 0;
        hipGetDevice(&dev);
        hipDeviceGetAttribute(&cus, hipDeviceAttributeMultiprocessorCount, dev);
        if (hipFuncSetAttribute((const void*)fwd_megakernel, hipFuncAttributeMaxDynamicSharedMemorySize, LDS_BYTES) != hipSuccess) { fprintf(stderr, "kernel_launch: hipFuncSetAttribute failed\n"); grid = -1; return; }
        if (hipOccupancyMaxActiveBlocksPerMultiprocessor(&per_cu, (const void*)fwd_megakernel, 512, LDS_BYTES) != hipSuccess || per_cu < 1) { fprintf(stderr, "kernel_launch: occupancy query failed (%d)\n", per_cu); grid = -1; return; }
        grid = cus * per_cu;
    }
    if (grid < 0) return;
    Params p{};
    for (int i = 0; i < 18; ++i) p.in[i] = (const float*)d_in[i];
    p.out = (float*)d_out; p.ws = (unsigned char*)d_ws; p.nsteps = NL * 10 + (PROBE ? 1 : 0); p.pad = PROBE;
    (void)hipMemsetAsync((unsigned char*)d_ws + WS_BAR, 0, CTL_XCNT, stream);
    void* args[] = {&p};
    hipError_t e = hipLaunchCooperativeKernel((const void*)fwd_megakernel, dim3(grid), dim3(512), args, LDS_BYTES, stream);
    if (e != hipSuccess) fprintf(stderr, "cooperative launch failed: %s (grid %d)\n", hipGetErrorString(e), grid);
}
```
